# Optimizing an MI355X kernel written in HIP

```python
import jax, jax.numpy as jnp
from jax import lax
import numpy as np

D_MODEL = 1024
BATCH = 16
SEQ = 2048
DEPTH = 4

N_MIXERS = 2
HEAD_DIM = 64
N_HEADS = D_MODEL // HEAD_DIM
N_KV = 4
GQA = N_HEADS // N_KV
ROT_DIM = HEAD_DIM // 4
ROPE_THETA = 500000.0
NORM_EPS = 1e-6
Q_W = N_HEADS * HEAD_DIM
KV_W = N_KV * HEAD_DIM

CMP_LEN = 32
CMP_STRIDE = 16
CMP_HID = 4 * HEAD_DIM
SEL_BLOCK = 64
SEL_COUNT = 8
WINDOW = 256
NSA_Q_BLOCK = 32
NSA_IN = 2 * Q_W + 6 * KV_W + 3 * N_HEADS

MOBA_BLOCK = 256
MOBA_TOPK = 3
MOBA_Q_BLOCK = 8
MOBA_IN = 2 * Q_W + 2 * KV_W

N_A = (DEPTH + 1) // 2
N_B = DEPTH // 2

kernel_name = "nsa_moba_hybrid_adaln_trunk"


def rms_norm(x, g):
    xf = x.astype(jnp.float32)
    y = xf * lax.rsqrt(jnp.mean(xf * xf, axis=-1, keepdims=True) + NORM_EPS)
    return (y * g.astype(jnp.float32)).astype(x.dtype)


def rope_tables(pos):
    inv_freq = ROPE_THETA ** (-jnp.arange(0, ROT_DIM, 2, dtype=jnp.float32) / ROT_DIM)
    ang = pos.astype(jnp.float32)[..., None] * inv_freq
    return jnp.cos(ang), jnp.sin(ang)


def partial_rope(x, cos, sin):
    half = ROT_DIM // 2
    c = cos[:, :, None, :].astype(x.dtype)
    s = sin[:, :, None, :].astype(x.dtype)
    x1, x2, rest = x[..., :half], x[..., half:ROT_DIM], x[..., ROT_DIM:]
    return jnp.concatenate([x1 * c - x2 * s, x2 * c + x1 * s, rest], axis=-1)


def masked_softmax(s, mask):
    s = jnp.where(mask, s.astype(jnp.float32), -jnp.inf)
    m = jnp.max(s, axis=-1, keepdims=True)
    e = jnp.exp(s - jnp.where(jnp.isfinite(m), m, 0.0))
    return e / jnp.maximum(jnp.sum(e, axis=-1, keepdims=True), 1e-30)


def split_cols(a, widths):
    return jnp.split(a, np.cumsum(widths)[:-1].tolist(), axis=-1)


def cmp_to_sel_weights(n_cmp, n_sel):
    cs = np.arange(n_cmp)[:, None] * CMP_STRIDE
    ss = np.arange(n_sel)[None, :] * SEL_BLOCK
    shared = np.clip(np.minimum(cs + CMP_LEN, ss + SEL_BLOCK) - np.maximum(cs, ss), 0, None)
    return jnp.asarray(shared / CMP_LEN, dtype=jnp.float32)


def nsa_mixer(h, cos, sin, positions, w_in, w_out, q_g, k_g, cmp_pe, cmp_w1, cmp_b1, cmp_w2, gate_b):
    B, S, _ = h.shape
    q, kc, vc, ks, vs, kw, vw, gl, z = split_cols(h @ w_in, [Q_W] + [KV_W] * 6 + [3 * N_HEADS, Q_W])
    q = partial_rope(rms_norm(q.reshape(B, S, N_HEADS, HEAD_DIM), q_g), cos, sin)
    q = q.reshape(B, S, N_KV, GQA, HEAD_DIM)
    gates = jax.nn.sigmoid(gl + gate_b).reshape(B, S, N_KV, GQA, 3)
    scale = HEAD_DIM ** -0.5

    n_cmp = (S - CMP_LEN) // CMP_STRIDE + 1
    blk_idx = np.arange(n_cmp)[:, None] * CMP_STRIDE + np.arange(CMP_LEN)[None, :]
    cmp_end = blk_idx[:, -1]

    def compress(t, i):
        blocks = t.reshape(B, S, N_KV, HEAD_DIM)[:, blk_idx] + cmp_pe[i][None, None, :, None, :]
        flat = blocks.transpose(0, 1, 3, 2, 4).reshape(B, n_cmp, N_KV, CMP_LEN * HEAD_DIM)
        return jax.nn.gelu(flat @ cmp_w1[i] + cmp_b1[i]) @ cmp_w2[i]

    cos_c, sin_c = rope_tables(positions[:, cmp_end])
    k_cmp = partial_rope(rms_norm(compress(kc, 0), k_g[0]), cos_c, sin_c)
    v_cmp = compress(vc, 1)
    cmp_end_j = jnp.asarray(cmp_end, dtype=jnp.int32)

    n_sel = S // SEL_BLOCK
    k_sel = min(SEL_COUNT, n_sel)
    sel_w = cmp_to_sel_weights(n_cmp, n_sel)
    ks = partial_rope(rms_norm(ks.reshape(B, S, N_KV, HEAD_DIM), k_g[1]), cos, sin)
    ks_blk = ks.reshape(B, n_sel, SEL_BLOCK, N_KV, HEAD_DIM).transpose(0, 3, 1, 2, 4)
    vs_blk = vs.reshape(B, n_sel, SEL_BLOCK, N_KV, HEAD_DIM).transpose(0, 3, 1, 2, 4)

    pad = ((0, 0), (WINDOW, 0), (0, 0), (0, 0))
    kw_pad = jnp.pad(partial_rope(rms_norm(kw.reshape(B, S, N_KV, HEAD_DIM), k_g[2]), cos, sin), pad)
    vw_pad = jnp.pad(vw.reshape(B, S, N_KV, HEAD_DIM), pad)

    b_i = jnp.arange(B)[:, None, None, None]
    g_i = jnp.arange(N_KV)[None, None, :, None]
    sel_blocks = jnp.arange(n_sel)
    C = NSA_Q_BLOCK

    def q_block(ci):
        t0 = ci * C
        t = t0 + jnp.arange(C)
        qc = lax.dynamic_slice_in_dim(q, t0, C, axis=1)
        gc = lax.dynamic_slice_in_dim(gates, t0, C, axis=1)
        m_cmp = (cmp_end_j[None, :] <= t[:, None])[None, :, None, None, :]
        p_cmp = masked_softmax(jnp.einsum('bcgrd,bngd->bcgrn', qc, k_cmp) * scale, m_cmp)
        o_cmp = jnp.einsum('bcgrn,bngd->bcgrd', p_cmp.astype(v_cmp.dtype), v_cmp)
        imp = jnp.einsum('bcgrn,nj->bcgj', p_cmp, sel_w)
        cur = (t // SEL_BLOCK)[:, None]
        valid = sel_blocks[None, :] <= cur
        forced = (sel_blocks[None, :] == 0) | (sel_blocks[None, :] == cur) | (sel_blocks[None, :] == cur - 1)
        score = jnp.where(forced[None, :, None, :], jnp.inf,
                          jnp.where(valid[None, :, None, :], imp, -jnp.inf))
        _, sel = lax.top_k(score, k_sel)
        kg_sel = ks_blk[b_i, g_i, sel].reshape(B, C, N_KV, k_sel * SEL_BLOCK, HEAD_DIM)
        vg_sel = vs_blk[b_i, g_i, sel].reshape(B, C, N_KV, k_sel * SEL_BLOCK, HEAD_DIM)
        kpos = (sel[..., None] * SEL_BLOCK + jnp.arange(SEL_BLOCK)).reshape(B, C, N_KV, 1, k_sel * SEL_BLOCK)
        m_slc = kpos <= t[None, :, None, None, None]
        p_slc = masked_softmax(jnp.einsum('bcgrd,bcgnd->bcgrn', qc, kg_sel) * scale, m_slc)
        o_slc = jnp.einsum('bcgrn,bcgnd->bcgrd', p_slc.astype(vg_sel.dtype), vg_sel)
        kwc = lax.dynamic_slice_in_dim(kw_pad, t0, C + WINDOW, axis=1)
        vwc = lax.dynamic_slice_in_dim(vw_pad, t0, C + WINDOW, axis=1)
        kp = t0 - WINDOW + jnp.arange(C + WINDOW)
        dist = t[:, None] - kp[None, :]
        m_win = ((dist >= 0) & (dist < WINDOW) & (kp[None, :] >= 0))[None, :, None, None, :]
        p_win = masked_softmax(jnp.einsum('bcgrd,bkgd->bcgrk', qc, kwc) * scale, m_win)
        o_win = jnp.einsum('bcgrk,bkgd->bcgrd', p_win.astype(vwc.dtype), vwc)
        return gc[..., 0:1] * o_cmp + gc[..., 1:2] * o_slc + gc[..., 2:3] * o_win

    o = lax.map(q_block, jnp.arange(S // C))
    o = jnp.moveaxis(o, 0, 1).reshape(B, S, Q_W)
    return (o * jax.nn.silu(z)) @ w_out


def moba_mixer(h, cos, sin, w_in, w_out, q_g, k_g):
    B, S, _ = h.shape
    q, k, v, z = split_cols(h @ w_in, [Q_W, KV_W, KV_W, Q_W])
    q = partial_rope(rms_norm(q.reshape(B, S, N_HEADS, HEAD_DIM), q_g), cos, sin)
    q = q.reshape(B, S, N_KV, GQA, HEAD_DIM)
    k = partial_rope(rms_norm(k.reshape(B, S, N_KV, HEAD_DIM), k_g), cos, sin)
    v = v.reshape(B, S, N_KV, HEAD_DIM)
    scale = HEAD_DIM ** -0.5

    n_blk = -(-S // MOBA_BLOCK)
    pad = ((0, 0), (0, n_blk * MOBA_BLOCK - S), (0, 0), (0, 0))
    k_pad = jnp.pad(k, pad)
    v_pad = jnp.pad(v, pad)
    k_blk = k_pad.reshape(B, n_blk, MOBA_BLOCK, N_KV, HEAD_DIM)
    k_mean = jnp.mean(k_blk.astype(jnp.float32), axis=2).astype(k.dtype)
    k_blk_t = k_blk.transpose(0, 3, 1, 2, 4)
    v_blk_t = v_pad.reshape(B, n_blk, MOBA_BLOCK, N_KV, HEAD_DIM).transpose(0, 3, 1, 2, 4)
    k_top = min(MOBA_TOPK, n_blk - 1)
    b_i = jnp.arange(B)[:, None, None, None, None]
    g_i = jnp.arange(N_KV)[None, None, :, None, None]
    blk = jnp.arange(n_blk)
    C = MOBA_Q_BLOCK

    def q_block(ci):
        t0 = ci * C
        t = t0 + jnp.arange(C)
        qc = lax.dynamic_slice_in_dim(q, t0, C, axis=1)
        own = t0 // MOBA_BLOCK
        bstart = own * MOBA_BLOCK
        k_own = lax.dynamic_slice_in_dim(k_pad, bstart, MOBA_BLOCK, axis=1)
        v_own = lax.dynamic_slice_in_dim(v_pad, bstart, MOBA_BLOCK, axis=1)
        kpos = bstart + jnp.arange(MOBA_BLOCK)
        m_own = jnp.broadcast_to((kpos[None, :] <= t[:, None])[None, :, None, None, :],
                                 (B, C, N_KV, GQA, MOBA_BLOCK))
        s_own = jnp.einsum('bcgrd,bkgd->bcgrk', qc, k_own) * scale
        if k_top > 0:
            s_gate = jnp.einsum('bcgrd,bjgd->bcgrj', qc, k_mean).astype(jnp.float32)
            s_gate = jnp.where(blk < own, s_gate, -jnp.inf)
            _, sel = lax.top_k(s_gate, k_top)
            kg = k_blk_t[b_i, g_i, sel]
            vg = v_blk_t[b_i, g_i, sel].reshape(B, C, N_KV, GQA, k_top * MOBA_BLOCK, HEAD_DIM)
            s_past = jnp.einsum('bcgrd,bcgrkld->bcgrkl', qc, kg).reshape(B, C, N_KV, GQA, k_top * MOBA_BLOCK) * scale
            m_past = jnp.broadcast_to((sel < own)[..., None],
                                      (B, C, N_KV, GQA, k_top, MOBA_BLOCK)).reshape(B, C, N_KV, GQA, k_top * MOBA_BLOCK)
            p = masked_softmax(jnp.concatenate([s_past, s_own], axis=-1),
                               jnp.concatenate([m_past, m_own], axis=-1)).astype(v.dtype)
            n_past = k_top * MOBA_BLOCK
            return (jnp.einsum('bcgrn,bcgrnd->bcgrd', p[..., :n_past], vg)
                    + jnp.einsum('bcgrk,bkgd->bcgrd', p[..., n_past:], v_own))
        p = masked_softmax(s_own, m_own).astype(v.dtype)
        return jnp.einsum('bcgrk,bkgd->bcgrd', p, v_own)

    o = lax.map(q_block, jnp.arange(S // C))
    o = jnp.moveaxis(o, 0, 1).reshape(B, S, Q_W)
    return (o * jax.nn.silu(z)) @ w_out


def setup_inputs(seed: int = 0) -> dict:
    key = jax.random.key(seed)
    ks = jax.random.split(key, 20)
    D = D_MODEL

    def nrm(k, shape, s):
        return jax.random.normal(k, shape, jnp.float32) * s

    x = nrm(ks[0], (BATCH, SEQ, D), 1.0)
    c = nrm(ks[1], (BATCH, D), 1.0)
    offset = jax.random.randint(ks[2], (BATCH, 1), 0, 4096, dtype=jnp.int32)
    positions = offset + jnp.arange(SEQ, dtype=jnp.int32)[None, :]
    return {
        "x": x,
        "c": c,
        "positions": positions,
        "norm_g": 1.0 + nrm(ks[3], (DEPTH, D), 0.02),
        "ada_w": nrm(ks[4], (DEPTH, D, 3 * D), 0.5 * D ** -0.5),
        "ada_b": nrm(ks[5], (DEPTH, 3 * D), 0.02),
        "nsa_w_in": nrm(ks[6], (N_A, D, NSA_IN), D ** -0.5),
        "nsa_w_out": nrm(ks[7], (N_A, Q_W, D), Q_W ** -0.5),
        "nsa_q_norm": 1.0 + nrm(ks[8], (N_A, HEAD_DIM), 0.02),
        "nsa_k_norm": 1.0 + nrm(ks[9], (N_A, 3, HEAD_DIM), 0.02),
        "nsa_cmp_pe": nrm(ks[10], (N_A, 2, CMP_LEN, HEAD_DIM), 0.1),
        "nsa_cmp_w1": nrm(ks[11], (N_A, 2, CMP_LEN * HEAD_DIM, CMP_HID), (CMP_LEN * HEAD_DIM) ** -0.5),
        "nsa_cmp_b1": nrm(ks[12], (N_A, 2, CMP_HID), 0.02),
        "nsa_cmp_w2": nrm(ks[13], (N_A, 2, CMP_HID, HEAD_DIM), CMP_HID ** -0.5),
        "nsa_gate_b": nrm(ks[14], (N_A, 3 * N_HEADS), 0.1),
        "moba_w_in": nrm(ks[15], (N_B, D, MOBA_IN), D ** -0.5),
        "moba_w_out": nrm(ks[16], (N_B, Q_W, D), Q_W ** -0.5),
        "moba_q_norm": 1.0 + nrm(ks[17], (N_B, HEAD_DIM), 0.02),
        "moba_k_norm": 1.0 + nrm(ks[18], (N_B, HEAD_DIM), 0.02),
    }


def reference(x, c, positions, norm_g, ada_w, ada_b, nsa_w_in, nsa_w_out, nsa_q_norm, nsa_k_norm,
              nsa_cmp_pe, nsa_cmp_w1, nsa_cmp_b1, nsa_cmp_w2, nsa_gate_b,
              moba_w_in, moba_w_out, moba_q_norm, moba_k_norm):
    cos, sin = rope_tables(positions)
    cond = jax.nn.silu(c)
    for i in range(DEPTH):
        shift, scale, gate = jnp.split(cond @ ada_w[i] + ada_b[i], 3, axis=-1)
        h = rms_norm(x, norm_g[i]) * (1 + scale[:, None, :]) + shift[:, None, :]
        j = i // N_MIXERS
        if i % N_MIXERS == 0:
            y = nsa_mixer(h, cos, sin, positions, nsa_w_in[j], nsa_w_out[j], nsa_q_norm[j], nsa_k_norm[j],
                          nsa_cmp_pe[j], nsa_cmp_w1[j], nsa_cmp_b1[j], nsa_cmp_w2[j], nsa_gate_b[j])
        else:
            y = moba_mixer(h, cos, sin, moba_w_in[j], moba_w_out[j], moba_q_norm[j], moba_k_norm[j])
        x = x + gate[:, None, :] * y
    return x
```

```cpp
#include <hip/hip_runtime.h>
#include <hip/hip_cooperative_groups.h>
#include <cstdio>
namespace cg = cooperative_groups;

#ifndef MULTI_LAUNCH
#define MULTI_LAUNCH 1
#endif

#define DI __device__ __forceinline__
typedef unsigned short bf16_t;
using bf16x8 = __attribute__((ext_vector_type(8))) short;
using f32x4 = __attribute__((ext_vector_type(4))) float;
typedef __bf16 bf16x2_t __attribute__((ext_vector_type(2)));
typedef float f32x2_t __attribute__((ext_vector_type(2)));
using u32x4 = __attribute__((ext_vector_type(4))) unsigned;
using u32x2 = __attribute__((ext_vector_type(2))) unsigned;

constexpr int DM = 1024, NB = 16, SEQ = 2048, NTOK = NB * SEQ;
constexpr int NSA_IN = 3632, NSA_NP = 3712, MOBA_IN = 2560;
constexpr float EPS = 1e-6f;
constexpr float QSCALE = 0.125f * 1.4426950408889634f;
constexpr float NEG = -1e30f;

constexpr size_t SZ_WT_NSA_IN = (size_t)2 * NSA_NP * 1024 * 2;
constexpr size_t SZ_WT_SQ = (size_t)2 * 1024 * 1024 * 2;
constexpr size_t SZ_WT_MOBA_IN = (size_t)2 * MOBA_IN * 1024 * 2;
constexpr size_t SZ_WT_CMP1 = (size_t)4 * 256 * 2048 * 2;
constexpr size_t SZ_ACT = (size_t)NTOK * 1024 * 2;
constexpr size_t SZ_KV = (size_t)NTOK * 256 * 2;
constexpr size_t OFF_WT_NSA_IN = 0;
constexpr size_t OFF_WT_NSA_OUT = OFF_WT_NSA_IN + SZ_WT_NSA_IN;
constexpr size_t OFF_WT_MOBA_IN = OFF_WT_NSA_OUT + SZ_WT_SQ;
constexpr size_t OFF_WT_MOBA_OUT = OFF_WT_MOBA_IN + SZ_WT_MOBA_IN;
constexpr size_t OFF_WT_CMP1 = OFF_WT_MOBA_OUT + SZ_WT_SQ;
constexpr size_t OFF_B1EFF = OFF_WT_CMP1 + SZ_WT_CMP1;
constexpr size_t OFF_ROPE = OFF_B1EFF + 4096;
constexpr size_t OFF_MOD = OFF_ROPE + (size_t)NTOK * 16 * 4;
constexpr size_t OFF_H = OFF_MOD + (size_t)4 * 16 * 3072 * 4;
constexpr size_t OFF_Q = OFF_H + SZ_ACT;
constexpr size_t OFF_SZ = OFF_Q + SZ_ACT;
constexpr size_t OFF_KC = OFF_SZ + SZ_ACT;
constexpr size_t OFF_VC = OFF_KC + SZ_KV;
constexpr size_t OFF_KS = OFF_VC + SZ_KV;
constexpr size_t OFF_KW = OFF_KS + SZ_KV;
constexpr size_t OFF_VST = OFF_KW + SZ_KV;
constexpr size_t OFF_VWT = OFF_VST + SZ_KV;
constexpr size_t OFF_GATES = OFF_VWT + SZ_KV;
constexpr size_t OFF_HID = OFF_GATES + (size_t)NTOK * 48 * 4;
constexpr size_t OFF_KCMP = OFF_HID + (size_t)2 * 8192 * 256 * 2;
constexpr size_t OFF_VCMPT = OFF_KCMP + (size_t)64 * 128 * 64 * 2;
constexpr size_t OFF_KMEAN = OFF_VCMPT + (size_t)64 * 128 * 64 * 2;
constexpr size_t WS_TOTAL = OFF_KMEAN + (size_t)64 * 16 * 64 * 2;

struct Params {
  const float *x, *c;
  const int* pos;
  const float *norm_g, *ada_w, *ada_b, *nsa_w_in, *nsa_w_out, *nsa_qn, *nsa_kn, *cmp_pe, *cmp_w1, *cmp_b1, *cmp_w2, *gate_b,
      *moba_w_in, *moba_w_out, *moba_qn, *moba_kn;
  float* out;
  char* ws;
};

constexpr int SMEM_BYTES = 73728;

DI unsigned pack_bf2(float a, float b) {
  f32x2_t v = {a, b};
  bf16x2_t r = __builtin_convertvector(v, bf16x2_t);
  return __builtin_bit_cast(unsigned, r);
}
DI float bf2f(bf16_t v) { return __uint_as_float(((unsigned)v) << 16); }
DI float bflo(unsigned u) { return __uint_as_float(u << 16); }
DI float bfhi(unsigned u) { return __uint_as_float(u & 0xffff0000u); }
DI f32x4 mfma16(bf16x8 a, bf16x8 b, f32x4 c) { return __builtin_amdgcn_mfma_f32_16x16x32_bf16(a, b, c, 0, 0, 0); }
DI float fexp2(float x) { return __builtin_amdgcn_exp2f(x); }
DI float sigmoidf_(float x) { return 1.f / (1.f + __expf(-x)); }
DI float siluf_(float x) { return x / (1.f + __expf(-x)); }
DI float geluf_(float x) {
  float u = 0.7978845608028654f * (x + 0.044715f * x * x * x);
  float t = 1.f - 2.f / (__expf(2.f * u) + 1.f);
  return 0.5f * x * (1.f + t);
}

DI void ada_item(const Params& p, int item, char* smem) {
  const int tid = threadIdx.x;
  const int l = item / 48, n0 = (item % 48) * 64;
  float* cond = (float*)smem;
  __syncthreads();
  for (int i = tid; i < 16 * 1024; i += 256) {
    int b = i >> 10, k = i & 1023;
    float v = p.c[i];
    cond[k * 16 + b] = siluf_(v);
  }
  __syncthreads();
  const int kq = tid >> 6, col = tid & 63;
  float acc[16];
#pragma unroll
  for (int b = 0; b < 16; ++b) acc[b] = 0.f;
  const float* w = p.ada_w + (size_t)l * 1024 * 3072 + n0 + col;
#pragma unroll 4
  for (int k = kq * 256; k < kq * 256 + 256; ++k) {
    float wv = w[(size_t)k * 3072];
    const float4* cp = (const float4*)(cond + k * 16);
    float4 c0 = cp[0], c1 = cp[1], c2 = cp[2], c3 = cp[3];
    acc[0] += wv * c0.x; acc[1] += wv * c0.y; acc[2] += wv * c0.z; acc[3] += wv * c0.w;
    acc[4] += wv * c1.x; acc[5] += wv * c1.y; acc[6] += wv * c1.z; acc[7] += wv * c1.w;
    acc[8] += wv * c2.x; acc[9] += wv * c2.y; acc[10] += wv * c2.z; acc[11] += wv * c2.w;
    acc[12] += wv * c3.x; acc[13] += wv * c3.y; acc[14] += wv * c3.z; acc[15] += wv * c3.w;
  }
  __syncthreads();
  float* red = (float*)smem;
#pragma unroll
  for (int b = 0; b < 16; ++b) red[(kq * 16 + b) * 64 + col] = acc[b];
  __syncthreads();
  float* mod = (float*)(p.ws + OFF_MOD);
  for (int i = tid; i < 16 * 64; i += 256) {
    int b = i >> 6, cc = i & 63;
    float s = red[(0 * 16 + b) * 64 + cc] + red[(16 + b) * 64 + cc] + red[(32 + b) * 64 + cc] + red[(48 + b) * 64 + cc];
    mod[(size_t)(l * 16 + b) * 3072 + n0 + cc] = s + p.ada_b[l * 3072 + n0 + cc];
  }
}

DI void b1eff_item(const Params& p, int item, char* smem) {
  const int tid = threadIdx.x;
  const int li = item >> 4, h0 = (item & 15) * 16;
  const int kg = tid >> 4, hh = tid & 15;
  const float* W1 = p.cmp_w1 + (size_t)li * 2048 * 256;
  const float* pe = p.cmp_pe + li * 2048;
  float acc = 0.f;
#pragma unroll 8
  for (int k = kg * 128; k < kg * 128 + 128; ++k) acc += pe[k] * W1[(size_t)k * 256 + h0 + hh];
  float* red = (float*)smem;
  __syncthreads();
  red[kg * 16 + hh] = acc;
  __syncthreads();
  if (tid < 16) {
    float s = 0.f;
    for (int g = 0; g < 16; ++g) s += red[g * 16 + tid];
    ((float*)(p.ws + OFF_B1EFF))[li * 256 + h0 + tid] = s + p.cmp_b1[li * 256 + h0 + tid];
  }
}

DI void rope_item(const Params& p, int item) {
  const int idx = item * 256 + threadIdx.x;
  const int tok = idx >> 3, i = idx & 7;
  const float invf[8] = {1.0f, 0.1939227432012558f, 0.03760603070259094f, 0.007292664609849453f,
                         0.0014142135623842478f, 0.00027424818836152554f, 5.318296098266728e-05f, 1.0313386155758053e-05f};
  float f = i == 0 ? invf[0] : i == 1 ? invf[1] : i == 2 ? invf[2] : i == 3 ? invf[3] : i == 4 ? invf[4] : i == 5 ? invf[5] : i == 6 ? invf[6] : invf[7];
  float ang = (float)p.pos[tok] * f;
  double rev = (double)ang * 0.15915494309189535;
  double fr = rev - floor(rev);
  float frf = (float)fr;
  float* rope = (float*)(p.ws + OFF_ROPE);
  rope[(size_t)tok * 16 + i] = __builtin_amdgcn_cosf(frf);
  rope[(size_t)tok * 16 + 8 + i] = __builtin_amdgcn_sinf(frf);
}

DI void transpose_item(const float* __restrict__ src, int K, int Nsrc, bf16_t* __restrict__ dst, int k0, int n0, int mapmode, char* smem) {
  float* tile = (float*)smem;
  const int tid = threadIdx.x;
  __syncthreads();
#pragma unroll 4
  for (int i = 0; i < 16; ++i) {
    int kk = i * 4 + (tid >> 6), nn = tid & 63;
    int nd = n0 + nn, ns = nd;
    if (mapmode == 1) ns = nd < 2560 ? nd : (nd < 3584 ? nd + 48 : (nd < 3632 ? nd - 1024 : -1));
    float v = ns >= 0 ? src[(size_t)(k0 + kk) * Nsrc + ns] : 0.f;
    tile[kk * 65 + nn] = v;
  }
  __syncthreads();
#pragma unroll 4
  for (int i = 0; i < 16; ++i) {
    int nn = i * 4 + (tid >> 6), kk = tid & 63;
    float v = tile[kk * 65 + nn];
    unsigned u = pack_bf2(v, 0.f);
    dst[(size_t)(n0 + nn) * K + k0 + kk] = (bf16_t)(u & 0xffff);
  }
}

constexpr int NW_ADA = 192, NW_B1 = 64, NW_ROPE = 1024;
constexpr int NW_T_NSA_IN = 16 * 58, NW_T_SQ = 256, NW_T_MOBA_IN = 16 * 40, NW_T_CMP = 128;
constexpr int NW_TRANS = 2 * NW_T_NSA_IN + 2 * NW_T_SQ + 2 * NW_T_MOBA_IN + 2 * NW_T_SQ + 4 * NW_T_CMP;
constexpr int NW_TOTAL = NW_ADA + NW_B1 + NW_ROPE + NW_TRANS;

DI void phaseW_item(const Params& p, int it, char* smem) {
  if (it < NW_ADA) { ada_item(p, it, smem); return; }
  it -= NW_ADA;
  if (it < NW_B1) { b1eff_item(p, it, smem); return; }
  it -= NW_B1;
  if (it < NW_ROPE) { rope_item(p, it); return; }
  it -= NW_ROPE;
  if (it < 2 * NW_T_NSA_IN) {
    int l = it / NW_T_NSA_IN, t = it % NW_T_NSA_IN;
    transpose_item(p.nsa_w_in + (size_t)l * 1024 * NSA_IN, 1024, NSA_IN, (bf16_t*)(p.ws + OFF_WT_NSA_IN) + (size_t)l * NSA_NP * 1024,
                   (t % 16) * 64, (t / 16) * 64, 1, smem);
    return;
  }
  it -= 2 * NW_T_NSA_IN;
  if (it < 2 * NW_T_SQ) {
    int l = it / NW_T_SQ, t = it % NW_T_SQ;
    transpose_item(p.nsa_w_out + (size_t)l * 1024 * 1024, 1024, 1024, (bf16_t*)(p.ws + OFF_WT_NSA_OUT) + (size_t)l * 1024 * 1024,
                   (t % 16) * 64, (t / 16) * 64, 0, smem);
    return;
  }
  it -= 2 * NW_T_SQ;
  if (it < 2 * NW_T_MOBA_IN) {
    int l = it / NW_T_MOBA_IN, t = it % NW_T_MOBA_IN;
    transpose_item(p.moba_w_in + (size_t)l * 1024 * MOBA_IN, 1024, MOBA_IN, (bf16_t*)(p.ws + OFF_WT_MOBA_IN) + (size_t)l * MOBA_IN * 1024,
                   (t % 16) * 64, (t / 16) * 64, 0, smem);
    return;
  }
  it -= 2 * NW_T_MOBA_IN;
  if (it < 2 * NW_T_SQ) {
    int l = it / NW_T_SQ, t = it % NW_T_SQ;
    transpose_item(p.moba_w_out + (size_t)l * 1024 * 1024, 1024, 1024, (bf16_t*)(p.ws + OFF_WT_MOBA_OUT) + (size_t)l * 1024 * 1024,
                   (t % 16) * 64, (t / 16) * 64, 0, smem);
    return;
  }
  it -= 2 * NW_T_SQ;
  {
    int li = it / NW_T_CMP, t = it % NW_T_CMP;
    transpose_item(p.cmp_w1 + (size_t)li * 2048 * 256, 2048, 256, (bf16_t*)(p.ws + OFF_WT_CMP1) + (size_t)li * 256 * 2048,
                   (t % 32) * 64, (t / 32) * 64, 0, smem);
  }
}

DI void prep_item(const Params& p, int layer, const float* __restrict__ xin, int item) {
  const int lane = threadIdx.x & 63, w = threadIdx.x >> 6;
  const int tok = item * 4 + w;
  const int b = tok >> 11;
  const float4* xr = (const float4*)(xin + (size_t)tok * 1024);
  float4 v[4];
  float ss = 0.f;
#pragma unroll
  for (int i = 0; i < 4; ++i) {
    v[i] = xr[lane + i * 64];
    ss += v[i].x * v[i].x + v[i].y * v[i].y + v[i].z * v[i].z + v[i].w * v[i].w;
  }
#pragma unroll
  for (int o = 32; o >= 1; o >>= 1) ss += __shfl_xor(ss, o);
  const float rstd = __builtin_amdgcn_rsqf(ss * (1.f / 1024.f) + EPS);
  const float* mod = (const float*)(p.ws + OFF_MOD) + (size_t)(layer * 16 + b) * 3072;
  const float4* g4 = (const float4*)(p.norm_g + layer * 1024);
  const float4* sh4 = (const float4*)(mod);
  const float4* sc4 = (const float4*)(mod + 1024);
  u32x2* hr = (u32x2*)((bf16_t*)(p.ws + OFF_H) + (size_t)tok * 1024);
#pragma unroll
  for (int i = 0; i < 4; ++i) {
    int c = lane + i * 64;
    float4 g = g4[c], sh = sh4[c], sc = sc4[c];
    float a0 = v[i].x * rstd * g.x * (1.f + sc.x) + sh.x;
    float a1 = v[i].y * rstd * g.y * (1.f + sc.y) + sh.y;
    float a2 = v[i].z * rstd * g.z * (1.f + sc.z) + sh.z;
    float a3 = v[i].w * rstd * g.w * (1.f + sc.w) + sh.w;
    u32x2 o;
    o.x = pack_bf2(a0, a1);
    o.y = pack_bf2(a2, a3);
    hr[c] = o;
  }
}

template <bool SWAP>
DI void gemm_mainloop(const bf16_t* __restrict__ A, const unsigned (&aoff)[4], int a_kstride, const bf16_t* __restrict__ Bt, int K, int n0,
                      char* smem, f32x4 (&acc)[4][4]) {
  bf16_t* sA = (bf16_t*)smem;
  bf16_t* sB = (bf16_t*)(smem + 36864);
  const int tid = threadIdx.x, lane = tid & 63, w = tid >> 6;
  const int wm = w >> 1, wn = w & 1, c16 = lane & 15, lg = lane >> 4;
  const int r0 = tid >> 3, c8 = tid & 7;
  const int nk = K >> 6;
  u32x4 ra[4], rb[4];
  const bf16_t* bbase = Bt + (size_t)(n0 + r0) * K + c8 * 8;
#pragma unroll
  for (int i = 0; i < 4; ++i) {
    ra[i] = *(const u32x4*)(A + aoff[i] + c8 * 8);
    rb[i] = *(const u32x4*)(bbase + (size_t)i * 32 * K);
  }
#pragma unroll
  for (int a = 0; a < 4; ++a)
#pragma unroll
    for (int b = 0; b < 4; ++b) acc[a][b] = f32x4{0.f, 0.f, 0.f, 0.f};
  __syncthreads();
  for (int kt = 0; kt < nk; ++kt) {
    const int buf = kt & 1;
    bf16_t* cA = sA + buf * (128 * 72);
    bf16_t* cB = sB + buf * (128 * 72);
#pragma unroll
    for (int i = 0; i < 4; ++i) {
      *(u32x4*)(cA + (r0 + 32 * i) * 72 + c8 * 8) = ra[i];
      *(u32x4*)(cB + (r0 + 32 * i) * 72 + c8 * 8) = rb[i];
    }
    __syncthreads();
    if (kt + 1 < nk) {
#pragma unroll
      for (int i = 0; i < 4; ++i) {
        ra[i] = *(const u32x4*)(A + aoff[i] + (size_t)(kt + 1) * a_kstride + c8 * 8);
        rb[i] = *(const u32x4*)(bbase + (size_t)i * 32 * K + (kt + 1) * 64);
      }
    }
#pragma unroll
    for (int ks = 0; ks < 2; ++ks) {
      bf16x8 af[4], bfr[4];
#pragma unroll
      for (int mt = 0; mt < 4; ++mt) af[mt] = *(const bf16x8*)(cA + (wm * 64 + mt * 16 + c16) * 72 + ks * 32 + lg * 8);
#pragma unroll
      for (int nt = 0; nt < 4; ++nt) bfr[nt] = *(const bf16x8*)(cB + (wn * 64 + nt * 16 + c16) * 72 + ks * 32 + lg * 8);
#pragma unroll
      for (int mt = 0; mt < 4; ++mt)
#pragma unroll
        for (int nt = 0; nt < 4; ++nt) {
          if (SWAP) acc[nt][mt] = mfma16(bfr[nt], af[mt], acc[nt][mt]);
          else acc[mt][nt] = mfma16(af[mt], bfr[nt], acc[mt][nt]);
        }
    }
  }
}

DI void epi_normrope(f32x4 (&acc)[4][4], int m_base  , int ncol_base  ,
                     bf16_t* __restrict__ dst, int ld, const float* __restrict__ gw, const float* __restrict__ rope, float oscale) {
  const int lane = threadIdx.x & 63, c16 = lane & 15, lg = lane >> 4;
  float gwv[4][4];
#pragma unroll
  for (int nt = 0; nt < 4; ++nt)
#pragma unroll
    for (int j = 0; j < 4; ++j) gwv[nt][j] = gw[nt * 16 + lg * 4 + j];
#pragma unroll
  for (int mt = 0; mt < 4; ++mt) {
    const int m = m_base + mt * 16 + c16;
    float ss = 0.f;
#pragma unroll
    for (int nt = 0; nt < 4; ++nt)
#pragma unroll
      for (int j = 0; j < 4; ++j) ss += acc[nt][mt][j] * acc[nt][mt][j];
    ss += __shfl_xor(ss, 16);
    ss += __shfl_xor(ss, 32);
    const float rstd = __builtin_amdgcn_rsqf(ss * (1.f / 64.f) + EPS);
    float v[4][4];
#pragma unroll
    for (int nt = 0; nt < 4; ++nt)
#pragma unroll
      for (int j = 0; j < 4; ++j) v[nt][j] = acc[nt][mt][j] * rstd * gwv[nt][j];
    const float4 cs = *(const float4*)(rope + (size_t)m * 16 + (lg & 1) * 4);
    const float4 sn = *(const float4*)(rope + (size_t)m * 16 + 8 + (lg & 1) * 4);
    const float csv[4] = {cs.x, cs.y, cs.z, cs.w};
    const float snv[4] = {sn.x, sn.y, sn.z, sn.w};
#pragma unroll
    for (int j = 0; j < 4; ++j) {
      float mine = v[0][j];
      float other = __shfl_xor(mine, 32);
      float r = (lg < 2) ? (mine * csv[j] - other * snv[j]) : (mine * csv[j] + other * snv[j]);
      v[0][j] = r;
    }
#pragma unroll
    for (int nt = 0; nt < 4; ++nt) {
      u32x2 o;
      o.x = pack_bf2(v[nt][0] * oscale, v[nt][1] * oscale);
      o.y = pack_bf2(v[nt][2] * oscale, v[nt][3] * oscale);
      *(u32x2*)(dst + (size_t)m * ld + ncol_base + nt * 16 + lg * 4) = o;
    }
  }
}

template <int MODE>
DI void epi_store_bf16(f32x4 (&acc)[4][4], int m_base, int ncol_base, bf16_t* __restrict__ dst, int ld, const float* __restrict__ bias) {
  const int lane = threadIdx.x & 63, c16 = lane & 15, lg = lane >> 4;
#pragma unroll
  for (int mt = 0; mt < 4; ++mt) {
    const int m = m_base + mt * 16 + c16;
#pragma unroll
    for (int nt = 0; nt < 4; ++nt) {
      float v[4];
#pragma unroll
      for (int j = 0; j < 4; ++j) {
        float a = acc[nt][mt][j];
        if (MODE == 1) a = siluf_(a);
        if (MODE == 2) a = geluf_(a + bias[ncol_base + nt * 16 + lg * 4 + j]);
        v[j] = a;
      }
      u32x2 o;
      o.x = pack_bf2(v[0], v[1]);
      o.y = pack_bf2(v[2], v[3]);
      *(u32x2*)(dst + (size_t)m * ld + ncol_base + nt * 16 + lg * 4) = o;
    }
  }
}

DI void epi_store_vt(f32x4 (&acc)[4][4], int m_base, int col_base, bf16_t* __restrict__ vt) {
  const int lane = threadIdx.x & 63, c16 = lane & 15, lg = lane >> 4;
#pragma unroll
  for (int mt = 0; mt < 4; ++mt) {
    const int m = m_base + mt * 16 + lg * 4;
    const int b = m >> 11, s = m & 2047;
#pragma unroll
    for (int nt = 0; nt < 4; ++nt) {
      const int col = col_base + nt * 16 + c16;
      const int gh = col >> 6, d = col & 63;
      u32x2 o;
      o.x = pack_bf2(acc[mt][nt][0], acc[mt][nt][1]);
      o.y = pack_bf2(acc[mt][nt][2], acc[mt][nt][3]);
      *(u32x2*)(vt + ((size_t)((b * 4 + gh) * 64 + d)) * 2048 + s) = o;
    }
  }
}

DI void inproj_tile(const Params& p, int layer, int tile, char* smem) {
  const bool nsa = (layer & 1) == 0;
  const int lj = layer >> 1;
  const int NT = nsa ? 29 : 20;
  const int mtile = tile / NT, ntile = tile % NT;
  const int m0 = mtile * 128, n0 = ntile * 128;
  const int tid = threadIdx.x, w = tid >> 6, wm = w >> 1, wn = w & 1;
  const bf16_t* A = (const bf16_t*)(p.ws + OFF_H);
  const bf16_t* Bt = nsa ? (const bf16_t*)(p.ws + OFF_WT_NSA_IN) + (size_t)lj * NSA_NP * 1024
                         : (const bf16_t*)(p.ws + OFF_WT_MOBA_IN) + (size_t)lj * MOBA_IN * 1024;
  unsigned aoff[4];
#pragma unroll
  for (int i = 0; i < 4; ++i) aoff[i] = (unsigned)(m0 + (tid >> 3) + 32 * i) * 1024u;
  int type;
  bf16_t* dst = nullptr;
  int ld = 0, coff = 0;
  const float* gw = nullptr;
  if (nsa) {
    if (ntile < 8) { type = 0; dst = (bf16_t*)(p.ws + OFF_Q); ld = 1024; coff = n0; gw = p.nsa_qn + lj * 64; }
    else if (ntile < 10) { type = 2; dst = (bf16_t*)(p.ws + OFF_KC); ld = 256; coff = n0 - 1024; }
    else if (ntile < 12) { type = 2; dst = (bf16_t*)(p.ws + OFF_VC); ld = 256; coff = n0 - 1280; }
    else if (ntile < 14) { type = 1; dst = (bf16_t*)(p.ws + OFF_KS); ld = 256; coff = n0 - 1536; gw = p.nsa_kn + (lj * 3 + 1) * 64; }
    else if (ntile < 16) { type = 3; dst = (bf16_t*)(p.ws + OFF_VST); coff = n0 - 1792; }
    else if (ntile < 18) { type = 1; dst = (bf16_t*)(p.ws + OFF_KW); ld = 256; coff = n0 - 2048; gw = p.nsa_kn + (lj * 3 + 2) * 64; }
    else if (ntile < 20) { type = 3; dst = (bf16_t*)(p.ws + OFF_VWT); coff = n0 - 2304; }
    else if (ntile < 28) { type = 4; dst = (bf16_t*)(p.ws + OFF_SZ); ld = 1024; coff = n0 - 2560; }
    else { type = 5; }
  } else {
    if (ntile < 8) { type = 0; dst = (bf16_t*)(p.ws + OFF_Q); ld = 1024; coff = n0; gw = p.moba_qn + lj * 64; }
    else if (ntile < 10) { type = 1; dst = (bf16_t*)(p.ws + OFF_KS); ld = 256; coff = n0 - 1024; gw = p.moba_kn + lj * 64; }
    else if (ntile < 12) { type = 3; dst = (bf16_t*)(p.ws + OFF_VST); coff = n0 - 1280; }
    else { type = 4; dst = (bf16_t*)(p.ws + OFF_SZ); ld = 1024; coff = n0 - 1536; }
  }
  f32x4 acc[4][4];
  const float* rope = (const float*)(p.ws + OFF_ROPE);
  const int m_base = m0 + wm * 64;
  if (type == 3) {
    gemm_mainloop<false>(A, aoff, 64, Bt, 1024, n0, smem, acc);
    epi_store_vt(acc, m_base, coff + wn * 64, dst);
  } else {
    gemm_mainloop<true>(A, aoff, 64, Bt, 1024, n0, smem, acc);
    if (type == 0) epi_normrope(acc, m_base, coff + wn * 64, dst, ld, gw, rope, QSCALE);
    else if (type == 1) epi_normrope(acc, m_base, coff + wn * 64, dst, ld, gw, rope, 1.0f);
    else if (type == 2) epi_store_bf16<0>(acc, m_base, coff + wn * 64, dst, ld, nullptr);
    else if (type == 4) epi_store_bf16<1>(acc, m_base, coff + wn * 64, dst, ld, nullptr);
    else {
      const int lane = tid & 63, c16 = lane & 15, lg = lane >> 4;
      float* gates = (float*)(p.ws + OFF_GATES);
      const float* gb = p.gate_b + lj * 48;
      if (wn == 0) {
#pragma unroll
        for (int mt = 0; mt < 4; ++mt) {
          const int m = m_base + mt * 16 + c16;
#pragma unroll
          for (int nt = 0; nt < 3; ++nt) {
            const int nl = nt * 16 + lg * 4;
            float4 o;
            o.x = sigmoidf_(acc[nt][mt][0] + gb[nl + 0]);
            o.y = sigmoidf_(acc[nt][mt][1] + gb[nl + 1]);
            o.z = sigmoidf_(acc[nt][mt][2] + gb[nl + 2]);
            o.w = sigmoidf_(acc[nt][mt][3] + gb[nl + 3]);
            *(float4*)(gates + (size_t)m * 48 + nl) = o;
          }
        }
      }
    }
  }
}

DI void cmp1_tile(const Params& p, int lj, int tile, char* smem) {
  const int i = tile >> 7, t = tile & 127;
  const int mtile = t >> 1, ntile = t & 1;
  const int m0 = mtile * 128, n0 = ntile * 128;
  const int tid = threadIdx.x, w = tid >> 6, wm = w >> 1, wn = w & 1;
  const bf16_t* A = (const bf16_t*)(p.ws + (i == 0 ? OFF_KC : OFF_VC));
  const bf16_t* Bt = (const bf16_t*)(p.ws + OFF_WT_CMP1) + (size_t)(lj * 2 + i) * 256 * 2048;
  unsigned aoff[4];
#pragma unroll
  for (int q = 0; q < 4; ++q) {
    int m = m0 + (tid >> 3) + 32 * q;
    int g = m & 3, n = (m >> 2) & 127, b = m >> 9;
    if (n > 126) n = 126;
    aoff[q] = (unsigned)((b * 2048 + 16 * n) * 256 + g * 64);
  }
  f32x4 acc[4][4];
  gemm_mainloop<true>(A, aoff, 256, Bt, 2048, n0, smem, acc);
  bf16_t* hid = (bf16_t*)(p.ws + OFF_HID) + (size_t)i * 8192 * 256;
  const float* b1 = (const float*)(p.ws + OFF_B1EFF) + (lj * 2 + i) * 256;
  epi_store_bf16<2>(acc, m0 + wm * 64, n0 + wn * 64, hid, 256, b1);
}

DI void cmp2_item(const Params& p, int lj, int item, char* smem) {
  const int tid = threadIdx.x;
  const int i = item >> 7, rt = item & 127;
  float* w2s = (float*)smem;
  const float* W2 = p.cmp_w2 + (size_t)(lj * 2 + i) * 256 * 64;
  __syncthreads();
  for (int q = tid; q < 256 * 64 / 4; q += 256) ((float4*)w2s)[q] = ((const float4*)W2)[q];
  __syncthreads();
  const int row = tid >> 2, cq = tid & 3;
  const int m = rt * 64 + row;
  const bf16_t* hid = (const bf16_t*)(p.ws + OFF_HID) + ((size_t)i * 8192 + m) * 256;
  float acc[16];
#pragma unroll
  for (int d = 0; d < 16; ++d) acc[d] = 0.f;
  for (int k8 = 0; k8 < 32; ++k8) {
    u32x4 hv = *(const u32x4*)(hid + k8 * 8);
    float hf[8] = {bflo(hv.x), bfhi(hv.x), bflo(hv.y), bfhi(hv.y), bflo(hv.z), bfhi(hv.z), bflo(hv.w), bfhi(hv.w)};
#pragma unroll
    for (int kk = 0; kk < 8; ++kk) {
      const float4* wr = (const float4*)(w2s + (k8 * 8 + kk) * 64 + cq * 16);
      float4 w0 = wr[0], w1 = wr[1], w2 = wr[2], w3 = wr[3];
      float h = hf[kk];
      acc[0] += h * w0.x; acc[1] += h * w0.y; acc[2] += h * w0.z; acc[3] += h * w0.w;
      acc[4] += h * w1.x; acc[5] += h * w1.y; acc[6] += h * w1.z; acc[7] += h * w1.w;
      acc[8] += h * w2.x; acc[9] += h * w2.y; acc[10] += h * w2.z; acc[11] += h * w2.w;
      acc[12] += h * w3.x; acc[13] += h * w3.y; acc[14] += h * w3.z; acc[15] += h * w3.w;
    }
  }
  const int g = m & 3, n = (m >> 2) & 127, b = m >> 9;
  const bool valid = n < 127;
  if (i == 0) {
    float ss = 0.f;
#pragma unroll
    for (int d = 0; d < 16; ++d) ss += acc[d] * acc[d];
    ss += __shfl_xor(ss, 1);
    ss += __shfl_xor(ss, 2);
    const float rstd = __builtin_amdgcn_rsqf(ss * (1.f / 64.f) + EPS);
    const float* gw = p.nsa_kn + (lj * 3 + 0) * 64 + cq * 16;
#pragma unroll
    for (int d = 0; d < 16; ++d) acc[d] = acc[d] * rstd * gw[d];
    if (cq == 0) {
      const int tokc = b * 2048 + (valid ? 16 * n + 31 : 2047);
      const float* rp = (const float*)(p.ws + OFF_ROPE) + (size_t)tokc * 16;
#pragma unroll
      for (int d = 0; d < 8; ++d) {
        float c = rp[d], s = rp[8 + d];
        float x1 = acc[d], x2 = acc[d + 8];
        acc[d] = x1 * c - x2 * s;
        acc[d + 8] = x2 * c + x1 * s;
      }
    }
    bf16_t* dst = (bf16_t*)(p.ws + OFF_KCMP) + ((size_t)((b * 4 + g) * 128 + n)) * 64 + cq * 16;
    u32x4 o0, o1;
    if (valid) {
      o0.x = pack_bf2(acc[0], acc[1]); o0.y = pack_bf2(acc[2], acc[3]); o0.z = pack_bf2(acc[4], acc[5]); o0.w = pack_bf2(acc[6], acc[7]);
      o1.x = pack_bf2(acc[8], acc[9]); o1.y = pack_bf2(acc[10], acc[11]); o1.z = pack_bf2(acc[12], acc[13]); o1.w = pack_bf2(acc[14], acc[15]);
    } else {
      o0 = u32x4{0u, 0u, 0u, 0u}; o1 = o0;
    }
    *(u32x4*)(dst) = o0;
    *(u32x4*)(dst + 8) = o1;
  } else {
    bf16_t* dst = (bf16_t*)(p.ws + OFF_VCMPT) + ((size_t)((b * 4 + g) * 64 + cq * 16)) * 128 + n;
#pragma unroll
    for (int d = 0; d < 16; ++d) {
      unsigned u = pack_bf2(valid ? acc[d] : 0.f, 0.f);
      dst[(size_t)d * 128] = (bf16_t)(u & 0xffff);
    }
  }
}

DI void kmean_item(const Params& p, int item, char* smem) {
  const int tid = threadIdx.x;
  const int blk = item & 7, g = (item >> 3) & 3, b = item >> 5;
  const int d8 = tid & 7, rg = tid >> 3;
  const bf16_t* K = (const bf16_t*)(p.ws + OFF_KS) + ((size_t)(b * 2048 + blk * 256)) * 256 + g * 64 + d8 * 8;
  float s[8];
#pragma unroll
  for (int q = 0; q < 8; ++q) s[q] = 0.f;
#pragma unroll
  for (int r = 0; r < 8; ++r) {
    u32x4 v = *(const u32x4*)(K + (size_t)(rg + 32 * r) * 256);
    s[0] += bflo(v.x); s[1] += bfhi(v.x); s[2] += bflo(v.y); s[3] += bfhi(v.y);
    s[4] += bflo(v.z); s[5] += bfhi(v.z); s[6] += bflo(v.w); s[7] += bfhi(v.w);
  }
  float* red = (float*)smem;
  __syncthreads();
#pragma unroll
  for (int q = 0; q < 8; ++q) red[rg * 64 + d8 * 8 + q] = s[q];
  __syncthreads();
  if (tid < 64) {
    float t = 0.f;
    for (int r = 0; r < 32; ++r) t += red[r * 64 + tid];
    bf16_t* km = (bf16_t*)(p.ws + OFF_KMEAN) + (size_t)((b * 4 + g) * 16) * 64;
    km[blk * 64 + tid] = (bf16_t)(pack_bf2(t * (1.f / 256.f), 0.f) & 0xffff);
    km[(8 + blk) * 64 + tid] = 0;
  }
}

template <bool NOMASK>
DI void attn_block64(const bf16_t* __restrict__ Ks, const bf16_t* __restrict__ Vs, const bf16x8 (&Qb)[2][2], f32x4 (&O)[4][2], float (&mrun)[2],
                     float (&lrun)[2], const int (&lo)[2], const int (&hi)[2]) {
  const int lane = threadIdx.x & 63, c16 = lane & 15, lg = lane >> 4;
  f32x4 Sx[4][2];
#pragma unroll
  for (int kt = 0; kt < 4; ++kt) {
    Sx[kt][0] = f32x4{0.f, 0.f, 0.f, 0.f};
    Sx[kt][1] = f32x4{0.f, 0.f, 0.f, 0.f};
#pragma unroll
    for (int ks = 0; ks < 2; ++ks) {
      bf16x8 a = *(const bf16x8*)(Ks + (kt * 16 + c16) * 72 + ks * 32 + lg * 8);
      Sx[kt][0] = mfma16(a, Qb[0][ks], Sx[kt][0]);
      Sx[kt][1] = mfma16(a, Qb[1][ks], Sx[kt][1]);
    }
  }
#pragma unroll
  for (int ct = 0; ct < 2; ++ct) {
    float mx = NEG;
#pragma unroll
    for (int kt = 0; kt < 4; ++kt)
#pragma unroll
      for (int j = 0; j < 4; ++j) {
        float s = Sx[kt][ct][j];
        if (!NOMASK) {
          const int idx = kt * 16 + j;
          s = (idx > lo[ct] && idx <= hi[ct]) ? s : NEG;
          Sx[kt][ct][j] = s;
        }
        mx = fmaxf(mx, s);
      }
    mx = fmaxf(mx, __shfl_xor(mx, 16));
    mx = fmaxf(mx, __shfl_xor(mx, 32));
    const float mn = fmaxf(mrun[ct], mx);
    const float alpha = fexp2(mrun[ct] - mn);
    mrun[ct] = mn;
    const float msafe = mn < -1e29f ? 0.f : mn;
    float rs = 0.f;
#pragma unroll
    for (int kt = 0; kt < 4; ++kt)
#pragma unroll
      for (int j = 0; j < 4; ++j) {
        float pv = fexp2(Sx[kt][ct][j] - msafe);
        Sx[kt][ct][j] = pv;
        rs += pv;
      }
    lrun[ct] = lrun[ct] * alpha + rs;
#pragma unroll
    for (int dt = 0; dt < 4; ++dt) O[dt][ct] *= alpha;
  }
#pragma unroll
  for (int kp = 0; kp < 2; ++kp) {
    bf16x8 Pb[2];
#pragma unroll
    for (int ct = 0; ct < 2; ++ct) {
      u32x4 u;
      u.x = pack_bf2(Sx[2 * kp][ct][0], Sx[2 * kp][ct][1]);
      u.y = pack_bf2(Sx[2 * kp][ct][2], Sx[2 * kp][ct][3]);
      u.z = pack_bf2(Sx[2 * kp + 1][ct][0], Sx[2 * kp + 1][ct][1]);
      u.w = pack_bf2(Sx[2 * kp + 1][ct][2], Sx[2 * kp + 1][ct][3]);
      Pb[ct] = __builtin_bit_cast(bf16x8, u);
    }
#pragma unroll
    for (int dt = 0; dt < 4; ++dt) {
      u32x2 v0 = *(const u32x2*)(Vs + (dt * 16 + c16) * 72 + kp * 32 + lg * 4);
      u32x2 v1 = *(const u32x2*)(Vs + (dt * 16 + c16) * 72 + kp * 32 + 16 + lg * 4);
      u32x4 u = u32x4{v0.x, v0.y, v1.x, v1.y};
      bf16x8 va = __builtin_bit_cast(bf16x8, u);
      O[dt][0] = mfma16(va, Pb[0], O[dt][0]);
      O[dt][1] = mfma16(va, Pb[1], O[dt][1]);
    }
  }
}

template <int MODE>
DI void attn_range(const bf16_t* __restrict__ Kg, const bf16_t* __restrict__ VTg, int j0, int j1, char* smem, int& buf, const bf16x8 (&Qb)[2][2],
                   f32x4 (&O)[4][2], float (&mrun)[2], float (&lrun)[2], const int (&tq)[2], const unsigned (&selbits)[2], int own) {
  const int tid = threadIdx.x, lane = tid & 63, lg = lane >> 4;
  const int r0 = tid >> 3, c8 = tid & 7;
  bf16_t* sK = (bf16_t*)smem;
  bf16_t* sV = (bf16_t*)(smem + 18432);
  u32x4 rk[2], rv[2];
  if (j0 <= j1) {
#pragma unroll
    for (int i = 0; i < 2; ++i) {
      rk[i] = *(const u32x4*)(Kg + (size_t)(j0 * 64 + r0 + 32 * i) * 256 + c8 * 8);
      rv[i] = *(const u32x4*)(VTg + (size_t)(r0 + 32 * i) * 2048 + j0 * 64 + c8 * 8);
    }
  }
  for (int j = j0; j <= j1; ++j) {
    bf16_t* cK = sK + buf * (64 * 72);
    bf16_t* cV = sV + buf * (64 * 72);
#pragma unroll
    for (int i = 0; i < 2; ++i) {
      *(u32x4*)(cK + (r0 + 32 * i) * 72 + c8 * 8) = rk[i];
      *(u32x4*)(cV + (r0 + 32 * i) * 72 + c8 * 8) = rv[i];
    }
    __syncthreads();
    if (j + 1 <= j1) {
#pragma unroll
      for (int i = 0; i < 2; ++i) {
        rk[i] = *(const u32x4*)(Kg + (size_t)((j + 1) * 64 + r0 + 32 * i) * 256 + c8 * 8);
        rv[i] = *(const u32x4*)(VTg + (size_t)(r0 + 32 * i) * 2048 + (j + 1) * 64 + c8 * 8);
      }
    }
    int lo[2], hi[2];
    const int kb = j * 64;
#pragma unroll
    for (int ct = 0; ct < 2; ++ct) {
      const int rel = tq[ct] - kb - lg * 4;
      if (MODE == 0) {
        hi[ct] = ((selbits[ct] >> j) & 1u) ? (j < j1 ? 1000 : rel) : -1;
        lo[ct] = -1000;
      } else if (MODE == 1) {
        hi[ct] = rel;
        lo[ct] = rel - 256;
      } else {
        const int jb = j >> 2;
        if (jb < own) hi[ct] = ((selbits[ct] >> jb) & 1u) ? 1000 : -1;
        else hi[ct] = (j < j1 ? 1000 : rel);
        lo[ct] = -1000;
      }
    }
    const bool act = (hi[0] >= 0 && lo[0] < 63) || (hi[1] >= 0 && lo[1] < 63);
    if (__any(act)) {
      const bool full = hi[0] >= 63 && lo[0] < 0 && hi[1] >= 63 && lo[1] < 0;
      if (__all(full)) attn_block64<true>(cK, cV, Qb, O, mrun, lrun, lo, hi);
      else attn_block64<false>(cK, cV, Qb, O, mrun, lrun, lo, hi);
    }
    buf ^= 1;
  }
}

DI void load_q(const Params& p, int b, int g, int tw  , bf16x8 (&Qb)[2][2]) {
  const int lane = threadIdx.x & 63, c16 = lane & 15, lg = lane >> 4;
  const bf16_t* q = (const bf16_t*)(p.ws + OFF_Q);
#pragma unroll
  for (int ct = 0; ct < 2; ++ct) {
    const int t = tw + ct * 4 + (c16 >> 2), head = g * 4 + (c16 & 3);
    const bf16_t* qp = q + ((size_t)(b * 2048 + t)) * 1024 + head * 64 + lg * 8;
    Qb[ct][0] = *(const bf16x8*)(qp);
    Qb[ct][1] = *(const bf16x8*)(qp + 32);
  }
}

DI void store_y(const Params& p, int b, int g, int tw, const f32x4 (&Ot)[4][2]) {
  const int lane = threadIdx.x & 63, c16 = lane & 15, lg = lane >> 4;
  const bf16_t* sz = (const bf16_t*)(p.ws + OFF_SZ);
  bf16_t* y = (bf16_t*)(p.ws + OFF_H);
#pragma unroll
  for (int ct = 0; ct < 2; ++ct) {
    const int t = tw + ct * 4 + (c16 >> 2), head = g * 4 + (c16 & 3);
    const size_t base = ((size_t)(b * 2048 + t)) * 1024 + head * 64 + lg * 4;
#pragma unroll
    for (int dt = 0; dt < 4; ++dt) {
      u32x2 zz = *(const u32x2*)(sz + base + dt * 16);
      u32x2 o;
      o.x = pack_bf2(Ot[dt][ct][0] * bflo(zz.x), Ot[dt][ct][1] * bfhi(zz.x));
      o.y = pack_bf2(Ot[dt][ct][2] * bflo(zz.y), Ot[dt][ct][3] * bfhi(zz.y));
      *(u32x2*)(y + base + dt * 16) = o;
    }
  }
}

DI void nsa_attn_item(const Params& p, int item, char* smem) {
  const int tid = threadIdx.x, lane = tid & 63, w = tid >> 6, c16 = lane & 15, lg = lane >> 4;
  const int bg = item & 63, qb = 63 - (item >> 6);
  const int b = bg >> 2, g = bg & 3;
  const int t0 = qb * 32, tw = t0 + w * 8;
  const int cur = t0 >> 6;
  unsigned* selm = (unsigned*)(smem + 36864);
  float* imp_main = (float*)(smem + 36992);
  float* imp_carry = (float*)(smem + 36992 + 4224);
  f32x4* Otl = (f32x4*)(smem + 36992) + tid;
  bf16x8 Qb[2][2];
  load_q(p, b, g, tw, Qb);
  int tq[2];
  float gate[2][3];
  const float* gates = (const float*)(p.ws + OFF_GATES);
#pragma unroll
  for (int ct = 0; ct < 2; ++ct) {
    tq[ct] = tw + ct * 4 + (c16 >> 2);
    const float* gp = gates + ((size_t)(b * 2048 + tq[ct])) * 48 + (g * 4 + (c16 & 3)) * 3;
    gate[ct][0] = gp[0]; gate[ct][1] = gp[1]; gate[ct][2] = gp[2];
  }
  __syncthreads();
  bf16_t* Kc = (bf16_t*)smem;
  bf16_t* VcT = (bf16_t*)(smem + 18432);
  {
    const bf16_t* kc = (const bf16_t*)(p.ws + OFF_KCMP) + (size_t)bg * 128 * 64;
    const bf16_t* vc = (const bf16_t*)(p.ws + OFF_VCMPT) + (size_t)bg * 64 * 128;
#pragma unroll
    for (int i = 0; i < 4; ++i) {
      int ch = tid + i * 256;
      int row = ch >> 3, cc = ch & 7;
      *(u32x4*)(Kc + row * 72 + cc * 8) = *(const u32x4*)(kc + row * 64 + cc * 8);
      int rv = ch >> 4, cv = ch & 15;
      *(u32x4*)(VcT + rv * 136 + cv * 8) = *(const u32x4*)(vc + rv * 128 + cv * 8);
    }
  }
  __syncthreads();
  f32x4 Ot[4][2];
#pragma unroll
  for (int ct = 0; ct < 2; ++ct) {
    f32x4 Sx[8];
#pragma unroll
    for (int kt = 0; kt < 8; ++kt) {
      Sx[kt] = f32x4{0.f, 0.f, 0.f, 0.f};
#pragma unroll
      for (int ks = 0; ks < 2; ++ks) {
        bf16x8 a = *(const bf16x8*)(Kc + (kt * 16 + c16) * 72 + ks * 32 + lg * 8);
        Sx[kt] = mfma16(a, Qb[ct][ks], Sx[kt]);
      }
    }
    {
      const int hi = ((tq[ct] - 31) >> 4) - lg * 4;
      float mx = NEG;
#pragma unroll
      for (int kt = 0; kt < 8; ++kt)
#pragma unroll
        for (int j = 0; j < 4; ++j) {
          float s = (kt * 16 + j <= hi) ? Sx[kt][j] : NEG;
          Sx[kt][j] = s;
          mx = fmaxf(mx, s);
        }
      mx = fmaxf(mx, __shfl_xor(mx, 16));
      mx = fmaxf(mx, __shfl_xor(mx, 32));
      const float msafe = mx < -1e29f ? 0.f : mx;
      float rs = 0.f;
#pragma unroll
      for (int kt = 0; kt < 8; ++kt)
#pragma unroll
        for (int j = 0; j < 4; ++j) {
          float pv = fexp2(Sx[kt][j] - msafe);
          Sx[kt][j] = pv;
          rs += pv;
        }
      rs += __shfl_xor(rs, 16);
      rs += __shfl_xor(rs, 32);
      const float inv = 1.f / fmaxf(rs, 1e-30f);
      const int qloc = w * 8 + ct * 4 + (c16 >> 2);
#pragma unroll
      for (int kt = 0; kt < 8; ++kt) {
#pragma unroll
        for (int j = 0; j < 4; ++j) Sx[kt][j] *= inv;
        float a = Sx[kt][0] + Sx[kt][1] + Sx[kt][2] + 0.5f * Sx[kt][3];
        float c = 0.5f * Sx[kt][3];
        a += __shfl_xor(a, 1);
        a += __shfl_xor(a, 2);
        c += __shfl_xor(c, 1);
        c += __shfl_xor(c, 2);
        if ((c16 & 3) == 0) {
          const int mi = kt * 4 + lg;
          imp_main[qloc * 33 + mi] = a;
          imp_carry[qloc * 34 + mi + 1] = c;
        }
      }
    }
    f32x4 O[4];
#pragma unroll
    for (int dt = 0; dt < 4; ++dt) O[dt] = f32x4{0.f, 0.f, 0.f, 0.f};
#pragma unroll
    for (int kp = 0; kp < 4; ++kp) {
      u32x4 u;
      u.x = pack_bf2(Sx[2 * kp][0], Sx[2 * kp][1]);
      u.y = pack_bf2(Sx[2 * kp][2], Sx[2 * kp][3]);
      u.z = pack_bf2(Sx[2 * kp + 1][0], Sx[2 * kp + 1][1]);
      u.w = pack_bf2(Sx[2 * kp + 1][2], Sx[2 * kp + 1][3]);
      bf16x8 Pb = __builtin_bit_cast(bf16x8, u);
#pragma unroll
      for (int dt = 0; dt < 4; ++dt) {
        u32x2 v0 = *(const u32x2*)(VcT + (dt * 16 + c16) * 136 + kp * 32 + lg * 4);
        u32x2 v1 = *(const u32x2*)(VcT + (dt * 16 + c16) * 136 + kp * 32 + 16 + lg * 4);
        u32x4 uu = u32x4{v0.x, v0.y, v1.x, v1.y};
        bf16x8 va = __builtin_bit_cast(bf16x8, uu);
        O[dt] = mfma16(va, Pb, O[dt]);
      }
    }
#pragma unroll
    for (int dt = 0; dt < 4; ++dt) Ot[dt][ct] = O[dt] * gate[ct][0];
  }
  __syncthreads();
  if (tid < 32) {
    unsigned mask = 1u | (1u << cur);
    if (cur >= 1) mask |= 1u << (cur - 1);
    const int need = 8 - __popc(mask);
    for (int it = 0; it < need; ++it) {
      float bv = -1.f;
      int best = -1;
      for (int j = 1; j <= cur - 2; ++j) {
        if (!((mask >> j) & 1u)) {
          float v = imp_main[tid * 33 + j] + imp_carry[tid * 34 + j];
          if (v > bv) { bv = v; best = j; }
        }
      }
      if (best < 0) break;
      mask |= 1u << best;
    }
    selm[tid] = mask;
  }
  __syncthreads();
  unsigned selbits[2];
#pragma unroll
  for (int ct = 0; ct < 2; ++ct) selbits[ct] = selm[w * 8 + ct * 4 + (c16 >> 2)];
#pragma unroll
  for (int dt = 0; dt < 4; ++dt)
#pragma unroll
    for (int ct = 0; ct < 2; ++ct) Otl[(dt * 2 + ct) * 256] = Ot[dt][ct];
  int buf = 0;
  {
    f32x4 O[4][2];
    float mrun[2] = {NEG, NEG}, lrun[2] = {0.f, 0.f};
#pragma unroll
    for (int dt = 0; dt < 4; ++dt) { O[dt][0] = f32x4{0.f, 0.f, 0.f, 0.f}; O[dt][1] = f32x4{0.f, 0.f, 0.f, 0.f}; }
    const bf16_t* Kg = (const bf16_t*)(p.ws + OFF_KS) + (size_t)b * 2048 * 256 + g * 64;
    const bf16_t* VTg = (const bf16_t*)(p.ws + OFF_VST) + (size_t)bg * 64 * 2048;
    attn_range<0>(Kg, VTg, 0, cur, smem, buf, Qb, O, mrun, lrun, tq, selbits, 0);
#pragma unroll
    for (int ct = 0; ct < 2; ++ct) {
      float l = lrun[ct];
      l += __shfl_xor(l, 16);
      l += __shfl_xor(l, 32);
      const float sc = gate[ct][1] / fmaxf(l, 1e-30f);
#pragma unroll
      for (int dt = 0; dt < 4; ++dt) Otl[(dt * 2 + ct) * 256] = Otl[(dt * 2 + ct) * 256] + O[dt][ct] * sc;
    }
  }
  {
    f32x4 O[4][2];
    float mrun[2] = {NEG, NEG}, lrun[2] = {0.f, 0.f};
#pragma unroll
    for (int dt = 0; dt < 4; ++dt) { O[dt][0] = f32x4{0.f, 0.f, 0.f, 0.f}; O[dt][1] = f32x4{0.f, 0.f, 0.f, 0.f}; }
    const bf16_t* Kg = (const bf16_t*)(p.ws + OFF_KW) + (size_t)b * 2048 * 256 + g * 64;
    const bf16_t* VTg = (const bf16_t*)(p.ws + OFF_VWT) + (size_t)bg * 64 * 2048;
    int jlo = t0 - 255;
    jlo = jlo < 0 ? 0 : (jlo >> 6);
    attn_range<1>(Kg, VTg, jlo, cur, smem, buf, Qb, O, mrun, lrun, tq, selbits, 0);
#pragma unroll
    for (int ct = 0; ct < 2; ++ct) {
      float l = lrun[ct];
      l += __shfl_xor(l, 16);
      l += __shfl_xor(l, 32);
      const float sc = gate[ct][2] / fmaxf(l, 1e-30f);
#pragma unroll
      for (int dt = 0; dt < 4; ++dt) Ot[dt][ct] = Otl[(dt * 2 + ct) * 256] + O[dt][ct] * sc;
    }
  }
  store_y(p, b, g, tw, Ot);
}

DI void moba_attn_item(const Params& p, int item, char* smem) {
  const int tid = threadIdx.x, lane = tid & 63, w = tid >> 6, c16 = lane & 15, lg = lane >> 4;
  const int bg = item & 63, qb = 63 - (item >> 6);
  const int b = bg >> 2, g = bg & 3;
  const int t0 = qb * 32, tw = t0 + w * 8;
  const int own = t0 >> 8;
  bf16x8 Qb[2][2];
  load_q(p, b, g, tw, Qb);
  int tq[2];
#pragma unroll
  for (int ct = 0; ct < 2; ++ct) tq[ct] = tw + ct * 4 + (c16 >> 2);
  __syncthreads();
  bf16_t* Km = (bf16_t*)(smem + 36864);
  if (tid < 128) {
    int row = tid >> 3, cc = tid & 7;
    *(u32x4*)(Km + row * 72 + cc * 8) = *(const u32x4*)((const bf16_t*)(p.ws + OFF_KMEAN) + (size_t)bg * 16 * 64 + row * 64 + cc * 8);
  }
  __syncthreads();
  unsigned selbits[2];
#pragma unroll
  for (int ct = 0; ct < 2; ++ct) {
    f32x4 sg = f32x4{0.f, 0.f, 0.f, 0.f};
#pragma unroll
    for (int ks = 0; ks < 2; ++ks) {
      bf16x8 a = *(const bf16x8*)(Km + c16 * 72 + ks * 32 + lg * 8);
      sg = mfma16(a, Qb[ct][ks], sg);
    }
    f32x4 ot;
#pragma unroll
    for (int j = 0; j < 4; ++j) ot[j] = __shfl_xor(sg[j], 16);
    const bool odd = (lg & 1) != 0;
    float v0 = odd ? ot[0] : sg[0], v1 = odd ? ot[1] : sg[1], v2 = odd ? ot[2] : sg[2], v3 = odd ? ot[3] : sg[3];
    float v4 = odd ? sg[0] : ot[0], v5 = odd ? sg[1] : ot[1], v6 = odd ? sg[2] : ot[2], v7 = odd ? sg[3] : ot[3];
    unsigned sel = 0;
#pragma unroll
    for (int it = 0; it < 3; ++it) {
      float bv = -3.0e38f;
      int best = -1;
#define CAND(J, V) if ((J) < own && !((sel >> (J)) & 1u) && (V) > bv) { bv = (V); best = (J); }
      CAND(0, v0) CAND(1, v1) CAND(2, v2) CAND(3, v3) CAND(4, v4) CAND(5, v5) CAND(6, v6) CAND(7, v7)
#undef CAND
      if (best >= 0) sel |= 1u << best;
    }
    selbits[ct] = (unsigned)__shfl((int)sel, c16);
  }
  int buf = 0;
  f32x4 O[4][2];
  float mrun[2] = {NEG, NEG}, lrun[2] = {0.f, 0.f};
#pragma unroll
  for (int dt = 0; dt < 4; ++dt) { O[dt][0] = f32x4{0.f, 0.f, 0.f, 0.f}; O[dt][1] = f32x4{0.f, 0.f, 0.f, 0.f}; }
  const bf16_t* Kg = (const bf16_t*)(p.ws + OFF_KS) + (size_t)b * 2048 * 256 + g * 64;
  const bf16_t* VTg = (const bf16_t*)(p.ws + OFF_VST) + (size_t)bg * 64 * 2048;
  attn_range<2>(Kg, VTg, 0, t0 >> 6, smem, buf, Qb, O, mrun, lrun, tq, selbits, own);
#pragma unroll
  for (int ct = 0; ct < 2; ++ct) {
    float l = lrun[ct];
    l += __shfl_xor(l, 16);
    l += __shfl_xor(l, 32);
    const float sc = 1.f / fmaxf(l, 1e-30f);
#pragma unroll
    for (int dt = 0; dt < 4; ++dt) O[dt][ct] *= sc;
  }
  store_y(p, b, g, tw, O);
}

DI void outproj_tile(const Params& p, int layer, const float* __restrict__ xin, int tile, char* smem) {
  const bool nsa = (layer & 1) == 0;
  const int lj = layer >> 1;
  const int mtile = tile >> 3, ntile = tile & 7;
  const int m0 = mtile * 128, n0 = ntile * 128;
  const int tid = threadIdx.x, lane = tid & 63, w = tid >> 6, wm = w >> 1, wn = w & 1, c16 = lane & 15, lg = lane >> 4;
  const bf16_t* A = (const bf16_t*)(p.ws + OFF_H);
  const bf16_t* Bt = (const bf16_t*)(p.ws + (nsa ? OFF_WT_NSA_OUT : OFF_WT_MOBA_OUT)) + (size_t)lj * 1024 * 1024;
  unsigned aoff[4];
#pragma unroll
  for (int i = 0; i < 4; ++i) aoff[i] = (unsigned)(m0 + (tid >> 3) + 32 * i) * 1024u;
  f32x4 acc[4][4];
  gemm_mainloop<true>(A, aoff, 64, Bt, 1024, n0, smem, acc);
  const int b = m0 >> 11;
  const float* gatev = (const float*)(p.ws + OFF_MOD) + (size_t)(layer * 16 + b) * 3072 + 2048;
#pragma unroll
  for (int nt = 0; nt < 4; ++nt) {
    const int n = n0 + wn * 64 + nt * 16 + lg * 4;
    const float4 gv = *(const float4*)(gatev + n);
#pragma unroll
    for (int mt = 0; mt < 4; ++mt) {
      const int m = m0 + wm * 64 + mt * 16 + c16;
      const float4 xv = *(const float4*)(xin + (size_t)m * 1024 + n);
      float4 o;
      o.x = xv.x + gv.x * acc[nt][mt][0];
      o.y = xv.y + gv.y * acc[nt][mt][1];
      o.z = xv.z + gv.z * acc[nt][mt][2];
      o.w = xv.w + gv.w * acc[nt][mt][3];
      *(float4*)(p.out + (size_t)m * 1024 + n) = o;
    }
  }
}

DI void run_phase(const Params& p, int layer, int ph, char* smem) {
  const int G = gridDim.x, bid = blockIdx.x;
  const bool nsa = (layer & 1) == 0;
  const int lj = layer >> 1;
  const float* xin = layer == 0 ? p.x : p.out;
  if (ph == 0) {
    for (int it = bid; it < NW_TOTAL; it += G) phaseW_item(p, it, smem);
  } else if (ph == 1) {
    for (int it = bid; it < NTOK / 4; it += G) prep_item(p, layer, xin, it);
  } else if (ph == 2) {
    const int n = 256 * (nsa ? 29 : 20);
    for (int it = bid; it < n; it += G) inproj_tile(p, layer, it, smem);
  } else if (ph == 3) {
    if (nsa) { for (int it = bid; it < 256; it += G) cmp1_tile(p, lj, it, smem); }
    else { for (int it = bid; it < 512; it += G) kmean_item(p, it, smem); }
  } else if (ph == 4) {
    if (nsa) for (int it = bid; it < 256; it += G) cmp2_item(p, lj, it, smem);
  } else if (ph == 5) {
#ifndef ONLY_MOBA
    if (nsa) { for (int it = bid; it < 4096; it += G) nsa_attn_item(p, it, smem); }
#endif
#ifndef ONLY_NSA
    if (!nsa) { for (int it = bid; it < 4096; it += G) moba_attn_item(p, it, smem); }
#endif
  } else if (ph == 6) {
    for (int it = bid; it < 2048; it += G) outproj_tile(p, layer, xin, it, smem);
  }
}

#if MULTI_LAUNCH
template <int PH>
__global__ void __launch_bounds__(256, 2) phase_kernel(Params p, int layer) {
  __shared__ __attribute__((aligned(16))) char smem[SMEM_BYTES];
  run_phase(p, layer, PH, smem);
}
#else
__global__ void __launch_bounds__(256, 2) mega_kernel(Params p) {
  __shared__ __attribute__((aligned(16))) char smem[SMEM_BYTES];
  cg::grid_group grid = cg::this_grid();
  run_phase(p, 0, 0, smem);
  grid.sync();
  for (int layer = 0; layer < 4; ++layer) {
    const bool nsa = (layer & 1) == 0;
    run_phase(p, layer, 1, smem);
    grid.sync();
    run_phase(p, layer, 2, smem);
    grid.sync();
    run_phase(p, layer, 3, smem);
    grid.sync();
    if (nsa) {
      run_phase(p, layer, 4, smem);
      grid.sync();
    }
    run_phase(p, layer, 5, smem);
    grid.sync();
    run_phase(p, layer, 6, smem);
    if (layer < 3) grid.sync();
  }
}
#endif

extern "C" void kernel_launch(void* const* d_in, const int* in_sizes, int n_in, void* d_out, int out_size, void* d_ws, size_t ws_size,
                              hipStream_t stream) {
  Params p{};
  p.x = (const float*)d_in[0];
  p.c = (const float*)d_in[1];
  p.pos = (const int*)d_in[2];
  p.norm_g = (const float*)d_in[3];
  p.ada_w = (const float*)d_in[4];
  p.ada_b = (const float*)d_in[5];
  p.nsa_w_in = (const float*)d_in[6];
  p.nsa_w_out = (const float*)d_in[7];
  p.nsa_qn = (const float*)d_in[8];
  p.nsa_kn = (const float*)d_in[9];
  p.cmp_pe = (const float*)d_in[10];
  p.cmp_w1 = (const float*)d_in[11];
  p.cmp_b1 = (const float*)d_in[12];
  p.cmp_w2 = (const float*)d_in[13];
  p.gate_b = (const float*)d_in[14];
  p.moba_w_in = (const float*)d_in[15];
  p.moba_w_out = (const float*)d_in[16];
  p.moba_qn = (const float*)d_in[17];
  p.moba_kn = (const float*)d_in[18];
  p.out = (float*)d_out;
  p.ws = (char*)d_ws;
  if (ws_size < WS_TOTAL) { fprintf(stderr, "workspace too small: %zu < %zu\n", ws_size, (size_t)WS_TOTAL); return; }
#if MULTI_LAUNCH
  const int G = 512;
  phase_kernel<0><<<G, 256, 0, stream>>>(p, 0);
  for (int layer = 0; layer < 4; ++layer) {
    phase_kernel<1><<<G, 256, 0, stream>>>(p, layer);
    phase_kernel<2><<<G, 256, 0, stream>>>(p, layer);
    phase_kernel<3><<<G, 256, 0, stream>>>(p, layer);
    if (!(layer & 1)) phase_kernel<4><<<G, 256, 0, stream>>>(p, layer);
    phase_kernel<5><<<G, 256, 0, stream>>>(p, layer);
    phase_kernel<6><<<G, 256, 0, stream>>>(p, layer);
  }
#else
  static int grid_blocks = 0;
  if (!grid_blocks) {
    int dev = 0, cus = 0, per_cu = 0;
    (void)hipGetDevice(&dev);
    (void)hipDeviceGetAttribute(&cus, hipDeviceAttributeMultiprocessorCount, dev);
    (void)hipOccupancyMaxActiveBlocksPerMultiprocessor(&per_cu, mega_kernel, 256, 0);
    if (per_cu > 2) per_cu = 2;
    grid_blocks = cus * per_cu;
  }
  void* args[] = {&p};
  hipError_t e = hipLaunchCooperativeKernel((void*)mega_kernel, dim3(grid_blocks), dim3(256), args, 0, stream);
  if (e != hipSuccess) fprintf(stderr, "cooperative launch failed: %s (grid %d)\n", hipGetErrorString(e), grid_blocks);
#endif
}
```

```cpp
#include <hip/hip_runtime.h>
#include <hip/hip_cooperative_groups.h>
#include <cstdio>
namespace cg = cooperative_groups;

#ifndef MULTI_LAUNCH
#define MULTI_LAUNCH 0
#endif

#define DI __device__ __forceinline__
typedef unsigned short bf16_t;
using bf16x8 = __attribute__((ext_vector_type(8))) short;
using f32x4 = __attribute__((ext_vector_type(4))) float;
typedef __bf16 bf16x2_t __attribute__((ext_vector_type(2)));
typedef float f32x2_t __attribute__((ext_vector_type(2)));
using u32x4 = __attribute__((ext_vector_type(4))) unsigned;
using u32x2 = __attribute__((ext_vector_type(2))) unsigned;

constexpr int DM = 1024, NB = 16, SEQ = 2048, NTOK = NB * SEQ;
constexpr int NSA_IN = 3632, NSA_NP = 3712, MOBA_IN = 2560;
constexpr float EPS = 1e-6f;
constexpr float QSCALE = 0.125f * 1.4426950408889634f;
constexpr float NEG = -1e30f;

constexpr size_t SZ_WT_NSA_IN = (size_t)2 * NSA_NP * 1024 * 2;
constexpr size_t SZ_WT_SQ = (size_t)2 * 1024 * 1024 * 2;
constexpr size_t SZ_WT_MOBA_IN = (size_t)2 * MOBA_IN * 1024 * 2;
constexpr size_t SZ_WT_CMP1 = (size_t)4 * 256 * 2048 * 2;
constexpr size_t SZ_ACT = (size_t)NTOK * 1024 * 2;
constexpr size_t SZ_KV = (size_t)NTOK * 256 * 2;
constexpr size_t OFF_WT_NSA_IN = 0;
constexpr size_t OFF_WT_NSA_OUT = OFF_WT_NSA_IN + SZ_WT_NSA_IN;
constexpr size_t OFF_WT_MOBA_IN = OFF_WT_NSA_OUT + SZ_WT_SQ;
constexpr size_t OFF_WT_MOBA_OUT = OFF_WT_MOBA_IN + SZ_WT_MOBA_IN;
constexpr size_t OFF_WT_CMP1 = OFF_WT_MOBA_OUT + SZ_WT_SQ;
constexpr size_t OFF_B1EFF = OFF_WT_CMP1 + SZ_WT_CMP1;
constexpr size_t OFF_ROPE = OFF_B1EFF + 4096;
constexpr size_t OFF_MOD = OFF_ROPE + (size_t)NTOK * 16 * 4;
constexpr size_t OFF_H = OFF_MOD + (size_t)4 * 16 * 3072 * 4;
constexpr size_t OFF_Q = OFF_H + SZ_ACT;
constexpr size_t OFF_SZ = OFF_Q + SZ_ACT;
constexpr size_t OFF_KC = OFF_SZ + SZ_ACT;
constexpr size_t OFF_VC = OFF_KC + SZ_KV;
constexpr size_t OFF_KS = OFF_VC + SZ_KV;
constexpr size_t OFF_KW = OFF_KS + SZ_KV;
constexpr size_t OFF_VST = OFF_KW + SZ_KV;
constexpr size_t OFF_VWT = OFF_VST + SZ_KV;
constexpr size_t OFF_GATES = OFF_VWT + SZ_KV;
constexpr size_t OFF_HID = OFF_GATES + (size_t)NTOK * 48 * 4;
constexpr size_t OFF_KCMP = OFF_HID + (size_t)2 * 8192 * 256 * 2;
constexpr size_t OFF_VCMPT = OFF_KCMP + (size_t)64 * 128 * 64 * 2;
constexpr size_t OFF_KMEAN = OFF_VCMPT + (size_t)64 * 128 * 64 * 2;
constexpr size_t WS_TOTAL = OFF_KMEAN + (size_t)64 * 16 * 64 * 2;

struct Params {
  const float *x, *c;
  const int* pos;
  const float *norm_g, *ada_w, *ada_b, *nsa_w_in, *nsa_w_out, *nsa_qn, *nsa_kn, *cmp_pe, *cmp_w1, *cmp_b1, *cmp_w2, *gate_b,
      *moba_w_in, *moba_w_out, *moba_qn, *moba_kn;
  float* out;
  char* ws;
};

constexpr int SMEM_BYTES = 73728;

DI int tidx() {
  int t = __builtin_amdgcn_workitem_id_x();
  asm volatile("" : "+v"(t));
  return t;
}
DI unsigned pack_bf2(float a, float b) {
  f32x2_t v = {a, b};
  bf16x2_t r = __builtin_convertvector(v, bf16x2_t);
  return __builtin_bit_cast(unsigned, r);
}
DI float bf2f(bf16_t v) { return __uint_as_float(((unsigned)v) << 16); }
DI float bflo(unsigned u) { return __uint_as_float(u << 16); }
DI float bfhi(unsigned u) { return __uint_as_float(u & 0xffff0000u); }
DI f32x4 mfma16(bf16x8 a, bf16x8 b, f32x4 c) { return __builtin_amdgcn_mfma_f32_16x16x32_bf16(a, b, c, 0, 0, 0); }
DI float fexp2(float x) { return __builtin_amdgcn_exp2f(x); }
DI float sigmoidf_(float x) { return 1.f / (1.f + __expf(-x)); }
DI float siluf_(float x) { return x / (1.f + __expf(-x)); }
DI float geluf_(float x) {
  float u = 0.7978845608028654f * (x + 0.044715f * x * x * x);
  float t = 1.f - 2.f / (__expf(2.f * u) + 1.f);
  return 0.5f * x * (1.f + t);
}

DI void ada_item(const Params& p, int item, char* smem) {
  const int tid = tidx();
  const int l = item / 48, n0 = (item % 48) * 64;
  float* cond = (float*)smem;
  __syncthreads();
  for (int i = tid; i < 16 * 1024; i += 256) {
    int b = i >> 10, k = i & 1023;
    float v = p.c[i];
    cond[k * 16 + b] = siluf_(v);
  }
  __syncthreads();
  const int kq = tid >> 6, col = tid & 63;
  float acc[16];
#pragma unroll
  for (int b = 0; b < 16; ++b) acc[b] = 0.f;
  const float* w = p.ada_w + (size_t)l * 1024 * 3072 + n0 + col;
#pragma unroll 4
  for (int k = kq * 256; k < kq * 256 + 256; ++k) {
    float wv = w[(size_t)k * 3072];
    const float4* cp = (const float4*)(cond + k * 16);
    float4 c0 = cp[0], c1 = cp[1], c2 = cp[2], c3 = cp[3];
    acc[0] += wv * c0.x; acc[1] += wv * c0.y; acc[2] += wv * c0.z; acc[3] += wv * c0.w;
    acc[4] += wv * c1.x; acc[5] += wv * c1.y; acc[6] += wv * c1.z; acc[7] += wv * c1.w;
    acc[8] += wv * c2.x; acc[9] += wv * c2.y; acc[10] += wv * c2.z; acc[11] += wv * c2.w;
    acc[12] += wv * c3.x; acc[13] += wv * c3.y; acc[14] += wv * c3.z; acc[15] += wv * c3.w;
  }
  __syncthreads();
  float* red = (float*)smem;
#pragma unroll
  for (int b = 0; b < 16; ++b) red[(kq * 16 + b) * 64 + col] = acc[b];
  __syncthreads();
  float* mod = (float*)(p.ws + OFF_MOD);
  for (int i = tid; i < 16 * 64; i += 256) {
    int b = i >> 6, cc = i & 63;
    float s = red[(0 * 16 + b) * 64 + cc] + red[(16 + b) * 64 + cc] + red[(32 + b) * 64 + cc] + red[(48 + b) * 64 + cc];
    mod[(size_t)(l * 16 + b) * 3072 + n0 + cc] = s + p.ada_b[l * 3072 + n0 + cc];
  }
}

DI void b1eff_item(const Params& p, int item, char* smem) {
  const int tid = tidx();
  const int li = item >> 4, h0 = (item & 15) * 16;
  const int kg = tid >> 4, hh = tid & 15;
  const float* W1 = p.cmp_w1 + (size_t)li * 2048 * 256;
  const float* pe = p.cmp_pe + li * 2048;
  float acc = 0.f;
#pragma unroll 8
  for (int k = kg * 128; k < kg * 128 + 128; ++k) acc += pe[k] * W1[(size_t)k * 256 + h0 + hh];
  float* red = (float*)smem;
  __syncthreads();
  red[kg * 16 + hh] = acc;
  __syncthreads();
  if (tid < 16) {
    float s = 0.f;
    for (int g = 0; g < 16; ++g) s += red[g * 16 + tid];
    ((float*)(p.ws + OFF_B1EFF))[li * 256 + h0 + tid] = s + p.cmp_b1[li * 256 + h0 + tid];
  }
}

DI void rope_item(const Params& p, int item) {
  const int idx = item * 256 + tidx();
  const int tok = idx >> 3, i = idx & 7;
  const float invf[8] = {1.0f, 0.1939227432012558f, 0.03760603070259094f, 0.007292664609849453f,
                         0.0014142135623842478f, 0.00027424818836152554f, 5.318296098266728e-05f, 1.0313386155758053e-05f};
  float f = i == 0 ? invf[0] : i == 1 ? invf[1] : i == 2 ? invf[2] : i == 3 ? invf[3] : i == 4 ? invf[4] : i == 5 ? invf[5] : i == 6 ? invf[6] : invf[7];
  float ang = (float)p.pos[tok] * f;
  double rev = (double)ang * 0.15915494309189535;
  double fr = rev - floor(rev);
  float frf = (float)fr;
  float* rope = (float*)(p.ws + OFF_ROPE);
  rope[(size_t)tok * 16 + i] = __builtin_amdgcn_cosf(frf);
  rope[(size_t)tok * 16 + 8 + i] = __builtin_amdgcn_sinf(frf);
}

DI void transpose_item(const float* __restrict__ src, int K, int Nsrc, bf16_t* __restrict__ dst, int k0, int n0, int mapmode, char* smem) {
  float* tile = (float*)smem;
  const int tid = tidx();
  __syncthreads();
#pragma unroll 4
  for (int i = 0; i < 16; ++i) {
    int kk = i * 4 + (tid >> 6), nn = tid & 63;
    int nd = n0 + nn, ns = nd;
    if (mapmode == 1) ns = nd < 2560 ? nd : (nd < 3584 ? nd + 48 : (nd < 3632 ? nd - 1024 : -1));
    float v = ns >= 0 ? src[(size_t)(k0 + kk) * Nsrc + ns] : 0.f;
    tile[kk * 65 + nn] = v;
  }
  __syncthreads();
#pragma unroll 4
  for (int i = 0; i < 16; ++i) {
    int nn = i * 4 + (tid >> 6), kk = tid & 63;
    float v = tile[kk * 65 + nn];
    unsigned u = pack_bf2(v, 0.f);
    dst[(size_t)(n0 + nn) * K + k0 + kk] = (bf16_t)(u & 0xffff);
  }
}

constexpr int NW_ADA = 192, NW_B1 = 64, NW_ROPE = 1024;
constexpr int NW_T_NSA_IN = 16 * 58, NW_T_SQ = 256, NW_T_MOBA_IN = 16 * 40, NW_T_CMP = 128;
constexpr int NW_TRANS = 2 * NW_T_NSA_IN + 2 * NW_T_SQ + 2 * NW_T_MOBA_IN + 2 * NW_T_SQ + 4 * NW_T_CMP;
constexpr int NW_TOTAL = NW_ADA + NW_B1 + NW_ROPE + NW_TRANS;

DI void phaseW_item(const Params& p, int it, char* smem) {
  if (it < NW_ADA) { ada_item(p, it, smem); return; }
  it -= NW_ADA;
  if (it < NW_B1) { b1eff_item(p, it, smem); return; }
  it -= NW_B1;
  if (it < NW_ROPE) { rope_item(p, it); return; }
  it -= NW_ROPE;
  if (it < 2 * NW_T_NSA_IN) {
    int l = it / NW_T_NSA_IN, t = it % NW_T_NSA_IN;
    transpose_item(p.nsa_w_in + (size_t)l * 1024 * NSA_IN, 1024, NSA_IN, (bf16_t*)(p.ws + OFF_WT_NSA_IN) + (size_t)l * NSA_NP * 1024,
                   (t % 16) * 64, (t / 16) * 64, 1, smem);
    return;
  }
  it -= 2 * NW_T_NSA_IN;
  if (it < 2 * NW_T_SQ) {
    int l = it / NW_T_SQ, t = it % NW_T_SQ;
    transpose_item(p.nsa_w_out + (size_t)l * 1024 * 1024, 1024, 1024, (bf16_t*)(p.ws + OFF_WT_NSA_OUT) + (size_t)l * 1024 * 1024,
                   (t % 16) * 64, (t / 16) * 64, 0, smem);
    return;
  }
  it -= 2 * NW_T_SQ;
  if (it < 2 * NW_T_MOBA_IN) {
    int l = it / NW_T_MOBA_IN, t = it % NW_T_MOBA_IN;
    transpose_item(p.moba_w_in + (size_t)l * 1024 * MOBA_IN, 1024, MOBA_IN, (bf16_t*)(p.ws + OFF_WT_MOBA_IN) + (size_t)l * MOBA_IN * 1024,
                   (t % 16) * 64, (t / 16) * 64, 0, smem);
    return;
  }
  it -= 2 * NW_T_MOBA_IN;
  if (it < 2 * NW_T_SQ) {
    int l = it / NW_T_SQ, t = it % NW_T_SQ;
    transpose_item(p.moba_w_out + (size_t)l * 1024 * 1024, 1024, 1024, (bf16_t*)(p.ws + OFF_WT_MOBA_OUT) + (size_t)l * 1024 * 1024,
                   (t % 16) * 64, (t / 16) * 64, 0, smem);
    return;
  }
  it -= 2 * NW_T_SQ;
  {
    int li = it / NW_T_CMP, t = it % NW_T_CMP;
    transpose_item(p.cmp_w1 + (size_t)li * 2048 * 256, 2048, 256, (bf16_t*)(p.ws + OFF_WT_CMP1) + (size_t)li * 256 * 2048,
                   (t % 32) * 64, (t / 32) * 64, 0, smem);
  }
}

DI void prep_item(const Params& p, int layer, const float* __restrict__ xin, int item) {
  const int lane = tidx() & 63, w = tidx() >> 6;
  const int tok = item * 4 + w;
  const int b = tok >> 11;
  const float4* xr = (const float4*)(xin + (size_t)tok * 1024);
  float4 v[4];
  float ss = 0.f;
#pragma unroll
  for (int i = 0; i < 4; ++i) {
    v[i] = xr[lane + i * 64];
    ss += v[i].x * v[i].x + v[i].y * v[i].y + v[i].z * v[i].z + v[i].w * v[i].w;
  }
#pragma unroll
  for (int o = 32; o >= 1; o >>= 1) ss += __shfl_xor(ss, o);
  const float rstd = __builtin_amdgcn_rsqf(ss * (1.f / 1024.f) + EPS);
  const float* mod = (const float*)(p.ws + OFF_MOD) + (size_t)(layer * 16 + b) * 3072;
  const float4* g4 = (const float4*)(p.norm_g + layer * 1024);
  const float4* sh4 = (const float4*)(mod);
  const float4* sc4 = (const float4*)(mod + 1024);
  u32x2* hr = (u32x2*)((bf16_t*)(p.ws + OFF_H) + (size_t)tok * 1024);
#pragma unroll
  for (int i = 0; i < 4; ++i) {
    int c = lane + i * 64;
    float4 g = g4[c], sh = sh4[c], sc = sc4[c];
    float a0 = v[i].x * rstd * g.x * (1.f + sc.x) + sh.x;
    float a1 = v[i].y * rstd * g.y * (1.f + sc.y) + sh.y;
    float a2 = v[i].z * rstd * g.z * (1.f + sc.z) + sh.z;
    float a3 = v[i].w * rstd * g.w * (1.f + sc.w) + sh.w;
    u32x2 o;
    o.x = pack_bf2(a0, a1);
    o.y = pack_bf2(a2, a3);
    hr[c] = o;
  }
}

template <bool SWAP>
DI void gemm_mainloop(const bf16_t* __restrict__ A, const unsigned (&aoff)[4], int a_kstride, const bf16_t* __restrict__ Bt, int K, int n0,
                      char* smem, f32x4 (&acc)[4][4]) {
  bf16_t* sA = (bf16_t*)smem;
  bf16_t* sB = (bf16_t*)(smem + 36864);
  const int tid = tidx(), lane = tid & 63, w = tid >> 6;
  const int wm = w >> 1, wn = w & 1, c16 = lane & 15, lg = lane >> 4;
  const int r0 = tid >> 3, c8 = tid & 7;
  const int nk = K >> 6;
  u32x4 ra[4], rb[4];
  const bf16_t* bbase = Bt + (size_t)(n0 + r0) * K + c8 * 8;
#pragma unroll
  for (int i = 0; i < 4; ++i) {
    ra[i] = *(const u32x4*)(A + aoff[i] + c8 * 8);
    rb[i] = *(const u32x4*)(bbase + (size_t)i * 32 * K);
  }
#pragma unroll
  for (int a = 0; a < 4; ++a)
#pragma unroll
    for (int b = 0; b < 4; ++b) acc[a][b] = f32x4{0.f, 0.f, 0.f, 0.f};
  __syncthreads();
  for (int kt = 0; kt < nk; ++kt) {
    const int buf = kt & 1;
    bf16_t* cA = sA + buf * (128 * 72);
    bf16_t* cB = sB + buf * (128 * 72);
#pragma unroll
    for (int i = 0; i < 4; ++i) {
      *(u32x4*)(cA + (r0 + 32 * i) * 72 + c8 * 8) = ra[i];
      *(u32x4*)(cB + (r0 + 32 * i) * 72 + c8 * 8) = rb[i];
    }
    __syncthreads();
    if (kt + 1 < nk) {
#pragma unroll
      for (int i = 0; i < 4; ++i) {
        ra[i] = *(const u32x4*)(A + aoff[i] + (size_t)(kt + 1) * a_kstride + c8 * 8);
        rb[i] = *(const u32x4*)(bbase + (size_t)i * 32 * K + (kt + 1) * 64);
      }
    }
#pragma unroll
    for (int ks = 0; ks < 2; ++ks) {
      bf16x8 af[4], bfr[4];
#pragma unroll
      for (int mt = 0; mt < 4; ++mt) af[mt] = *(const bf16x8*)(cA + (wm * 64 + mt * 16 + c16) * 72 + ks * 32 + lg * 8);
#pragma unroll
      for (int nt = 0; nt < 4; ++nt) bfr[nt] = *(const bf16x8*)(cB + (wn * 64 + nt * 16 + c16) * 72 + ks * 32 + lg * 8);
#pragma unroll
      for (int mt = 0; mt < 4; ++mt)
#pragma unroll
        for (int nt = 0; nt < 4; ++nt) {
          if (SWAP) acc[nt][mt] = mfma16(bfr[nt], af[mt], acc[nt][mt]);
          else acc[mt][nt] = mfma16(af[mt], bfr[nt], acc[mt][nt]);
        }
    }
  }
}

DI void epi_normrope(f32x4 (&acc)[4][4], int m_base  , int ncol_base  ,
                     bf16_t* __restrict__ dst, int ld, const float* __restrict__ gw, const float* __restrict__ rope, float oscale) {
  const int lane = tidx() & 63, c16 = lane & 15, lg = lane >> 4;
  float gwv[4][4];
#pragma unroll
  for (int nt = 0; nt < 4; ++nt)
#pragma unroll
    for (int j = 0; j < 4; ++j) gwv[nt][j] = gw[nt * 16 + lg * 4 + j];
#pragma unroll
  for (int mt = 0; mt < 4; ++mt) {
    const int m = m_base + mt * 16 + c16;
    float ss = 0.f;
#pragma unroll
    for (int nt = 0; nt < 4; ++nt)
#pragma unroll
      for (int j = 0; j < 4; ++j) ss += acc[nt][mt][j] * acc[nt][mt][j];
    ss += __shfl_xor(ss, 16);
    ss += __shfl_xor(ss, 32);
    const float rstd = __builtin_amdgcn_rsqf(ss * (1.f / 64.f) + EPS);
    float v[4][4];
#pragma unroll
    for (int nt = 0; nt < 4; ++nt)
#pragma unroll
      for (int j = 0; j < 4; ++j) v[nt][j] = acc[nt][mt][j] * rstd * gwv[nt][j];
    const float4 cs = *(const float4*)(rope + (size_t)m * 16 + (lg & 1) * 4);
    const float4 sn = *(const float4*)(rope + (size_t)m * 16 + 8 + (lg & 1) * 4);
    const float csv[4] = {cs.x, cs.y, cs.z, cs.w};
    const float snv[4] = {sn.x, sn.y, sn.z, sn.w};
#pragma unroll
    for (int j = 0; j < 4; ++j) {
      float mine = v[0][j];
      float other = __shfl_xor(mine, 32);
      float r = (lg < 2) ? (mine * csv[j] - other * snv[j]) : (mine * csv[j] + other * snv[j]);
      v[0][j] = r;
    }
#pragma unroll
    for (int nt = 0; nt < 4; ++nt) {
      u32x2 o;
      o.x = pack_bf2(v[nt][0] * oscale, v[nt][1] * oscale);
      o.y = pack_bf2(v[nt][2] * oscale, v[nt][3] * oscale);
      *(u32x2*)(dst + (size_t)m * ld + ncol_base + nt * 16 + lg * 4) = o;
    }
  }
}

template <int MODE>
DI void epi_store_bf16(f32x4 (&acc)[4][4], int m_base, int ncol_base, bf16_t* __restrict__ dst, int ld, const float* __restrict__ bias) {
  const int lane = tidx() & 63, c16 = lane & 15, lg = lane >> 4;
#pragma unroll
  for (int mt = 0; mt < 4; ++mt) {
    const int m = m_base + mt * 16 + c16;
#pragma unroll
    for (int nt = 0; nt < 4; ++nt) {
      float v[4];
#pragma unroll
      for (int j = 0; j < 4; ++j) {
        float a = acc[nt][mt][j];
        if (MODE == 1) a = siluf_(a);
        if (MODE == 2) a = geluf_(a + bias[ncol_base + nt * 16 + lg * 4 + j]);
        v[j] = a;
      }
      u32x2 o;
      o.x = pack_bf2(v[0], v[1]);
      o.y = pack_bf2(v[2], v[3]);
      *(u32x2*)(dst + (size_t)m * ld + ncol_base + nt * 16 + lg * 4) = o;
    }
  }
}

DI void epi_store_vt(f32x4 (&acc)[4][4], int m_base, int col_base, bf16_t* __restrict__ vt) {
  const int lane = tidx() & 63, c16 = lane & 15, lg = lane >> 4;
#pragma unroll
  for (int mt = 0; mt < 4; ++mt) {
    const int m = m_base + mt * 16 + lg * 4;
    const int b = m >> 11, s = m & 2047;
#pragma unroll
    for (int nt = 0; nt < 4; ++nt) {
      const int col = col_base + nt * 16 + c16;
      const int gh = col >> 6, d = col & 63;
      u32x2 o;
      o.x = pack_bf2(acc[mt][nt][0], acc[mt][nt][1]);
      o.y = pack_bf2(acc[mt][nt][2], acc[mt][nt][3]);
      *(u32x2*)(vt + ((size_t)((b * 4 + gh) * 64 + d)) * 2048 + s) = o;
    }
  }
}

DI void inproj_tile(const Params& p, int layer, int tile, char* smem) {
  const bool nsa = (layer & 1) == 0;
  const int lj = layer >> 1;
  const int NT = nsa ? 29 : 20;
  const int mtile = tile / NT, ntile = tile % NT;
  const int m0 = mtile * 128, n0 = ntile * 128;
  const int tid = tidx(), w = tid >> 6, wm = w >> 1, wn = w & 1;
  const bf16_t* A = (const bf16_t*)(p.ws + OFF_H);
  const bf16_t* Bt = nsa ? (const bf16_t*)(p.ws + OFF_WT_NSA_IN) + (size_t)lj * NSA_NP * 1024
                         : (const bf16_t*)(p.ws + OFF_WT_MOBA_IN) + (size_t)lj * MOBA_IN * 1024;
  unsigned aoff[4];
#pragma unroll
  for (int i = 0; i < 4; ++i) aoff[i] = (unsigned)(m0 + (tid >> 3) + 32 * i) * 1024u;
  int type;
  bf16_t* dst = nullptr;
  int ld = 0, coff = 0;
  const float* gw = nullptr;
  if (nsa) {
    if (ntile < 8) { type = 0; dst = (bf16_t*)(p.ws + OFF_Q); ld = 1024; coff = n0; gw = p.nsa_qn + lj * 64; }
    else if (ntile < 10) { type = 2; dst = (bf16_t*)(p.ws + OFF_KC); ld = 256; coff = n0 - 1024; }
    else if (ntile < 12) { type = 2; dst = (bf16_t*)(p.ws + OFF_VC); ld = 256; coff = n0 - 1280; }
    else if (ntile < 14) { type = 1; dst = (bf16_t*)(p.ws + OFF_KS); ld = 256; coff = n0 - 1536; gw = p.nsa_kn + (lj * 3 + 1) * 64; }
    else if (ntile < 16) { type = 3; dst = (bf16_t*)(p.ws + OFF_VST); coff = n0 - 1792; }
    else if (ntile < 18) { type = 1; dst = (bf16_t*)(p.ws + OFF_KW); ld = 256; coff = n0 - 2048; gw = p.nsa_kn + (lj * 3 + 2) * 64; }
    else if (ntile < 20) { type = 3; dst = (bf16_t*)(p.ws + OFF_VWT); coff = n0 - 2304; }
    else if (ntile < 28) { type = 4; dst = (bf16_t*)(p.ws + OFF_SZ); ld = 1024; coff = n0 - 2560; }
    else { type = 5; }
  } else {
    if (ntile < 8) { type = 0; dst = (bf16_t*)(p.ws + OFF_Q); ld = 1024; coff = n0; gw = p.moba_qn + lj * 64; }
    else if (ntile < 10) { type = 1; dst = (bf16_t*)(p.ws + OFF_KS); ld = 256; coff = n0 - 1024; gw = p.moba_kn + lj * 64; }
    else if (ntile < 12) { type = 3; dst = (bf16_t*)(p.ws + OFF_VST); coff = n0 - 1280; }
    else { type = 4; dst = (bf16_t*)(p.ws + OFF_SZ); ld = 1024; coff = n0 - 1536; }
  }
  f32x4 acc[4][4];
  const float* rope = (const float*)(p.ws + OFF_ROPE);
  const int m_base = m0 + wm * 64;
  if (type == 3) {
    gemm_mainloop<false>(A, aoff, 64, Bt, 1024, n0, smem, acc);
    epi_store_vt(acc, m_base, coff + wn * 64, dst);
  } else {
    gemm_mainloop<true>(A, aoff, 64, Bt, 1024, n0, smem, acc);
    if (type == 0) epi_normrope(acc, m_base, coff + wn * 64, dst, ld, gw, rope, QSCALE);
    else if (type == 1) epi_normrope(acc, m_base, coff + wn * 64, dst, ld, gw, rope, 1.0f);
    else if (type == 2) epi_store_bf16<0>(acc, m_base, coff + wn * 64, dst, ld, nullptr);
    else if (type == 4) epi_store_bf16<1>(acc, m_base, coff + wn * 64, dst, ld, nullptr);
    else {
      const int lane = tid & 63, c16 = lane & 15, lg = lane >> 4;
      float* gates = (float*)(p.ws + OFF_GATES);
      const float* gb = p.gate_b + lj * 48;
      if (wn == 0) {
#pragma unroll
        for (int mt = 0; mt < 4; ++mt) {
          const int m = m_base + mt * 16 + c16;
#pragma unroll
          for (int nt = 0; nt < 3; ++nt) {
            const int nl = nt * 16 + lg * 4;
            float4 o;
            o.x = sigmoidf_(acc[nt][mt][0] + gb[nl + 0]);
            o.y = sigmoidf_(acc[nt][mt][1] + gb[nl + 1]);
            o.z = sigmoidf_(acc[nt][mt][2] + gb[nl + 2]);
            o.w = sigmoidf_(acc[nt][mt][3] + gb[nl + 3]);
            *(float4*)(gates + (size_t)m * 48 + nl) = o;
          }
        }
      }
    }
  }
}

DI void cmp1_tile(const Params& p, int lj, int tile, char* smem) {
  const int i = tile >> 7, t = tile & 127;
  const int mtile = t >> 1, ntile = t & 1;
  const int m0 = mtile * 128, n0 = ntile * 128;
  const int tid = tidx(), w = tid >> 6, wm = w >> 1, wn = w & 1;
  const bf16_t* A = (const bf16_t*)(p.ws + (i == 0 ? OFF_KC : OFF_VC));
  const bf16_t* Bt = (const bf16_t*)(p.ws + OFF_WT_CMP1) + (size_t)(lj * 2 + i) * 256 * 2048;
  unsigned aoff[4];
#pragma unroll
  for (int q = 0; q < 4; ++q) {
    int m = m0 + (tid >> 3) + 32 * q;
    int g = m & 3, n = (m >> 2) & 127, b = m >> 9;
    if (n > 126) n = 126;
    aoff[q] = (unsigned)((b * 2048 + 16 * n) * 256 + g * 64);
  }
  f32x4 acc[4][4];
  gemm_mainloop<true>(A, aoff, 256, Bt, 2048, n0, smem, acc);
  bf16_t* hid = (bf16_t*)(p.ws + OFF_HID) + (size_t)i * 8192 * 256;
  const float* b1 = (const float*)(p.ws + OFF_B1EFF) + (lj * 2 + i) * 256;
  epi_store_bf16<2>(acc, m0 + wm * 64, n0 + wn * 64, hid, 256, b1);
}

DI void cmp2_item(const Params& p, int lj, int item, char* smem) {
  const int tid = tidx();
  const int i = item >> 7, rt = item & 127;
  float* w2s = (float*)smem;
  const float* W2 = p.cmp_w2 + (size_t)(lj * 2 + i) * 256 * 64;
  __syncthreads();
  for (int q = tid; q < 256 * 64 / 4; q += 256) ((float4*)w2s)[q] = ((const float4*)W2)[q];
  __syncthreads();
  const int row = tid >> 2, cq = tid & 3;
  const int m = rt * 64 + row;
  const bf16_t* hid = (const bf16_t*)(p.ws + OFF_HID) + ((size_t)i * 8192 + m) * 256;
  float acc[16];
#pragma unroll
  for (int d = 0; d < 16; ++d) acc[d] = 0.f;
  for (int k8 = 0; k8 < 32; ++k8) {
    u32x4 hv = *(const u32x4*)(hid + k8 * 8);
    float hf[8] = {bflo(hv.x), bfhi(hv.x), bflo(hv.y), bfhi(hv.y), bflo(hv.z), bfhi(hv.z), bflo(hv.w), bfhi(hv.w)};
#pragma unroll
    for (int kk = 0; kk < 8; ++kk) {
      const float4* wr = (const float4*)(w2s + (k8 * 8 + kk) * 64 + cq * 16);
      float4 w0 = wr[0], w1 = wr[1], w2 = wr[2], w3 = wr[3];
      float h = hf[kk];
      acc[0] += h * w0.x; acc[1] += h * w0.y; acc[2] += h * w0.z; acc[3] += h * w0.w;
      acc[4] += h * w1.x; acc[5] += h * w1.y; acc[6] += h * w1.z; acc[7] += h * w1.w;
      acc[8] += h * w2.x; acc[9] += h * w2.y; acc[10] += h * w2.z; acc[11] += h * w2.w;
      acc[12] += h * w3.x; acc[13] += h * w3.y; acc[14] += h * w3.z; acc[15] += h * w3.w;
    }
  }
  const int g = m & 3, n = (m >> 2) & 127, b = m >> 9;
  const bool valid = n < 127;
  if (i == 0) {
    float ss = 0.f;
#pragma unroll
    for (int d = 0; d < 16; ++d) ss += acc[d] * acc[d];
    ss += __shfl_xor(ss, 1);
    ss += __shfl_xor(ss, 2);
    const float rstd = __builtin_amdgcn_rsqf(ss * (1.f / 64.f) + EPS);
    const float* gw = p.nsa_kn + (lj * 3 + 0) * 64 + cq * 16;
#pragma unroll
    for (int d = 0; d < 16; ++d) acc[d] = acc[d] * rstd * gw[d];
    if (cq == 0) {
      const int tokc = b * 2048 + (valid ? 16 * n + 31 : 2047);
      const float* rp = (const float*)(p.ws + OFF_ROPE) + (size_t)tokc * 16;
#pragma unroll
      for (int d = 0; d < 8; ++d) {
        float c = rp[d], s = rp[8 + d];
        float x1 = acc[d], x2 = acc[d + 8];
        acc[d] = x1 * c - x2 * s;
        acc[d + 8] = x2 * c + x1 * s;
      }
    }
    bf16_t* dst = (bf16_t*)(p.ws + OFF_KCMP) + ((size_t)((b * 4 + g) * 128 + n)) * 64 + cq * 16;
    u32x4 o0, o1;
    if (valid) {
      o0.x = pack_bf2(acc[0], acc[1]); o0.y = pack_bf2(acc[2], acc[3]); o0.z = pack_bf2(acc[4], acc[5]); o0.w = pack_bf2(acc[6], acc[7]);
      o1.x = pack_bf2(acc[8], acc[9]); o1.y = pack_bf2(acc[10], acc[11]); o1.z = pack_bf2(acc[12], acc[13]); o1.w = pack_bf2(acc[14], acc[15]);
    } else {
      o0 = u32x4{0u, 0u, 0u, 0u}; o1 = o0;
    }
    *(u32x4*)(dst) = o0;
    *(u32x4*)(dst + 8) = o1;
  } else {
    bf16_t* dst = (bf16_t*)(p.ws + OFF_VCMPT) + ((size_t)((b * 4 + g) * 64 + cq * 16)) * 128 + n;
#pragma unroll
    for (int d = 0; d < 16; ++d) {
      unsigned u = pack_bf2(valid ? acc[d] : 0.f, 0.f);
      dst[(size_t)d * 128] = (bf16_t)(u & 0xffff);
    }
  }
}

DI void kmean_item(const Params& p, int item, char* smem) {
  const int tid = tidx();
  const int blk = item & 7, g = (item >> 3) & 3, b = item >> 5;
  const int d8 = tid & 7, rg = tid >> 3;
  const bf16_t* K = (const bf16_t*)(p.ws + OFF_KS) + ((size_t)(b * 2048 + blk * 256)) * 256 + g * 64 + d8 * 8;
  float s[8];
#pragma unroll
  for (int q = 0; q < 8; ++q) s[q] = 0.f;
#pragma unroll
  for (int r = 0; r < 8; ++r) {
    u32x4 v = *(const u32x4*)(K + (size_t)(rg + 32 * r) * 256);
    s[0] += bflo(v.x); s[1] += bfhi(v.x); s[2] += bflo(v.y); s[3] += bfhi(v.y);
    s[4] += bflo(v.z); s[5] += bfhi(v.z); s[6] += bflo(v.w); s[7] += bfhi(v.w);
  }
  float* red = (float*)smem;
  __syncthreads();
#pragma unroll
  for (int q = 0; q < 8; ++q) red[rg * 64 + d8 * 8 + q] = s[q];
  __syncthreads();
  if (tid < 64) {
    float t = 0.f;
    for (int r = 0; r < 32; ++r) t += red[r * 64 + tid];
    bf16_t* km = (bf16_t*)(p.ws + OFF_KMEAN) + (size_t)((b * 4 + g) * 16) * 64;
    km[blk * 64 + tid] = (bf16_t)(pack_bf2(t * (1.f / 256.f), 0.f) & 0xffff);
    km[(8 + blk) * 64 + tid] = 0;
  }
}

template <bool NOMASK>
DI void attn_block64(const bf16_t* __restrict__ Ks, const bf16_t* __restrict__ Vs, const bf16x8 (&Qb)[2][2], f32x4 (&O)[4][2], float (&mrun)[2],
                     float (&lrun)[2], const int (&lo)[2], const int (&hi)[2]) {
  const int lane = tidx() & 63, c16 = lane & 15, lg = lane >> 4;
  f32x4 Sx[4][2];
#pragma unroll
  for (int kt = 0; kt < 4; ++kt) {
    Sx[kt][0] = f32x4{0.f, 0.f, 0.f, 0.f};
    Sx[kt][1] = f32x4{0.f, 0.f, 0.f, 0.f};
#pragma unroll
    for (int ks = 0; ks < 2; ++ks) {
      bf16x8 a = *(const bf16x8*)(Ks + (kt * 16 + c16) * 72 + ks * 32 + lg * 8);
      Sx[kt][0] = mfma16(a, Qb[0][ks], Sx[kt][0]);
      Sx[kt][1] = mfma16(a, Qb[1][ks], Sx[kt][1]);
    }
  }
#pragma unroll
  for (int ct = 0; ct < 2; ++ct) {
    float mx = NEG;
#pragma unroll
    for (int kt = 0; kt < 4; ++kt)
#pragma unroll
      for (int j = 0; j < 4; ++j) {
        float s = Sx[kt][ct][j];
        if (!NOMASK) {
          const int idx = kt * 16 + j;
          s = (idx > lo[ct] && idx <= hi[ct]) ? s : NEG;
          Sx[kt][ct][j] = s;
        }
        mx = fmaxf(mx, s);
      }
    mx = fmaxf(mx, __shfl_xor(mx, 16));
    mx = fmaxf(mx, __shfl_xor(mx, 32));
    const float mn = fmaxf(mrun[ct], mx);
    const float alpha = fexp2(mrun[ct] - mn);
    mrun[ct] = mn;
    const float msafe = mn < -1e29f ? 0.f : mn;
    float rs = 0.f;
#pragma unroll
    for (int kt = 0; kt < 4; ++kt)
#pragma unroll
      for (int j = 0; j < 4; ++j) {
        float pv = fexp2(Sx[kt][ct][j] - msafe);
        Sx[kt][ct][j] = pv;
        rs += pv;
      }
    lrun[ct] = lrun[ct] * alpha + rs;
#pragma unroll
    for (int dt = 0; dt < 4; ++dt) O[dt][ct] *= alpha;
  }
#pragma unroll
  for (int kp = 0; kp < 2; ++kp) {
    bf16x8 Pb[2];
#pragma unroll
    for (int ct = 0; ct < 2; ++ct) {
      u32x4 u;
      u.x = pack_bf2(Sx[2 * kp][ct][0], Sx[2 * kp][ct][1]);
      u.y = pack_bf2(Sx[2 * kp][ct][2], Sx[2 * kp][ct][3]);
      u.z = pack_bf2(Sx[2 * kp + 1][ct][0], Sx[2 * kp + 1][ct][1]);
      u.w = pack_bf2(Sx[2 * kp + 1][ct][2], Sx[2 * kp + 1][ct][3]);
      Pb[ct] = __builtin_bit_cast(bf16x8, u);
    }
#pragma unroll
    for (int dt = 0; dt < 4; ++dt) {
      u32x2 v0 = *(const u32x2*)(Vs + (dt * 16 + c16) * 72 + kp * 32 + lg * 4);
      u32x2 v1 = *(const u32x2*)(Vs + (dt * 16 + c16) * 72 + kp * 32 + 16 + lg * 4);
      u32x4 u = u32x4{v0.x, v0.y, v1.x, v1.y};
      bf16x8 va = __builtin_bit_cast(bf16x8, u);
      O[dt][0] = mfma16(va, Pb[0], O[dt][0]);
      O[dt][1] = mfma16(va, Pb[1], O[dt][1]);
    }
  }
}

template <int MODE>
DI void attn_range(const bf16_t* __restrict__ Kg, const bf16_t* __restrict__ VTg, int j0, int j1, char* smem, int& buf, const bf16x8 (&Qb)[2][2],
                   f32x4 (&O)[4][2], float (&mrun)[2], float (&lrun)[2], const int (&tq)[2], const unsigned (&selbits)[2], int own) {
  const int tid = tidx(), lane = tid & 63, lg = lane >> 4;
  const int r0 = tid >> 3, c8 = tid & 7;
  bf16_t* sK = (bf16_t*)smem;
  bf16_t* sV = (bf16_t*)(smem + 18432);
  u32x4 rk[2], rv[2];
  if (j0 <= j1) {
#pragma unroll
    for (int i = 0; i < 2; ++i) {
      rk[i] = *(const u32x4*)(Kg + (size_t)(j0 * 64 + r0 + 32 * i) * 256 + c8 * 8);
      rv[i] = *(const u32x4*)(VTg + (size_t)(r0 + 32 * i) * 2048 + j0 * 64 + c8 * 8);
    }
  }
  for (int j = j0; j <= j1; ++j) {
    bf16_t* cK = sK + buf * (64 * 72);
    bf16_t* cV = sV + buf * (64 * 72);
#pragma unroll
    for (int i = 0; i < 2; ++i) {
      *(u32x4*)(cK + (r0 + 32 * i) * 72 + c8 * 8) = rk[i];
      *(u32x4*)(cV + (r0 + 32 * i) * 72 + c8 * 8) = rv[i];
    }
    __syncthreads();
    if (j + 1 <= j1) {
#pragma unroll
      for (int i = 0; i < 2; ++i) {
        rk[i] = *(const u32x4*)(Kg + (size_t)((j + 1) * 64 + r0 + 32 * i) * 256 + c8 * 8);
        rv[i] = *(const u32x4*)(VTg + (size_t)(r0 + 32 * i) * 2048 + (j + 1) * 64 + c8 * 8);
      }
    }
    int lo[2], hi[2];
    const int kb = j * 64;
#pragma unroll
    for (int ct = 0; ct < 2; ++ct) {
      const int rel = tq[ct] - kb - lg * 4;
      if (MODE == 0) {
        hi[ct] = ((selbits[ct] >> j) & 1u) ? (j < j1 ? 1000 : rel) : -1;
        lo[ct] = -1000;
      } else if (MODE == 1) {
        hi[ct] = rel;
        lo[ct] = rel - 256;
      } else {
        const int jb = j >> 2;
        if (jb < own) hi[ct] = ((selbits[ct] >> jb) & 1u) ? 1000 : -1;
        else hi[ct] = (j < j1 ? 1000 : rel);
        lo[ct] = -1000;
      }
    }
    const bool act = (hi[0] >= 0 && lo[0] < 63) || (hi[1] >= 0 && lo[1] < 63);
    if (__any(act)) {
      const bool full = hi[0] >= 63 && lo[0] < 0 && hi[1] >= 63 && lo[1] < 0;
      if (__all(full)) attn_block64<true>(cK, cV, Qb, O, mrun, lrun, lo, hi);
      else attn_block64<false>(cK, cV, Qb, O, mrun, lrun, lo, hi);
    }
    buf ^= 1;
  }
}

DI void load_q(const Params& p, int b, int g, int tw  , bf16x8 (&Qb)[2][2]) {
  const int lane = tidx() & 63, c16 = lane & 15, lg = lane >> 4;
  const bf16_t* q = (const bf16_t*)(p.ws + OFF_Q);
#pragma unroll
  for (int ct = 0; ct < 2; ++ct) {
    const int t = tw + ct * 4 + (c16 >> 2), head = g * 4 + (c16 & 3);
    const bf16_t* qp = q + ((size_t)(b * 2048 + t)) * 1024 + head * 64 + lg * 8;
    Qb[ct][0] = *(const bf16x8*)(qp);
    Qb[ct][1] = *(const bf16x8*)(qp + 32);
  }
}

DI void store_y(const Params& p, int b, int g, int tw, const f32x4 (&Ot)[4][2]) {
  const int lane = tidx() & 63, c16 = lane & 15, lg = lane >> 4;
  const bf16_t* sz = (const bf16_t*)(p.ws + OFF_SZ);
  bf16_t* y = (bf16_t*)(p.ws + OFF_H);
#pragma unroll
  for (int ct = 0; ct < 2; ++ct) {
    const int t = tw + ct * 4 + (c16 >> 2), head = g * 4 + (c16 & 3);
    const size_t base = ((size_t)(b * 2048 + t)) * 1024 + head * 64 + lg * 4;
#pragma unroll
    for (int dt = 0; dt < 4; ++dt) {
      u32x2 zz = *(const u32x2*)(sz + base + dt * 16);
      u32x2 o;
      o.x = pack_bf2(Ot[dt][ct][0] * bflo(zz.x), Ot[dt][ct][1] * bfhi(zz.x));
      o.y = pack_bf2(Ot[dt][ct][2] * bflo(zz.y), Ot[dt][ct][3] * bfhi(zz.y));
      *(u32x2*)(y + base + dt * 16) = o;
    }
  }
}

DI void nsa_attn_item(const Params& p, int item, char* smem) {
  const int tid = tidx(), lane = tid & 63, w = tid >> 6, c16 = lane & 15, lg = lane >> 4;
  const int bg = item & 63, qb = 63 - (item >> 6);
  const int b = bg >> 2, g = bg & 3;
  const int t0 = qb * 32, tw = t0 + w * 8;
  const int cur = t0 >> 6;
  unsigned* selm = (unsigned*)(smem + 36864);
  float* imp_main = (float*)(smem + 36992);
  float* imp_carry = (float*)(smem + 36992 + 4224);
  f32x4* Otl = (f32x4*)(smem + 36992) + tid;
  bf16x8 Qb[2][2];
  load_q(p, b, g, tw, Qb);
  int tq[2];
  float gate[2][3];
  const float* gates = (const float*)(p.ws + OFF_GATES);
#pragma unroll
  for (int ct = 0; ct < 2; ++ct) {
    tq[ct] = tw + ct * 4 + (c16 >> 2);
    const float* gp = gates + ((size_t)(b * 2048 + tq[ct])) * 48 + (g * 4 + (c16 & 3)) * 3;
    gate[ct][0] = gp[0]; gate[ct][1] = gp[1]; gate[ct][2] = gp[2];
  }
  __syncthreads();
  bf16_t* Kc = (bf16_t*)smem;
  bf16_t* VcT = (bf16_t*)(smem + 18432);
  {
    const bf16_t* kc = (const bf16_t*)(p.ws + OFF_KCMP) + (size_t)bg * 128 * 64;
    const bf16_t* vc = (const bf16_t*)(p.ws + OFF_VCMPT) + (size_t)bg * 64 * 128;
#pragma unroll
    for (int i = 0; i < 4; ++i) {
      int ch = tid + i * 256;
      int row = ch >> 3, cc = ch & 7;
      *(u32x4*)(Kc + row * 72 + cc * 8) = *(const u32x4*)(kc + row * 64 + cc * 8);
      int rv = ch >> 4, cv = ch & 15;
      *(u32x4*)(VcT + rv * 136 + cv * 8) = *(const u32x4*)(vc + rv * 128 + cv * 8);
    }
  }
  __syncthreads();
  f32x4 Ot[4][2];
#pragma unroll
  for (int ct = 0; ct < 2; ++ct) {
    f32x4 Sx[8];
#pragma unroll
    for (int kt = 0; kt < 8; ++kt) {
      Sx[kt] = f32x4{0.f, 0.f, 0.f, 0.f};
#pragma unroll
      for (int ks = 0; ks < 2; ++ks) {
        bf16x8 a = *(const bf16x8*)(Kc + (kt * 16 + c16) * 72 + ks * 32 + lg * 8);
        Sx[kt] = mfma16(a, Qb[ct][ks], Sx[kt]);
      }
    }
    {
      const int hi = ((tq[ct] - 31) >> 4) - lg * 4;
      float mx = NEG;
#pragma unroll
      for (int kt = 0; kt < 8; ++kt)
#pragma unroll
        for (int j = 0; j < 4; ++j) {
          float s = (kt * 16 + j <= hi) ? Sx[kt][j] : NEG;
          Sx[kt][j] = s;
          mx = fmaxf(mx, s);
        }
      mx = fmaxf(mx, __shfl_xor(mx, 16));
      mx = fmaxf(mx, __shfl_xor(mx, 32));
      const float msafe = mx < -1e29f ? 0.f : mx;
      float rs = 0.f;
#pragma unroll
      for (int kt = 0; kt < 8; ++kt)
#pragma unroll
        for (int j = 0; j < 4; ++j) {
          float pv = fexp2(Sx[kt][j] - msafe);
          Sx[kt][j] = pv;
          rs += pv;
        }
      rs += __shfl_xor(rs, 16);
      rs += __shfl_xor(rs, 32);
      const float inv = 1.f / fmaxf(rs, 1e-30f);
      const int qloc = w * 8 + ct * 4 + (c16 >> 2);
#pragma unroll
      for (int kt = 0; kt < 8; ++kt) {
#pragma unroll
        for (int j = 0; j < 4; ++j) Sx[kt][j] *= inv;
        float a = Sx[kt][0] + Sx[kt][1] + Sx[kt][2] + 0.5f * Sx[kt][3];
        float c = 0.5f * Sx[kt][3];
        a += __shfl_xor(a, 1);
        a += __shfl_xor(a, 2);
        c += __shfl_xor(c, 1);
        c += __shfl_xor(c, 2);
        if ((c16 & 3) == 0) {
          const int mi = kt * 4 + lg;
          imp_main[qloc * 33 + mi] = a;
          imp_carry[qloc * 34 + mi + 1] = c;
        }
      }
    }
    f32x4 O[4];
#pragma unroll
    for (int dt = 0; dt < 4; ++dt) O[dt] = f32x4{0.f, 0.f, 0.f, 0.f};
#pragma unroll
    for (int kp = 0; kp < 4; ++kp) {
      u32x4 u;
      u.x = pack_bf2(Sx[2 * kp][0], Sx[2 * kp][1]);
      u.y = pack_bf2(Sx[2 * kp][2], Sx[2 * kp][3]);
      u.z = pack_bf2(Sx[2 * kp + 1][0], Sx[2 * kp + 1][1]);
      u.w = pack_bf2(Sx[2 * kp + 1][2], Sx[2 * kp + 1][3]);
      bf16x8 Pb = __builtin_bit_cast(bf16x8, u);
#pragma unroll
      for (int dt = 0; dt < 4; ++dt) {
        u32x2 v0 = *(const u32x2*)(VcT + (dt * 16 + c16) * 136 + kp * 32 + lg * 4);
        u32x2 v1 = *(const u32x2*)(VcT + (dt * 16 + c16) * 136 + kp * 32 + 16 + lg * 4);
        u32x4 uu = u32x4{v0.x, v0.y, v1.x, v1.y};
        bf16x8 va = __builtin_bit_cast(bf16x8, uu);
        O[dt] = mfma16(va, Pb, O[dt]);
      }
    }
#pragma unroll
    for (int dt = 0; dt < 4; ++dt) Ot[dt][ct] = O[dt] * gate[ct][0];
  }
  __syncthreads();
  if (tid < 32) {
    unsigned mask = 1u | (1u << cur);
    if (cur >= 1) mask |= 1u << (cur - 1);
    const int need = 8 - __popc(mask);
    for (int it = 0; it < need; ++it) {
      float bv = -1.f;
      int best = -1;
      for (int j = 1; j <= cur - 2; ++j) {
        if (!((mask >> j) & 1u)) {
          float v = imp_main[tid * 33 + j] + imp_carry[tid * 34 + j];
          if (v > bv) { bv = v; best = j; }
        }
      }
      if (best < 0) break;
      mask |= 1u << best;
    }
    selm[tid] = mask;
  }
  __syncthreads();
  unsigned selbits[2];
#pragma unroll
  for (int ct = 0; ct < 2; ++ct) selbits[ct] = selm[w * 8 + ct * 4 + (c16 >> 2)];
#pragma unroll
  for (int dt = 0; dt < 4; ++dt)
#pragma unroll
    for (int ct = 0; ct < 2; ++ct) Otl[(dt * 2 + ct) * 256] = Ot[dt][ct];
  int buf = 0;
  {
    f32x4 O[4][2];
    float mrun[2] = {NEG, NEG}, lrun[2] = {0.f, 0.f};
#pragma unroll
    for (int dt = 0; dt < 4; ++dt) { O[dt][0] = f32x4{0.f, 0.f, 0.f, 0.f}; O[dt][1] = f32x4{0.f, 0.f, 0.f, 0.f}; }
    const bf16_t* Kg = (const bf16_t*)(p.ws + OFF_KS) + (size_t)b * 2048 * 256 + g * 64;
    const bf16_t* VTg = (const bf16_t*)(p.ws + OFF_VST) + (size_t)bg * 64 * 2048;
    attn_range<0>(Kg, VTg, 0, cur, smem, buf, Qb, O, mrun, lrun, tq, selbits, 0);
#pragma unroll
    for (int ct = 0; ct < 2; ++ct) {
      float l = lrun[ct];
      l += __shfl_xor(l, 16);
      l += __shfl_xor(l, 32);
      const float sc = gate[ct][1] / fmaxf(l, 1e-30f);
#pragma unroll
      for (int dt = 0; dt < 4; ++dt) Otl[(dt * 2 + ct) * 256] = Otl[(dt * 2 + ct) * 256] + O[dt][ct] * sc;
    }
  }
  {
    f32x4 O[4][2];
    float mrun[2] = {NEG, NEG}, lrun[2] = {0.f, 0.f};
#pragma unroll
    for (int dt = 0; dt < 4; ++dt) { O[dt][0] = f32x4{0.f, 0.f, 0.f, 0.f}; O[dt][1] = f32x4{0.f, 0.f, 0.f, 0.f}; }
    const bf16_t* Kg = (const bf16_t*)(p.ws + OFF_KW) + (size_t)b * 2048 * 256 + g * 64;
    const bf16_t* VTg = (const bf16_t*)(p.ws + OFF_VWT) + (size_t)bg * 64 * 2048;
    int jlo = t0 - 255;
    jlo = jlo < 0 ? 0 : (jlo >> 6);
    attn_range<1>(Kg, VTg, jlo, cur, smem, buf, Qb, O, mrun, lrun, tq, selbits, 0);
#pragma unroll
    for (int ct = 0; ct < 2; ++ct) {
      float l = lrun[ct];
      l += __shfl_xor(l, 16);
      l += __shfl_xor(l, 32);
      const float sc = gate[ct][2] / fmaxf(l, 1e-30f);
#pragma unroll
      for (int dt = 0; dt < 4; ++dt) Ot[dt][ct] = Otl[(dt * 2 + ct) * 256] + O[dt][ct] * sc;
    }
  }
  store_y(p, b, g, tw, Ot);
}

DI void moba_attn_item(const Params& p, int item, char* smem) {
  const int tid = tidx(), lane = tid & 63, w = tid >> 6, c16 = lane & 15, lg = lane >> 4;
  const int bg = item & 63, qb = 63 - (item >> 6);
  const int b = bg >> 2, g = bg & 3;
  const int t0 = qb * 32, tw = t0 + w * 8;
  const int own = t0 >> 8;
  bf16x8 Qb[2][2];
  load_q(p, b, g, tw, Qb);
  int tq[2];
#pragma unroll
  for (int ct = 0; ct < 2; ++ct) tq[ct] = tw + ct * 4 + (c16 >> 2);
  __syncthreads();
  bf16_t* Km = (bf16_t*)(smem + 36864);
  if (tid < 128) {
    int row = tid >> 3, cc = tid & 7;
    *(u32x4*)(Km + row * 72 + cc * 8) = *(const u32x4*)((const bf16_t*)(p.ws + OFF_KMEAN) + (size_t)bg * 16 * 64 + row * 64 + cc * 8);
  }
  __syncthreads();
  unsigned selbits[2];
#pragma unroll
  for (int ct = 0; ct < 2; ++ct) {
    f32x4 sg = f32x4{0.f, 0.f, 0.f, 0.f};
#pragma unroll
    for (int ks = 0; ks < 2; ++ks) {
      bf16x8 a = *(const bf16x8*)(Km + c16 * 72 + ks * 32 + lg * 8);
      sg = mfma16(a, Qb[ct][ks], sg);
    }
    f32x4 ot;
#pragma unroll
    for (int j = 0; j < 4; ++j) ot[j] = __shfl_xor(sg[j], 16);
    const bool odd = (lg & 1) != 0;
    float v0 = odd ? ot[0] : sg[0], v1 = odd ? ot[1] : sg[1], v2 = odd ? ot[2] : sg[2], v3 = odd ? ot[3] : sg[3];
    float v4 = odd ? sg[0] : ot[0], v5 = odd ? sg[1] : ot[1], v6 = odd ? sg[2] : ot[2], v7 = odd ? sg[3] : ot[3];
    unsigned sel = 0;
#pragma unroll
    for (int it = 0; it < 3; ++it) {
      float bv = -3.0e38f;
      int best = -1;
#define CAND(J, V) if ((J) < own && !((sel >> (J)) & 1u) && (V) > bv) { bv = (V); best = (J); }
      CAND(0, v0) CAND(1, v1) CAND(2, v2) CAND(3, v3) CAND(4, v4) CAND(5, v5) CAND(6, v6) CAND(7, v7)
#undef CAND
      if (best >= 0) sel |= 1u << best;
    }
    selbits[ct] = (unsigned)__shfl((int)sel, c16);
  }
  int buf = 0;
  f32x4 O[4][2];
  float mrun[2] = {NEG, NEG}, lrun[2] = {0.f, 0.f};
#pragma unroll
  for (int dt = 0; dt < 4; ++dt) { O[dt][0] = f32x4{0.f, 0.f, 0.f, 0.f}; O[dt][1] = f32x4{0.f, 0.f, 0.f, 0.f}; }
  const bf16_t* Kg = (const bf16_t*)(p.ws + OFF_KS) + (size_t)b * 2048 * 256 + g * 64;
  const bf16_t* VTg = (const bf16_t*)(p.ws + OFF_VST) + (size_t)bg * 64 * 2048;
  attn_range<2>(Kg, VTg, 0, t0 >> 6, smem, buf, Qb, O, mrun, lrun, tq, selbits, own);
#pragma unroll
  for (int ct = 0; ct < 2; ++ct) {
    float l = lrun[ct];
    l += __shfl_xor(l, 16);
    l += __shfl_xor(l, 32);
    const float sc = 1.f / fmaxf(l, 1e-30f);
#pragma unroll
    for (int dt = 0; dt < 4; ++dt) O[dt][ct] *= sc;
  }
  store_y(p, b, g, tw, O);
}

DI void outproj_tile(const Params& p, int layer, const float* __restrict__ xin, int tile, char* smem) {
  const bool nsa = (layer & 1) == 0;
  const int lj = layer >> 1;
  const int mtile = tile >> 3, ntile = tile & 7;
  const int m0 = mtile * 128, n0 = ntile * 128;
  const int tid = tidx(), lane = tid & 63, w = tid >> 6, wm = w >> 1, wn = w & 1, c16 = lane & 15, lg = lane >> 4;
  const bf16_t* A = (const bf16_t*)(p.ws + OFF_H);
  const bf16_t* Bt = (const bf16_t*)(p.ws + (nsa ? OFF_WT_NSA_OUT : OFF_WT_MOBA_OUT)) + (size_t)lj * 1024 * 1024;
  unsigned aoff[4];
#pragma unroll
  for (int i = 0; i < 4; ++i) aoff[i] = (unsigned)(m0 + (tid >> 3) + 32 * i) * 1024u;
  f32x4 acc[4][4];
  gemm_mainloop<true>(A, aoff, 64, Bt, 1024, n0, smem, acc);
  const int b = m0 >> 11;
  const float* gatev = (const float*)(p.ws + OFF_MOD) + (size_t)(layer * 16 + b) * 3072 + 2048;
#pragma unroll
  for (int nt = 0; nt < 4; ++nt) {
    const int n = n0 + wn * 64 + nt * 16 + lg * 4;
    const float4 gv = *(const float4*)(gatev + n);
#pragma unroll
    for (int mt = 0; mt < 4; ++mt) {
      const int m = m0 + wm * 64 + mt * 16 + c16;
      const float4 xv = *(const float4*)(xin + (size_t)m * 1024 + n);
      float4 o;
      o.x = xv.x + gv.x * acc[nt][mt][0];
      o.y = xv.y + gv.y * acc[nt][mt][1];
      o.z = xv.z + gv.z * acc[nt][mt][2];
      o.w = xv.w + gv.w * acc[nt][mt][3];
      *(float4*)(p.out + (size_t)m * 1024 + n) = o;
    }
  }
}

DI void run_phase(const Params& pin, int layer, int ph, char* smem) {
  Params p = pin;
  asm volatile("" : "+s"(p.ws), "+s"(p.out));
  const int G = gridDim.x, bid = blockIdx.x;
  const bool nsa = (layer & 1) == 0;
  const int lj = layer >> 1;
  const float* xin = layer == 0 ? p.x : p.out;
  if (ph == 0) {
    for (int it = bid; it < NW_TOTAL; it += G) phaseW_item(p, it, smem);
  } else if (ph == 1) {
    for (int it = bid; it < NTOK / 4; it += G) prep_item(p, layer, xin, it);
  } else if (ph == 2) {
    const int n = 256 * (nsa ? 29 : 20);
    for (int it = bid; it < n; it += G) inproj_tile(p, layer, it, smem);
  } else if (ph == 3) {
    if (nsa) { for (int it = bid; it < 256; it += G) cmp1_tile(p, lj, it, smem); }
    else { for (int it = bid; it < 512; it += G) kmean_item(p, it, smem); }
  } else if (ph == 4) {
    if (nsa) for (int it = bid; it < 256; it += G) cmp2_item(p, lj, it, smem);
  } else if (ph == 5) {
#ifndef ONLY_MOBA
    if (nsa) { for (int it = bid; it < 4096; it += G) nsa_attn_item(p, it, smem); }
#endif
#ifndef ONLY_NSA
    if (!nsa) { for (int it = bid; it < 4096; it += G) moba_attn_item(p, it, smem); }
#endif
  } else if (ph == 6) {
    for (int it = bid; it < 2048; it += G) outproj_tile(p, layer, xin, it, smem);
  }
}

#if MULTI_LAUNCH
template <int PH>
__global__ void __launch_bounds__(256, 2) phase_kernel(Params p, int layer) {
  __shared__ __attribute__((aligned(16))) char smem[SMEM_BYTES];
  run_phase(p, layer, PH, smem);
}
#else
__global__ void __launch_bounds__(256, 2) mega_kernel(Params p) {
  __shared__ __attribute__((aligned(16))) char smem[SMEM_BYTES];
  cg::grid_group grid = cg::this_grid();
  run_phase(p, 0, 0, smem);
  grid.sync();
  for (int layer = 0; layer < 4; ++layer) {
    const bool nsa = (layer & 1) == 0;
    run_phase(p, layer, 1, smem);
    grid.sync();
    run_phase(p, layer, 2, smem);
    grid.sync();
    run_phase(p, layer, 3, smem);
    grid.sync();
    if (nsa) {
      run_phase(p, layer, 4, smem);
      grid.sync();
    }
    run_phase(p, layer, 5, smem);
    grid.sync();
    run_phase(p, layer, 6, smem);
    if (layer < 3) grid.sync();
  }
}
#endif

extern "C" void kernel_launch(void* const* d_in, const int* in_sizes, int n_in, void* d_out, int out_size, void* d_ws, size_t ws_size,
                              hipStream_t stream) {
  Params p{};
  p.x = (const float*)d_in[0];
  p.c = (const float*)d_in[1];
  p.pos = (const int*)d_in[2];
  p.norm_g = (const float*)d_in[3];
  p.ada_w = (const float*)d_in[4];
  p.ada_b = (const float*)d_in[5];
  p.nsa_w_in = (const float*)d_in[6];
  p.nsa_w_out = (const float*)d_in[7];
  p.nsa_qn = (const float*)d_in[8];
  p.nsa_kn = (const float*)d_in[9];
  p.cmp_pe = (const float*)d_in[10];
  p.cmp_w1 = (const float*)d_in[11];
  p.cmp_b1 = (const float*)d_in[12];
  p.cmp_w2 = (const float*)d_in[13];
  p.gate_b = (const float*)d_in[14];
  p.moba_w_in = (const float*)d_in[15];
  p.moba_w_out = (const float*)d_in[16];
  p.moba_qn = (const float*)d_in[17];
  p.moba_kn = (const float*)d_in[18];
  p.out = (float*)d_out;
  p.ws = (char*)d_ws;
  if (ws_size < WS_TOTAL) { fprintf(stderr, "workspace too small: %zu < %zu\n", ws_size, (size_t)WS_TOTAL); return; }
#if MULTI_LAUNCH
  const int G = 512;
  phase_kernel<0><<<G, 256, 0, stream>>>(p, 0);
  for (int layer = 0; layer < 4; ++layer) {
    phase_kernel<1><<<G, 256, 0, stream>>>(p, layer);
    phase_kernel<2><<<G, 256, 0, stream>>>(p, layer);
    phase_kernel<3><<<G, 256, 0, stream>>>(p, layer);
    if (!(layer & 1)) phase_kernel<4><<<G, 256, 0, stream>>>(p, layer);
    phase_kernel<5><<<G, 256, 0, stream>>>(p, layer);
    phase_kernel<6><<<G, 256, 0, stream>>>(p, layer);
  }
#else
  static int grid_blocks = 0;
  if (!grid_blocks) {
    int dev = 0, cus = 0, per_cu = 0;
    (void)hipGetDevice(&dev);
    (void)hipDeviceGetAttribute(&cus, hipDeviceAttributeMultiprocessorCount, dev);
    (void)hipOccupancyMaxActiveBlocksPerMultiprocessor(&per_cu, mega_kernel, 256, 0);
    if (per_cu > 2) per_cu = 2;
    grid_blocks = cus * per_cu;
  }
  void* args[] = {&p};
  hipError_t e = hipLaunchCooperativeKernel((void*)mega_kernel, dim3(grid_blocks), dim3(256), args, 0, stream);
  if (e != hipSuccess) fprintf(stderr, "cooperative launch failed: %s (grid %d)\n", hipGetErrorString(e), grid_blocks);
#endif
}
```

```cpp
#include <hip/hip_runtime.h>
#include <hip/hip_cooperative_groups.h>
#include <cstdio>
namespace cg = cooperative_groups;

#ifndef MULTI_LAUNCH
#define MULTI_LAUNCH 0
#endif

#define DI __device__ __forceinline__
typedef unsigned short bf16_t;
using bf16x8 = __attribute__((ext_vector_type(8))) short;
using f32x4 = __attribute__((ext_vector_type(4))) float;
typedef __bf16 bf16x2_t __attribute__((ext_vector_type(2)));
typedef float f32x2_t __attribute__((ext_vector_type(2)));
using u32x4 = __attribute__((ext_vector_type(4))) unsigned;
using u32x2 = __attribute__((ext_vector_type(2))) unsigned;

constexpr int DM = 1024, NB = 16, SEQ = 2048, NTOK = NB * SEQ;
constexpr int NSA_IN = 3632, NSA_NP = 3712, MOBA_IN = 2560;
constexpr float EPS = 1e-6f;
constexpr float QSCALE = 0.125f * 1.4426950408889634f;
constexpr float NEG = -1e30f;

constexpr size_t SZ_WT_NSA_IN = (size_t)2 * NSA_NP * 1024 * 2;
constexpr size_t SZ_WT_SQ = (size_t)2 * 1024 * 1024 * 2;
constexpr size_t SZ_WT_MOBA_IN = (size_t)2 * MOBA_IN * 1024 * 2;
constexpr size_t SZ_WT_CMP1 = (size_t)4 * 256 * 2048 * 2;
constexpr size_t SZ_ACT = (size_t)NTOK * 1024 * 2;
constexpr size_t SZ_KV = (size_t)NTOK * 256 * 2;
constexpr size_t OFF_WT_NSA_IN = 0;
constexpr size_t OFF_WT_NSA_OUT = OFF_WT_NSA_IN + SZ_WT_NSA_IN;
constexpr size_t OFF_WT_MOBA_IN = OFF_WT_NSA_OUT + SZ_WT_SQ;
constexpr size_t OFF_WT_MOBA_OUT = OFF_WT_MOBA_IN + SZ_WT_MOBA_IN;
constexpr size_t OFF_WT_CMP1 = OFF_WT_MOBA_OUT + SZ_WT_SQ;
constexpr size_t OFF_B1EFF = OFF_WT_CMP1 + SZ_WT_CMP1;
constexpr size_t OFF_ROPE = OFF_B1EFF + 4096;
constexpr size_t OFF_MOD = OFF_ROPE + (size_t)NTOK * 16 * 4;
constexpr size_t OFF_H = OFF_MOD + (size_t)4 * 16 * 3072 * 4;
constexpr size_t OFF_Q = OFF_H + SZ_ACT;
constexpr size_t OFF_SZ = OFF_Q + SZ_ACT;
constexpr size_t OFF_KC = OFF_SZ + SZ_ACT;
constexpr size_t OFF_VC = OFF_KC + SZ_KV;
constexpr size_t OFF_KS = OFF_VC + SZ_KV;
constexpr size_t OFF_KW = OFF_KS + SZ_KV;
constexpr size_t OFF_VST = OFF_KW + SZ_KV;
constexpr size_t OFF_VWT = OFF_VST + SZ_KV;
constexpr size_t OFF_GATES = OFF_VWT + SZ_KV;
constexpr size_t OFF_HID = OFF_GATES + (size_t)NTOK * 48 * 4;
constexpr size_t OFF_KCMP = OFF_HID + (size_t)2 * 8192 * 256 * 2;
constexpr size_t OFF_VCMPT = OFF_KCMP + (size_t)64 * 128 * 64 * 2;
constexpr size_t OFF_KMEAN = OFF_VCMPT + (size_t)64 * 128 * 64 * 2;
constexpr size_t OFF_BAR = OFF_KMEAN + (size_t)64 * 16 * 64 * 2;
constexpr size_t BAR_BYTES = 3456 * 4;
constexpr size_t WS_TOTAL = OFF_BAR + 16384;

struct Params {
  const float *x, *c;
  const int* pos;
  const float *norm_g, *ada_w, *ada_b, *nsa_w_in, *nsa_w_out, *nsa_qn, *nsa_kn, *cmp_pe, *cmp_w1, *cmp_b1, *cmp_w2, *gate_b,
      *moba_w_in, *moba_w_out, *moba_qn, *moba_kn;
  float* out;
  char* ws;
};

constexpr int SMEM_BYTES = 73728;

DI int tidx() {
  int t = __builtin_amdgcn_workitem_id_x();
  asm volatile("" : "+v"(t));
  return t;
}
DI unsigned pack_bf2(float a, float b) {
  f32x2_t v = {a, b};
  bf16x2_t r = __builtin_convertvector(v, bf16x2_t);
  return __builtin_bit_cast(unsigned, r);
}
DI float bf2f(bf16_t v) { return __uint_as_float(((unsigned)v) << 16); }
DI float bflo(unsigned u) { return __uint_as_float(u << 16); }
DI float bfhi(unsigned u) { return __uint_as_float(u & 0xffff0000u); }
DI f32x4 mfma16(bf16x8 a, bf16x8 b, f32x4 c) { return __builtin_amdgcn_mfma_f32_16x16x32_bf16(a, b, c, 0, 0, 0); }
DI float fexp2(float x) { return __builtin_amdgcn_exp2f(x); }
DI float sigmoidf_(float x) { return 1.f / (1.f + __expf(-x)); }
DI float siluf_(float x) { return x / (1.f + __expf(-x)); }
DI float geluf_(float x) {
  float u = 0.7978845608028654f * (x + 0.044715f * x * x * x);
  float t = 1.f - 2.f / (__expf(2.f * u) + 1.f);
  return 0.5f * x * (1.f + t);
}


#define XB_TMO      128
#define XB_XCNT(j)  (256  + 64 * (j))
#define XB_XSUB(j)  (1280 + 64 * (j))
#define XB_XGEN(j)  (2304 + 64 * (j))
#define XB_TOP      3328
#define XB_TOPGEN   3392
#define XB_SPIN_CAP (1u << 22)
#define LAS __attribute__((address_space(3)))
DI unsigned xb_ld(unsigned* p) { return __hip_atomic_load(p, __ATOMIC_RELAXED, __HIP_MEMORY_SCOPE_AGENT); }
DI unsigned xb_add(unsigned* p, unsigned v) { return __hip_atomic_fetch_add(p, v, __ATOMIC_RELAXED, __HIP_MEMORY_SCOPE_AGENT); }
DI unsigned xb_xcc_id() { return (unsigned)__builtin_amdgcn_s_getreg((3 << 11) | 20) & 0xFu; }
#define XB_SPIN(cond, bar) do { unsigned _sp = 0; while (cond) { __builtin_amdgcn_s_sleep(1); \
    if ((++_sp & 255u) == 0u) { if (xb_ld(&(bar)[XB_TMO])) break; if (_sp > XB_SPIN_CAP) { atomicAdd(&(bar)[XB_TMO], 1u); break; } } } } while (0)
struct XcdBarrier { unsigned* bar; unsigned x; volatile LAS unsigned* st; };
DI XcdBarrier xcd_barrier_post(unsigned* bar, volatile LAS unsigned* st) {
  XcdBarrier b; b.bar = bar; b.x = xb_xcc_id(); b.st = st;
  if (__builtin_amdgcn_workitem_id_x() == 0) (void)xb_add(&bar[XB_XCNT(b.x)], 1u);
  return b;
}
DI void xcd_barrier_complete(unsigned* bar, unsigned x, unsigned& nloc, unsigned& nx) {
  const unsigned G = gridDim.x * gridDim.y * gridDim.z;
  unsigned sum, cnt, mine, sp = 0u;
  for (;;) {
    sum = 0u; cnt = 0u; mine = 0u;
#pragma unroll
    for (unsigned j = 0; j < 16; ++j) { const unsigned c = xb_ld(&bar[XB_XCNT(j)]); sum += c; cnt += (c > 0u) ? 1u : 0u; mine = (j == x) ? c : mine; }
    if (sum == G) break;
    __builtin_amdgcn_s_sleep(1);
    if ((++sp & 255u) == 0u) { if (xb_ld(&bar[XB_TMO])) break; if (sp > XB_SPIN_CAP) { atomicAdd(&bar[XB_TMO], 1u); break; } }
  }
  nloc = mine > 0u ? mine : 1u; nx = cnt > 0u ? cnt : 1u;
}
DI void xcd_barrier(const XcdBarrier& b) {
  asm volatile("s_waitcnt vmcnt(0)" ::: "memory");
  __syncthreads();
  if (__builtin_amdgcn_workitem_id_x() == 0) {
    unsigned* bar = b.bar;
    __builtin_amdgcn_s_waitcnt(0);
    unsigned nloc = b.st[0], nx = b.st[1];
    if (nloc == 0u) { xcd_barrier_complete(bar, b.x, nloc, nx); b.st[0] = nloc; b.st[1] = nx; }
    const unsigned old = xb_add(&bar[XB_XSUB(b.x)], 1u);
    const unsigned gen = old / nloc;
    if (old + 1u == (gen + 1u) * nloc) {
      __builtin_amdgcn_fence(__ATOMIC_RELEASE, "agent");
      asm volatile("s_waitcnt vmcnt(0)" ::: "memory");
      const unsigned og = xb_add(&bar[XB_TOP], 1u);
      const unsigned tg = og / nx;
      if (og + 1u == (tg + 1u) * nx) xb_add(&bar[XB_TOPGEN], 1u);
      else XB_SPIN(xb_ld(&bar[XB_TOPGEN]) == tg, bar);
      __builtin_amdgcn_fence(__ATOMIC_ACQUIRE, "agent");
      xb_add(&bar[XB_XGEN(b.x)], 1u);
      asm volatile("s_waitcnt vmcnt(0)" ::: "memory");
    } else {
      XB_SPIN(xb_ld(&bar[XB_XGEN(b.x)]) == gen, bar);
      __builtin_amdgcn_fence(__ATOMIC_ACQUIRE, "agent");
      asm volatile("s_waitcnt vmcnt(0)" ::: "memory");
    }
  }
  __syncthreads();
}

DI void ada_item(const Params& p, int item, char* smem) {
  const int tid = tidx();
  const int l = item / 48, n0 = (item % 48) * 64;
  float* cond = (float*)smem;
  __syncthreads();
  for (int i = tid; i < 16 * 1024; i += 256) {
    int b = i >> 10, k = i & 1023;
    float v = p.c[i];
    cond[k * 16 + b] = siluf_(v);
  }
  __syncthreads();
  const int kq = tid >> 6, col = tid & 63;
  float acc[16];
#pragma unroll
  for (int b = 0; b < 16; ++b) acc[b] = 0.f;
  const float* w = p.ada_w + (size_t)l * 1024 * 3072 + n0 + col;
#pragma unroll 4
  for (int k = kq * 256; k < kq * 256 + 256; ++k) {
    float wv = w[(size_t)k * 3072];
    const float4* cp = (const float4*)(cond + k * 16);
    float4 c0 = cp[0], c1 = cp[1], c2 = cp[2], c3 = cp[3];
    acc[0] += wv * c0.x; acc[1] += wv * c0.y; acc[2] += wv * c0.z; acc[3] += wv * c0.w;
    acc[4] += wv * c1.x; acc[5] += wv * c1.y; acc[6] += wv * c1.z; acc[7] += wv * c1.w;
    acc[8] += wv * c2.x; acc[9] += wv * c2.y; acc[10] += wv * c2.z; acc[11] += wv * c2.w;
    acc[12] += wv * c3.x; acc[13] += wv * c3.y; acc[14] += wv * c3.z; acc[15] += wv * c3.w;
  }
  __syncthreads();
  float* red = (float*)smem;
#pragma unroll
  for (int b = 0; b < 16; ++b) red[(kq * 16 + b) * 64 + col] = acc[b];
  __syncthreads();
  float* mod = (float*)(p.ws + OFF_MOD);
  for (int i = tid; i < 16 * 64; i += 256) {
    int b = i >> 6, cc = i & 63;
    float s = red[(0 * 16 + b) * 64 + cc] + red[(16 + b) * 64 + cc] + red[(32 + b) * 64 + cc] + red[(48 + b) * 64 + cc];
    mod[(size_t)(l * 16 + b) * 3072 + n0 + cc] = s + p.ada_b[l * 3072 + n0 + cc];
  }
}

DI void b1eff_item(const Params& p, int item, char* smem) {
  const int tid = tidx();
  const int li = item >> 4, h0 = (item & 15) * 16;
  const int kg = tid >> 4, hh = tid & 15;
  const float* W1 = p.cmp_w1 + (size_t)li * 2048 * 256;
  const float* pe = p.cmp_pe + li * 2048;
  float acc = 0.f;
#pragma unroll 8
  for (int k = kg * 128; k < kg * 128 + 128; ++k) acc += pe[k] * W1[(size_t)k * 256 + h0 + hh];
  float* red = (float*)smem;
  __syncthreads();
  red[kg * 16 + hh] = acc;
  __syncthreads();
  if (tid < 16) {
    float s = 0.f;
    for (int g = 0; g < 16; ++g) s += red[g * 16 + tid];
    ((float*)(p.ws + OFF_B1EFF))[li * 256 + h0 + tid] = s + p.cmp_b1[li * 256 + h0 + tid];
  }
}

DI void rope_item(const Params& p, int item) {
  const int idx = item * 256 + tidx();
  const int tok = idx >> 3, i = idx & 7;
  const float invf[8] = {1.0f, 0.1939227432012558f, 0.03760603070259094f, 0.007292664609849453f,
                         0.0014142135623842478f, 0.00027424818836152554f, 5.318296098266728e-05f, 1.0313386155758053e-05f};
  float f = i == 0 ? invf[0] : i == 1 ? invf[1] : i == 2 ? invf[2] : i == 3 ? invf[3] : i == 4 ? invf[4] : i == 5 ? invf[5] : i == 6 ? invf[6] : invf[7];
  float ang = (float)p.pos[tok] * f;
  double rev = (double)ang * 0.15915494309189535;
  double fr = rev - floor(rev);
  float frf = (float)fr;
  float* rope = (float*)(p.ws + OFF_ROPE);
  rope[(size_t)tok * 16 + i] = __builtin_amdgcn_cosf(frf);
  rope[(size_t)tok * 16 + 8 + i] = __builtin_amdgcn_sinf(frf);
}

DI void transpose_item(const float* __restrict__ src, int K, int Nsrc, bf16_t* __restrict__ dst, int k0, int n0, int mapmode, char* smem) {
  float* tile = (float*)smem;
  const int tid = tidx();
  __syncthreads();
#pragma unroll 4
  for (int i = 0; i < 16; ++i) {
    int kk = i * 4 + (tid >> 6), nn = tid & 63;
    int nd = n0 + nn, ns = nd;
    if (mapmode == 1) ns = nd < 2560 ? nd : (nd < 3584 ? nd + 48 : (nd < 3632 ? nd - 1024 : -1));
    float v = ns >= 0 ? src[(size_t)(k0 + kk) * Nsrc + ns] : 0.f;
    tile[kk * 65 + nn] = v;
  }
  __syncthreads();
#pragma unroll 4
  for (int i = 0; i < 16; ++i) {
    int nn = i * 4 + (tid >> 6), kk = tid & 63;
    float v = tile[kk * 65 + nn];
    unsigned u = pack_bf2(v, 0.f);
    dst[(size_t)(n0 + nn) * K + k0 + kk] = (bf16_t)(u & 0xffff);
  }
}

constexpr int NW_ADA = 192, NW_B1 = 64, NW_ROPE = 1024;
constexpr int NW_T_NSA_IN = 16 * 58, NW_T_SQ = 256, NW_T_MOBA_IN = 16 * 40, NW_T_CMP = 128;
constexpr int NW_TRANS = 2 * NW_T_NSA_IN + 2 * NW_T_SQ + 2 * NW_T_MOBA_IN + 2 * NW_T_SQ + 4 * NW_T_CMP;
constexpr int NW_TOTAL = NW_ADA + NW_B1 + NW_ROPE + NW_TRANS;

DI void phaseW_item(const Params& p, int it, char* smem) {
  if (it < NW_ADA) { ada_item(p, it, smem); return; }
  it -= NW_ADA;
  if (it < NW_B1) { b1eff_item(p, it, smem); return; }
  it -= NW_B1;
  if (it < NW_ROPE) { rope_item(p, it); return; }
  it -= NW_ROPE;
  if (it < 2 * NW_T_NSA_IN) {
    int l = it / NW_T_NSA_IN, t = it % NW_T_NSA_IN;
    transpose_item(p.nsa_w_in + (size_t)l * 1024 * NSA_IN, 1024, NSA_IN, (bf16_t*)(p.ws + OFF_WT_NSA_IN) + (size_t)l * NSA_NP * 1024,
                   (t % 16) * 64, (t / 16) * 64, 1, smem);
    return;
  }
  it -= 2 * NW_T_NSA_IN;
  if (it < 2 * NW_T_SQ) {
    int l = it / NW_T_SQ, t = it % NW_T_SQ;
    transpose_item(p.nsa_w_out + (size_t)l * 1024 * 1024, 1024, 1024, (bf16_t*)(p.ws + OFF_WT_NSA_OUT) + (size_t)l * 1024 * 1024,
                   (t % 16) * 64, (t / 16) * 64, 0, smem);
    return;
  }
  it -= 2 * NW_T_SQ;
  if (it < 2 * NW_T_MOBA_IN) {
    int l = it / NW_T_MOBA_IN, t = it % NW_T_MOBA_IN;
    transpose_item(p.moba_w_in + (size_t)l * 1024 * MOBA_IN, 1024, MOBA_IN, (bf16_t*)(p.ws + OFF_WT_MOBA_IN) + (size_t)l * MOBA_IN * 1024,
                   (t % 16) * 64, (t / 16) * 64, 0, smem);
    return;
  }
  it -= 2 * NW_T_MOBA_IN;
  if (it < 2 * NW_T_SQ) {
    int l = it / NW_T_SQ, t = it % NW_T_SQ;
    transpose_item(p.moba_w_out + (size_t)l * 1024 * 1024, 1024, 1024, (bf16_t*)(p.ws + OFF_WT_MOBA_OUT) + (size_t)l * 1024 * 1024,
                   (t % 16) * 64, (t / 16) * 64, 0, smem);
    return;
  }
  it -= 2 * NW_T_SQ;
  {
    int li = it / NW_T_CMP, t = it % NW_T_CMP;
    transpose_item(p.cmp_w1 + (size_t)li * 2048 * 256, 2048, 256, (bf16_t*)(p.ws + OFF_WT_CMP1) + (size_t)li * 256 * 2048,
                   (t % 32) * 64, (t / 32) * 64, 0, smem);
  }
}

DI void prep_item(const Params& p, int layer, const float* __restrict__ xin, int item) {
  const int lane = tidx() & 63, w = tidx() >> 6;
  const int tok = item * 4 + w;
  const int b = tok >> 11;
  const float4* xr = (const float4*)(xin + (size_t)tok * 1024);
  float4 v[4];
  float ss = 0.f;
#pragma unroll
  for (int i = 0; i < 4; ++i) {
    v[i] = xr[lane + i * 64];
    ss += v[i].x * v[i].x + v[i].y * v[i].y + v[i].z * v[i].z + v[i].w * v[i].w;
  }
#pragma unroll
  for (int o = 32; o >= 1; o >>= 1) ss += __shfl_xor(ss, o);
  const float rstd = __builtin_amdgcn_rsqf(ss * (1.f / 1024.f) + EPS);
  const float* mod = (const float*)(p.ws + OFF_MOD) + (size_t)(layer * 16 + b) * 3072;
  const float4* g4 = (const float4*)(p.norm_g + layer * 1024);
  const float4* sh4 = (const float4*)(mod);
  const float4* sc4 = (const float4*)(mod + 1024);
  u32x2* hr = (u32x2*)((bf16_t*)(p.ws + OFF_H) + (size_t)tok * 1024);
#pragma unroll
  for (int i = 0; i < 4; ++i) {
    int c = lane + i * 64;
    float4 g = g4[c], sh = sh4[c], sc = sc4[c];
    float a0 = v[i].x * rstd * g.x * (1.f + sc.x) + sh.x;
    float a1 = v[i].y * rstd * g.y * (1.f + sc.y) + sh.y;
    float a2 = v[i].z * rstd * g.z * (1.f + sc.z) + sh.z;
    float a3 = v[i].w * rstd * g.w * (1.f + sc.w) + sh.w;
    u32x2 o;
    o.x = pack_bf2(a0, a1);
    o.y = pack_bf2(a2, a3);
    hr[c] = o;
  }
}

template <bool SWAP>
DI void gemm_mainloop(const bf16_t* __restrict__ A, const unsigned (&aoff)[4], int a_kstride, const bf16_t* __restrict__ Bt, int K, int n0,
                      char* smem, f32x4 (&acc)[4][4]) {
  bf16_t* sA = (bf16_t*)smem;
  bf16_t* sB = (bf16_t*)(smem + 36864);
  const int tid = tidx(), lane = tid & 63, w = tid >> 6;
  const int wm = w >> 1, wn = w & 1, c16 = lane & 15, lg = lane >> 4;
  const int r0 = tid >> 3, c8 = tid & 7;
  const int nk = K >> 6;
  u32x4 ra[4], rb[4];
  const bf16_t* bbase = Bt + (size_t)(n0 + r0) * K + c8 * 8;
#pragma unroll
  for (int i = 0; i < 4; ++i) {
    ra[i] = *(const u32x4*)(A + aoff[i] + c8 * 8);
    rb[i] = *(const u32x4*)(bbase + (size_t)i * 32 * K);
  }
#pragma unroll
  for (int a = 0; a < 4; ++a)
#pragma unroll
    for (int b = 0; b < 4; ++b) acc[a][b] = f32x4{0.f, 0.f, 0.f, 0.f};
  __syncthreads();
  for (int kt = 0; kt < nk; ++kt) {
    const int buf = kt & 1;
    bf16_t* cA = sA + buf * (128 * 72);
    bf16_t* cB = sB + buf * (128 * 72);
#pragma unroll
    for (int i = 0; i < 4; ++i) {
      *(u32x4*)(cA + (r0 + 32 * i) * 72 + c8 * 8) = ra[i];
      *(u32x4*)(cB + (r0 + 32 * i) * 72 + c8 * 8) = rb[i];
    }
    __syncthreads();
    if (kt + 1 < nk) {
#pragma unroll
      for (int i = 0; i < 4; ++i) {
        ra[i] = *(const u32x4*)(A + aoff[i] + (size_t)(kt + 1) * a_kstride + c8 * 8);
        rb[i] = *(const u32x4*)(bbase + (size_t)i * 32 * K + (kt + 1) * 64);
      }
    }
#pragma unroll
    for (int ks = 0; ks < 2; ++ks) {
      bf16x8 af[4], bfr[4];
#pragma unroll
      for (int mt = 0; mt < 4; ++mt) af[mt] = *(const bf16x8*)(cA + (wm * 64 + mt * 16 + c16) * 72 + ks * 32 + lg * 8);
#pragma unroll
      for (int nt = 0; nt < 4; ++nt) bfr[nt] = *(const bf16x8*)(cB + (wn * 64 + nt * 16 + c16) * 72 + ks * 32 + lg * 8);
#pragma unroll
      for (int mt = 0; mt < 4; ++mt)
#pragma unroll
        for (int nt = 0; nt < 4; ++nt) {
          if (SWAP) acc[nt][mt] = mfma16(bfr[nt], af[mt], acc[nt][mt]);
          else acc[mt][nt] = mfma16(af[mt], bfr[nt], acc[mt][nt]);
        }
    }
  }
}

DI void epi_normrope(f32x4 (&acc)[4][4], int m_base  , int ncol_base  ,
                     bf16_t* __restrict__ dst, int ld, const float* __restrict__ gw, const float* __restrict__ rope, float oscale) {
  const int lane = tidx() & 63, c16 = lane & 15, lg = lane >> 4;
  float gwv[4][4];
#pragma unroll
  for (int nt = 0; nt < 4; ++nt)
#pragma unroll
    for (int j = 0; j < 4; ++j) gwv[nt][j] = gw[nt * 16 + lg * 4 + j];
#pragma unroll
  for (int mt = 0; mt < 4; ++mt) {
    const int m = m_base + mt * 16 + c16;
    float ss = 0.f;
#pragma unroll
    for (int nt = 0; nt < 4; ++nt)
#pragma unroll
      for (int j = 0; j < 4; ++j) ss += acc[nt][mt][j] * acc[nt][mt][j];
    ss += __shfl_xor(ss, 16);
    ss += __shfl_xor(ss, 32);
    const float rstd = __builtin_amdgcn_rsqf(ss * (1.f / 64.f) + EPS);
    float v[4][4];
#pragma unroll
    for (int nt = 0; nt < 4; ++nt)
#pragma unroll
      for (int j = 0; j < 4; ++j) v[nt][j] = acc[nt][mt][j] * rstd * gwv[nt][j];
    const float4 cs = *(const float4*)(rope + (size_t)m * 16 + (lg & 1) * 4);
    const float4 sn = *(const float4*)(rope + (size_t)m * 16 + 8 + (lg & 1) * 4);
    const float csv[4] = {cs.x, cs.y, cs.z, cs.w};
    const float snv[4] = {sn.x, sn.y, sn.z, sn.w};
#pragma unroll
    for (int j = 0; j < 4; ++j) {
      float mine = v[0][j];
      float other = __shfl_xor(mine, 32);
      float r = (lg < 2) ? (mine * csv[j] - other * snv[j]) : (mine * csv[j] + other * snv[j]);
      v[0][j] = r;
    }
#pragma unroll
    for (int nt = 0; nt < 4; ++nt) {
      u32x2 o;
      o.x = pack_bf2(v[nt][0] * oscale, v[nt][1] * oscale);
      o.y = pack_bf2(v[nt][2] * oscale, v[nt][3] * oscale);
      *(u32x2*)(dst + (size_t)m * ld + ncol_base + nt * 16 + lg * 4) = o;
    }
  }
}

template <int MODE>
DI void epi_store_bf16(f32x4 (&acc)[4][4], int m_base, int ncol_base, bf16_t* __restrict__ dst, int ld, const float* __restrict__ bias) {
  const int lane = tidx() & 63, c16 = lane & 15, lg = lane >> 4;
#pragma unroll
  for (int mt = 0; mt < 4; ++mt) {
    const int m = m_base + mt * 16 + c16;
#pragma unroll
    for (int nt = 0; nt < 4; ++nt) {
      float v[4];
#pragma unroll
      for (int j = 0; j < 4; ++j) {
        float a = acc[nt][mt][j];
        if (MODE == 1) a = siluf_(a);
        if (MODE == 2) a = geluf_(a + bias[ncol_base + nt * 16 + lg * 4 + j]);
        v[j] = a;
      }
      u32x2 o;
      o.x = pack_bf2(v[0], v[1]);
      o.y = pack_bf2(v[2], v[3]);
      *(u32x2*)(dst + (size_t)m * ld + ncol_base + nt * 16 + lg * 4) = o;
    }
  }
}

DI void epi_store_vt(f32x4 (&acc)[4][4], int m_base, int col_base, bf16_t* __restrict__ vt) {
  const int lane = tidx() & 63, c16 = lane & 15, lg = lane >> 4;
#pragma unroll
  for (int mt = 0; mt < 4; ++mt) {
    const int m = m_base + mt * 16 + lg * 4;
    const int b = m >> 11, s = m & 2047;
#pragma unroll
    for (int nt = 0; nt < 4; ++nt) {
      const int col = col_base + nt * 16 + c16;
      const int gh = col >> 6, d = col & 63;
      u32x2 o;
      o.x = pack_bf2(acc[mt][nt][0], acc[mt][nt][1]);
      o.y = pack_bf2(acc[mt][nt][2], acc[mt][nt][3]);
      *(u32x2*)(vt + ((size_t)((b * 4 + gh) * 64 + d)) * 2048 + s) = o;
    }
  }
}

DI void inproj_tile(const Params& p, int layer, int tile, char* smem) {
  const bool nsa = (layer & 1) == 0;
  const int lj = layer >> 1;
  const int NT = nsa ? 29 : 20;
  const int mtile = tile / NT, ntile = tile % NT;
  const int m0 = mtile * 128, n0 = ntile * 128;
  const int tid = tidx(), w = tid >> 6, wm = w >> 1, wn = w & 1;
  const bf16_t* A = (const bf16_t*)(p.ws + OFF_H);
  const bf16_t* Bt = nsa ? (const bf16_t*)(p.ws + OFF_WT_NSA_IN) + (size_t)lj * NSA_NP * 1024
                         : (const bf16_t*)(p.ws + OFF_WT_MOBA_IN) + (size_t)lj * MOBA_IN * 1024;
  unsigned aoff[4];
#pragma unroll
  for (int i = 0; i < 4; ++i) aoff[i] = (unsigned)(m0 + (tid >> 3) + 32 * i) * 1024u;
  int type;
  bf16_t* dst = nullptr;
  int ld = 0, coff = 0;
  const float* gw = nullptr;
  if (nsa) {
    if (ntile < 8) { type = 0; dst = (bf16_t*)(p.ws + OFF_Q); ld = 1024; coff = n0; gw = p.nsa_qn + lj * 64; }
    else if (ntile < 10) { type = 2; dst = (bf16_t*)(p.ws + OFF_KC); ld = 256; coff = n0 - 1024; }
    else if (ntile < 12) { type = 2; dst = (bf16_t*)(p.ws + OFF_VC); ld = 256; coff = n0 - 1280; }
    else if (ntile < 14) { type = 1; dst = (bf16_t*)(p.ws + OFF_KS); ld = 256; coff = n0 - 1536; gw = p.nsa_kn + (lj * 3 + 1) * 64; }
    else if (ntile < 16) { type = 3; dst = (bf16_t*)(p.ws + OFF_VST); coff = n0 - 1792; }
    else if (ntile < 18) { type = 1; dst = (bf16_t*)(p.ws + OFF_KW); ld = 256; coff = n0 - 2048; gw = p.nsa_kn + (lj * 3 + 2) * 64; }
    else if (ntile < 20) { type = 3; dst = (bf16_t*)(p.ws + OFF_VWT); coff = n0 - 2304; }
    else if (ntile < 28) { type = 4; dst = (bf16_t*)(p.ws + OFF_SZ); ld = 1024; coff = n0 - 2560; }
    else { type = 5; }
  } else {
    if (ntile < 8) { type = 0; dst = (bf16_t*)(p.ws + OFF_Q); ld = 1024; coff = n0; gw = p.moba_qn + lj * 64; }
    else if (ntile < 10) { type = 1; dst = (bf16_t*)(p.ws + OFF_KS); ld = 256; coff = n0 - 1024; gw = p.moba_kn + lj * 64; }
    else if (ntile < 12) { type = 3; dst = (bf16_t*)(p.ws + OFF_VST); coff = n0 - 1280; }
    else { type = 4; dst = (bf16_t*)(p.ws + OFF_SZ); ld = 1024; coff = n0 - 1536; }
  }
  f32x4 acc[4][4];
  const float* rope = (const float*)(p.ws + OFF_ROPE);
  const int m_base = m0 + wm * 64;
  if (type == 3) {
    gemm_mainloop<false>(A, aoff, 64, Bt, 1024, n0, smem, acc);
    epi_store_vt(acc, m_base, coff + wn * 64, dst);
  } else {
    gemm_mainloop<true>(A, aoff, 64, Bt, 1024, n0, smem, acc);
    if (type == 0) epi_normrope(acc, m_base, coff + wn * 64, dst, ld, gw, rope, QSCALE);
    else if (type == 1) epi_normrope(acc, m_base, coff + wn * 64, dst, ld, gw, rope, 1.0f);
    else if (type == 2) epi_store_bf16<0>(acc, m_base, coff + wn * 64, dst, ld, nullptr);
    else if (type == 4) epi_store_bf16<1>(acc, m_base, coff + wn * 64, dst, ld, nullptr);
    else {
      const int lane = tid & 63, c16 = lane & 15, lg = lane >> 4;
      float* gates = (float*)(p.ws + OFF_GATES);
      const float* gb = p.gate_b + lj * 48;
      if (wn == 0) {
#pragma unroll
        for (int mt = 0; mt < 4; ++mt) {
          const int m = m_base + mt * 16 + c16;
#pragma unroll
          for (int nt = 0; nt < 3; ++nt) {
            const int nl = nt * 16 + lg * 4;
            float4 o;
            o.x = sigmoidf_(acc[nt][mt][0] + gb[nl + 0]);
            o.y = sigmoidf_(acc[nt][mt][1] + gb[nl + 1]);
            o.z = sigmoidf_(acc[nt][mt][2] + gb[nl + 2]);
            o.w = sigmoidf_(acc[nt][mt][3] + gb[nl + 3]);
            *(float4*)(gates + (size_t)m * 48 + nl) = o;
          }
        }
      }
    }
  }
}

DI void cmp1_tile(const Params& p, int lj, int tile, char* smem) {
  const int i = tile >> 7, t = tile & 127;
  const int mtile = t >> 1, ntile = t & 1;
  const int m0 = mtile * 128, n0 = ntile * 128;
  const int tid = tidx(), w = tid >> 6, wm = w >> 1, wn = w & 1;
  const bf16_t* A = (const bf16_t*)(p.ws + (i == 0 ? OFF_KC : OFF_VC));
  const bf16_t* Bt = (const bf16_t*)(p.ws + OFF_WT_CMP1) + (size_t)(lj * 2 + i) * 256 * 2048;
  unsigned aoff[4];
#pragma unroll
  for (int q = 0; q < 4; ++q) {
    int m = m0 + (tid >> 3) + 32 * q;
    int g = m & 3, n = (m >> 2) & 127, b = m >> 9;
    if (n > 126) n = 126;
    aoff[q] = (unsigned)((b * 2048 + 16 * n) * 256 + g * 64);
  }
  f32x4 acc[4][4];
  gemm_mainloop<true>(A, aoff, 256, Bt, 2048, n0, smem, acc);
  bf16_t* hid = (bf16_t*)(p.ws + OFF_HID) + (size_t)i * 8192 * 256;
  const float* b1 = (const float*)(p.ws + OFF_B1EFF) + (lj * 2 + i) * 256;
  epi_store_bf16<2>(acc, m0 + wm * 64, n0 + wn * 64, hid, 256, b1);
}

DI void cmp2_item(const Params& p, int lj, int item, char* smem) {
  const int tid = tidx();
  const int i = item >> 7, rt = item & 127;
  float* w2s = (float*)smem;
  const float* W2 = p.cmp_w2 + (size_t)(lj * 2 + i) * 256 * 64;
  __syncthreads();
  for (int q = tid; q < 256 * 64 / 4; q += 256) ((float4*)w2s)[q] = ((const float4*)W2)[q];
  __syncthreads();
  const int row = tid >> 2, cq = tid & 3;
  const int m = rt * 64 + row;
  const bf16_t* hid = (const bf16_t*)(p.ws + OFF_HID) + ((size_t)i * 8192 + m) * 256;
  float acc[16];
#pragma unroll
  for (int d = 0; d < 16; ++d) acc[d] = 0.f;
  for (int k8 = 0; k8 < 32; ++k8) {
    u32x4 hv = *(const u32x4*)(hid + k8 * 8);
    float hf[8] = {bflo(hv.x), bfhi(hv.x), bflo(hv.y), bfhi(hv.y), bflo(hv.z), bfhi(hv.z), bflo(hv.w), bfhi(hv.w)};
#pragma unroll
    for (int kk = 0; kk < 8; ++kk) {
      const float4* wr = (const float4*)(w2s + (k8 * 8 + kk) * 64 + cq * 16);
      float4 w0 = wr[0], w1 = wr[1], w2 = wr[2], w3 = wr[3];
      float h = hf[kk];
      acc[0] += h * w0.x; acc[1] += h * w0.y; acc[2] += h * w0.z; acc[3] += h * w0.w;
      acc[4] += h * w1.x; acc[5] += h * w1.y; acc[6] += h * w1.z; acc[7] += h * w1.w;
      acc[8] += h * w2.x; acc[9] += h * w2.y; acc[10] += h * w2.z; acc[11] += h * w2.w;
      acc[12] += h * w3.x; acc[13] += h * w3.y; acc[14] += h * w3.z; acc[15] += h * w3.w;
    }
  }
  const int g = m & 3, n = (m >> 2) & 127, b = m >> 9;
  const bool valid = n < 127;
  if (i == 0) {
    float ss = 0.f;
#pragma unroll
    for (int d = 0; d < 16; ++d) ss += acc[d] * acc[d];
    ss += __shfl_xor(ss, 1);
    ss += __shfl_xor(ss, 2);
    const float rstd = __builtin_amdgcn_rsqf(ss * (1.f / 64.f) + EPS);
    const float* gw = p.nsa_kn + (lj * 3 + 0) * 64 + cq * 16;
#pragma unroll
    for (int d = 0; d < 16; ++d) acc[d] = acc[d] * rstd * gw[d];
    if (cq == 0) {
      const int tokc = b * 2048 + (valid ? 16 * n + 31 : 2047);
      const float* rp = (const float*)(p.ws + OFF_ROPE) + (size_t)tokc * 16;
#pragma unroll
      for (int d = 0; d < 8; ++d) {
        float c = rp[d], s = rp[8 + d];
        float x1 = acc[d], x2 = acc[d + 8];
        acc[d] = x1 * c - x2 * s;
        acc[d + 8] = x2 * c + x1 * s;
      }
    }
    bf16_t* dst = (bf16_t*)(p.ws + OFF_KCMP) + ((size_t)((b * 4 + g) * 128 + n)) * 64 + cq * 16;
    u32x4 o0, o1;
    if (valid) {
      o0.x = pack_bf2(acc[0], acc[1]); o0.y = pack_bf2(acc[2], acc[3]); o0.z = pack_bf2(acc[4], acc[5]); o0.w = pack_bf2(acc[6], acc[7]);
      o1.x = pack_bf2(acc[8], acc[9]); o1.y = pack_bf2(acc[10], acc[11]); o1.z = pack_bf2(acc[12], acc[13]); o1.w = pack_bf2(acc[14], acc[15]);
    } else {
      o0 = u32x4{0u, 0u, 0u, 0u}; o1 = o0;
    }
    *(u32x4*)(dst) = o0;
    *(u32x4*)(dst + 8) = o1;
  } else {
    bf16_t* dst = (bf16_t*)(p.ws + OFF_VCMPT) + ((size_t)((b * 4 + g) * 64 + cq * 16)) * 128 + n;
#pragma unroll
    for (int d = 0; d < 16; ++d) {
      unsigned u = pack_bf2(valid ? acc[d] : 0.f, 0.f);
      dst[(size_t)d * 128] = (bf16_t)(u & 0xffff);
    }
  }
}

DI void kmean_item(const Params& p, int item, char* smem) {
  const int tid = tidx();
  const int blk = item & 7, g = (item >> 3) & 3, b = item >> 5;
  const int d8 = tid & 7, rg = tid >> 3;
  const bf16_t* K = (const bf16_t*)(p.ws + OFF_KS) + ((size_t)(b * 2048 + blk * 256)) * 256 + g * 64 + d8 * 8;
  float s[8];
#pragma unroll
  for (int q = 0; q < 8; ++q) s[q] = 0.f;
#pragma unroll
  for (int r = 0; r < 8; ++r) {
    u32x4 v = *(const u32x4*)(K + (size_t)(rg + 32 * r) * 256);
    s[0] += bflo(v.x); s[1] += bfhi(v.x); s[2] += bflo(v.y); s[3] += bfhi(v.y);
    s[4] += bflo(v.z); s[5] += bfhi(v.z); s[6] += bflo(v.w); s[7] += bfhi(v.w);
  }
  float* red = (float*)smem;
  __syncthreads();
#pragma unroll
  for (int q = 0; q < 8; ++q) red[rg * 64 + d8 * 8 + q] = s[q];
  __syncthreads();
  if (tid < 64) {
    float t = 0.f;
    for (int r = 0; r < 32; ++r) t += red[r * 64 + tid];
    bf16_t* km = (bf16_t*)(p.ws + OFF_KMEAN) + (size_t)((b * 4 + g) * 16) * 64;
    km[blk * 64 + tid] = (bf16_t)(pack_bf2(t * (1.f / 256.f), 0.f) & 0xffff);
    km[(8 + blk) * 64 + tid] = 0;
  }
}

template <bool NOMASK>
DI void attn_block64(const bf16_t* __restrict__ Ks, const bf16_t* __restrict__ Vs, const bf16x8 (&Qb)[2][2], f32x4 (&O)[4][2], float (&mrun)[2],
                     float (&lrun)[2], const int (&lo)[2], const int (&hi)[2]) {
  const int lane = tidx() & 63, c16 = lane & 15, lg = lane >> 4;
  f32x4 Sx[4][2];
#pragma unroll
  for (int kt = 0; kt < 4; ++kt) {
    Sx[kt][0] = f32x4{0.f, 0.f, 0.f, 0.f};
    Sx[kt][1] = f32x4{0.f, 0.f, 0.f, 0.f};
#pragma unroll
    for (int ks = 0; ks < 2; ++ks) {
      bf16x8 a = *(const bf16x8*)(Ks + (kt * 16 + c16) * 72 + ks * 32 + lg * 8);
      Sx[kt][0] = mfma16(a, Qb[0][ks], Sx[kt][0]);
      Sx[kt][1] = mfma16(a, Qb[1][ks], Sx[kt][1]);
    }
  }
#pragma unroll
  for (int ct = 0; ct < 2; ++ct) {
    float mx = NEG;
#pragma unroll
    for (int kt = 0; kt < 4; ++kt)
#pragma unroll
      for (int j = 0; j < 4; ++j) {
        float s = Sx[kt][ct][j];
        if (!NOMASK) {
          const int idx = kt * 16 + j;
          s = (idx > lo[ct] && idx <= hi[ct]) ? s : NEG;
          Sx[kt][ct][j] = s;
        }
        mx = fmaxf(mx, s);
      }
    mx = fmaxf(mx, __shfl_xor(mx, 16));
    mx = fmaxf(mx, __shfl_xor(mx, 32));
    const float mn = fmaxf(mrun[ct], mx);
    const float alpha = fexp2(mrun[ct] - mn);
    mrun[ct] = mn;
    const float msafe = mn < -1e29f ? 0.f : mn;
    float rs = 0.f;
#pragma unroll
    for (int kt = 0; kt < 4; ++kt)
#pragma unroll
      for (int j = 0; j < 4; ++j) {
        float pv = fexp2(Sx[kt][ct][j] - msafe);
        Sx[kt][ct][j] = pv;
        rs += pv;
      }
    lrun[ct] = lrun[ct] * alpha + rs;
#pragma unroll
    for (int dt = 0; dt < 4; ++dt) O[dt][ct] *= alpha;
  }
#pragma unroll
  for (int kp = 0; kp < 2; ++kp) {
    bf16x8 Pb[2];
#pragma unroll
    for (int ct = 0; ct < 2; ++ct) {
      u32x4 u;
      u.x = pack_bf2(Sx[2 * kp][ct][0], Sx[2 * kp][ct][1]);
      u.y = pack_bf2(Sx[2 * kp][ct][2], Sx[2 * kp][ct][3]);
      u.z = pack_bf2(Sx[2 * kp + 1][ct][0], Sx[2 * kp + 1][ct][1]);
      u.w = pack_bf2(Sx[2 * kp + 1][ct][2], Sx[2 * kp + 1][ct][3]);
      Pb[ct] = __builtin_bit_cast(bf16x8, u);
    }
#pragma unroll
    for (int dt = 0; dt < 4; ++dt) {
      u32x2 v0 = *(const u32x2*)(Vs + (dt * 16 + c16) * 72 + kp * 32 + lg * 4);
      u32x2 v1 = *(const u32x2*)(Vs + (dt * 16 + c16) * 72 + kp * 32 + 16 + lg * 4);
      u32x4 u = u32x4{v0.x, v0.y, v1.x, v1.y};
      bf16x8 va = __builtin_bit_cast(bf16x8, u);
      O[dt][0] = mfma16(va, Pb[0], O[dt][0]);
      O[dt][1] = mfma16(va, Pb[1], O[dt][1]);
    }
  }
}

template <int MODE>
DI void attn_range(const bf16_t* __restrict__ Kg, const bf16_t* __restrict__ VTg, int j0, int j1, char* smem, int& buf, const bf16x8 (&Qb)[2][2],
                   f32x4 (&O)[4][2], float (&mrun)[2], float (&lrun)[2], const int (&tq)[2], const unsigned (&selbits)[2], int own) {
  const int tid = tidx(), lane = tid & 63, lg = lane >> 4;
  const int r0 = tid >> 3, c8 = tid & 7;
  bf16_t* sK = (bf16_t*)smem;
  bf16_t* sV = (bf16_t*)(smem + 18432);
  u32x4 rk[2], rv[2];
  if (j0 <= j1) {
#pragma unroll
    for (int i = 0; i < 2; ++i) {
      rk[i] = *(const u32x4*)(Kg + (size_t)(j0 * 64 + r0 + 32 * i) * 256 + c8 * 8);
      rv[i] = *(const u32x4*)(VTg + (size_t)(r0 + 32 * i) * 2048 + j0 * 64 + c8 * 8);
    }
  }
  for (int j = j0; j <= j1; ++j) {
    bf16_t* cK = sK + buf * (64 * 72);
    bf16_t* cV = sV + buf * (64 * 72);
#pragma unroll
    for (int i = 0; i < 2; ++i) {
      *(u32x4*)(cK + (r0 + 32 * i) * 72 + c8 * 8) = rk[i];
      *(u32x4*)(cV + (r0 + 32 * i) * 72 + c8 * 8) = rv[i];
    }
    __syncthreads();
    if (j + 1 <= j1) {
#pragma unroll
      for (int i = 0; i < 2; ++i) {
        rk[i] = *(const u32x4*)(Kg + (size_t)((j + 1) * 64 + r0 + 32 * i) * 256 + c8 * 8);
        rv[i] = *(const u32x4*)(VTg + (size_t)(r0 + 32 * i) * 2048 + (j + 1) * 64 + c8 * 8);
      }
    }
    int lo[2], hi[2];
    const int kb = j * 64;
#pragma unroll
    for (int ct = 0; ct < 2; ++ct) {
      const int rel = tq[ct] - kb - lg * 4;
      if (MODE == 0) {
        hi[ct] = ((selbits[ct] >> j) & 1u) ? (j < j1 ? 1000 : rel) : -1;
        lo[ct] = -1000;
      } else if (MODE == 1) {
        hi[ct] = rel;
        lo[ct] = rel - 256;
      } else {
        const int jb = j >> 2;
        if (jb < own) hi[ct] = ((selbits[ct] >> jb) & 1u) ? 1000 : -1;
        else hi[ct] = (j < j1 ? 1000 : rel);
        lo[ct] = -1000;
      }
    }
    const bool act = (hi[0] >= 0 && lo[0] < 63) || (hi[1] >= 0 && lo[1] < 63);
    if (__any(act)) {
      const bool full = hi[0] >= 63 && lo[0] < 0 && hi[1] >= 63 && lo[1] < 0;
      if (__all(full)) attn_block64<true>(cK, cV, Qb, O, mrun, lrun, lo, hi);
      else attn_block64<false>(cK, cV, Qb, O, mrun, lrun, lo, hi);
    }
    buf ^= 1;
  }
}

DI void load_q(const Params& p, int b, int g, int tw  , bf16x8 (&Qb)[2][2]) {
  const int lane = tidx() & 63, c16 = lane & 15, lg = lane >> 4;
  const bf16_t* q = (const bf16_t*)(p.ws + OFF_Q);
#pragma unroll
  for (int ct = 0; ct < 2; ++ct) {
    const int t = tw + ct * 4 + (c16 >> 2), head = g * 4 + (c16 & 3);
    const bf16_t* qp = q + ((size_t)(b * 2048 + t)) * 1024 + head * 64 + lg * 8;
    Qb[ct][0] = *(const bf16x8*)(qp);
    Qb[ct][1] = *(const bf16x8*)(qp + 32);
  }
}

DI void store_y(const Params& p, int b, int g, int tw, const f32x4 (&Ot)[4][2]) {
  const int lane = tidx() & 63, c16 = lane & 15, lg = lane >> 4;
  const bf16_t* sz = (const bf16_t*)(p.ws + OFF_SZ);
  bf16_t* y = (bf16_t*)(p.ws + OFF_H);
#pragma unroll
  for (int ct = 0; ct < 2; ++ct) {
    const int t = tw + ct * 4 + (c16 >> 2), head = g * 4 + (c16 & 3);
    const size_t base = ((size_t)(b * 2048 + t)) * 1024 + head * 64 + lg * 4;
#pragma unroll
    for (int dt = 0; dt < 4; ++dt) {
      u32x2 zz = *(const u32x2*)(sz + base + dt * 16);
      u32x2 o;
      o.x = pack_bf2(Ot[dt][ct][0] * bflo(zz.x), Ot[dt][ct][1] * bfhi(zz.x));
      o.y = pack_bf2(Ot[dt][ct][2] * bflo(zz.y), Ot[dt][ct][3] * bfhi(zz.y));
      *(u32x2*)(y + base + dt * 16) = o;
    }
  }
}

DI void nsa_attn_item(const Params& p, int item, char* smem) {
  const int tid = tidx(), lane = tid & 63, w = tid >> 6, c16 = lane & 15, lg = lane >> 4;
  const int bg = item & 63, qb = 63 - (item >> 6);
  const int b = bg >> 2, g = bg & 3;
  const int t0 = qb * 32, tw = t0 + w * 8;
  const int cur = t0 >> 6;
  unsigned* selm = (unsigned*)(smem + 36864);
  float* imp_main = (float*)(smem + 36992);
  float* imp_carry = (float*)(smem + 36992 + 4224);
  f32x4* Otl = (f32x4*)(smem + 36992) + tid;
  bf16x8 Qb[2][2];
  load_q(p, b, g, tw, Qb);
  int tq[2];
  float gate[2][3];
  const float* gates = (const float*)(p.ws + OFF_GATES);
#pragma unroll
  for (int ct = 0; ct < 2; ++ct) {
    tq[ct] = tw + ct * 4 + (c16 >> 2);
    const float* gp = gates + ((size_t)(b * 2048 + tq[ct])) * 48 + (g * 4 + (c16 & 3)) * 3;
    gate[ct][0] = gp[0]; gate[ct][1] = gp[1]; gate[ct][2] = gp[2];
  }
  __syncthreads();
  bf16_t* Kc = (bf16_t*)smem;
  bf16_t* VcT = (bf16_t*)(smem + 18432);
  {
    const bf16_t* kc = (const bf16_t*)(p.ws + OFF_KCMP) + (size_t)bg * 128 * 64;
    const bf16_t* vc = (const bf16_t*)(p.ws + OFF_VCMPT) + (size_t)bg * 64 * 128;
#pragma unroll
    for (int i = 0; i < 4; ++i) {
      int ch = tid + i * 256;
      int row = ch >> 3, cc = ch & 7;
      *(u32x4*)(Kc + row * 72 + cc * 8) = *(const u32x4*)(kc + row * 64 + cc * 8);
      int rv = ch >> 4, cv = ch & 15;
      *(u32x4*)(VcT + rv * 136 + cv * 8) = *(const u32x4*)(vc + rv * 128 + cv * 8);
    }
  }
  __syncthreads();
  f32x4 Ot[4][2];
#pragma unroll
  for (int ct = 0; ct < 2; ++ct) {
    f32x4 Sx[8];
#pragma unroll
    for (int kt = 0; kt < 8; ++kt) {
      Sx[kt] = f32x4{0.f, 0.f, 0.f, 0.f};
#pragma unroll
      for (int ks = 0; ks < 2; ++ks) {
        bf16x8 a = *(const bf16x8*)(Kc + (kt * 16 + c16) * 72 + ks * 32 + lg * 8);
        Sx[kt] = mfma16(a, Qb[ct][ks], Sx[kt]);
      }
    }
    {
      const int hi = ((tq[ct] - 31) >> 4) - lg * 4;
      float mx = NEG;
#pragma unroll
      for (int kt = 0; kt < 8; ++kt)
#pragma unroll
        for (int j = 0; j < 4; ++j) {
          float s = (kt * 16 + j <= hi) ? Sx[kt][j] : NEG;
          Sx[kt][j] = s;
          mx = fmaxf(mx, s);
        }
      mx = fmaxf(mx, __shfl_xor(mx, 16));
      mx = fmaxf(mx, __shfl_xor(mx, 32));
      const float msafe = mx < -1e29f ? 0.f : mx;
      float rs = 0.f;
#pragma unroll
      for (int kt = 0; kt < 8; ++kt)
#pragma unroll
        for (int j = 0; j < 4; ++j) {
          float pv = fexp2(Sx[kt][j] - msafe);
          Sx[kt][j] = pv;
          rs += pv;
        }
      rs += __shfl_xor(rs, 16);
      rs += __shfl_xor(rs, 32);
      const float inv = 1.f / fmaxf(rs, 1e-30f);
      const int qloc = w * 8 + ct * 4 + (c16 >> 2);
#pragma unroll
      for (int kt = 0; kt < 8; ++kt) {
#pragma unroll
        for (int j = 0; j < 4; ++j) Sx[kt][j] *= inv;
        float a = Sx[kt][0] + Sx[kt][1] + Sx[kt][2] + 0.5f * Sx[kt][3];
        float c = 0.5f * Sx[kt][3];
        a += __shfl_xor(a, 1);
        a += __shfl_xor(a, 2);
        c += __shfl_xor(c, 1);
        c += __shfl_xor(c, 2);
        if ((c16 & 3) == 0) {
          const int mi = kt * 4 + lg;
          imp_main[qloc * 33 + mi] = a;
          imp_carry[qloc * 34 + mi + 1] = c;
        }
      }
    }
    f32x4 O[4];
#pragma unroll
    for (int dt = 0; dt < 4; ++dt) O[dt] = f32x4{0.f, 0.f, 0.f, 0.f};
#pragma unroll
    for (int kp = 0; kp < 4; ++kp) {
      u32x4 u;
      u.x = pack_bf2(Sx[2 * kp][0], Sx[2 * kp][1]);
      u.y = pack_bf2(Sx[2 * kp][2], Sx[2 * kp][3]);
      u.z = pack_bf2(Sx[2 * kp + 1][0], Sx[2 * kp + 1][1]);
      u.w = pack_bf2(Sx[2 * kp + 1][2], Sx[2 * kp + 1][3]);
      bf16x8 Pb = __builtin_bit_cast(bf16x8, u);
#pragma unroll
      for (int dt = 0; dt < 4; ++dt) {
        u32x2 v0 = *(const u32x2*)(VcT + (dt * 16 + c16) * 136 + kp * 32 + lg * 4);
        u32x2 v1 = *(const u32x2*)(VcT + (dt * 16 + c16) * 136 + kp * 32 + 16 + lg * 4);
        u32x4 uu = u32x4{v0.x, v0.y, v1.x, v1.y};
        bf16x8 va = __builtin_bit_cast(bf16x8, uu);
        O[dt] = mfma16(va, Pb, O[dt]);
      }
    }
#pragma unroll
    for (int dt = 0; dt < 4; ++dt) Ot[dt][ct] = O[dt] * gate[ct][0];
  }
  __syncthreads();
  if (tid < 32) {
    unsigned mask = 1u | (1u << cur);
    if (cur >= 1) mask |= 1u << (cur - 1);
    const int need = 8 - __popc(mask);
    for (int it = 0; it < need; ++it) {
      float bv = -1.f;
      int best = -1;
      for (int j = 1; j <= cur - 2; ++j) {
        if (!((mask >> j) & 1u)) {
          float v = imp_main[tid * 33 + j] + imp_carry[tid * 34 + j];
          if (v > bv) { bv = v; best = j; }
        }
      }
      if (best < 0) break;
      mask |= 1u << best;
    }
    selm[tid] = mask;
  }
  __syncthreads();
  unsigned selbits[2];
#pragma unroll
  for (int ct = 0; ct < 2; ++ct) selbits[ct] = selm[w * 8 + ct * 4 + (c16 >> 2)];
#pragma unroll
  for (int dt = 0; dt < 4; ++dt)
#pragma unroll
    for (int ct = 0; ct < 2; ++ct) Otl[(dt * 2 + ct) * 256] = Ot[dt][ct];
  int buf = 0;
  {
    f32x4 O[4][2];
    float mrun[2] = {NEG, NEG}, lrun[2] = {0.f, 0.f};
#pragma unroll
    for (int dt = 0; dt < 4; ++dt) { O[dt][0] = f32x4{0.f, 0.f, 0.f, 0.f}; O[dt][1] = f32x4{0.f, 0.f, 0.f, 0.f}; }
    const bf16_t* Kg = (const bf16_t*)(p.ws + OFF_KS) + (size_t)b * 2048 * 256 + g * 64;
    const bf16_t* VTg = (const bf16_t*)(p.ws + OFF_VST) + (size_t)bg * 64 * 2048;
    attn_range<0>(Kg, VTg, 0, cur, smem, buf, Qb, O, mrun, lrun, tq, selbits, 0);
#pragma unroll
    for (int ct = 0; ct < 2; ++ct) {
      float l = lrun[ct];
      l += __shfl_xor(l, 16);
      l += __shfl_xor(l, 32);
      const float sc = gate[ct][1] / fmaxf(l, 1e-30f);
#pragma unroll
      for (int dt = 0; dt < 4; ++dt) Otl[(dt * 2 + ct) * 256] = Otl[(dt * 2 + ct) * 256] + O[dt][ct] * sc;
    }
  }
  {
    f32x4 O[4][2];
    float mrun[2] = {NEG, NEG}, lrun[2] = {0.f, 0.f};
#pragma unroll
    for (int dt = 0; dt < 4; ++dt) { O[dt][0] = f32x4{0.f, 0.f, 0.f, 0.f}; O[dt][1] = f32x4{0.f, 0.f, 0.f, 0.f}; }
    const bf16_t* Kg = (const bf16_t*)(p.ws + OFF_KW) + (size_t)b * 2048 * 256 + g * 64;
    const bf16_t* VTg = (const bf16_t*)(p.ws + OFF_VWT) + (size_t)bg * 64 * 2048;
    int jlo = t0 - 255;
    jlo = jlo < 0 ? 0 : (jlo >> 6);
    attn_range<1>(Kg, VTg, jlo, cur, smem, buf, Qb, O, mrun, lrun, tq, selbits, 0);
#pragma unroll
    for (int ct = 0; ct < 2; ++ct) {
      float l = lrun[ct];
      l += __shfl_xor(l, 16);
      l += __shfl_xor(l, 32);
      const float sc = gate[ct][2] / fmaxf(l, 1e-30f);
#pragma unroll
      for (int dt = 0; dt < 4; ++dt) Ot[dt][ct] = Otl[(dt * 2 + ct) * 256] + O[dt][ct] * sc;
    }
  }
  store_y(p, b, g, tw, Ot);
}

DI void moba_attn_item(const Params& p, int item, char* smem) {
  const int tid = tidx(), lane = tid & 63, w = tid >> 6, c16 = lane & 15, lg = lane >> 4;
  const int bg = item & 63, qb = 63 - (item >> 6);
  const int b = bg >> 2, g = bg & 3;
  const int t0 = qb * 32, tw = t0 + w * 8;
  const int own = t0 >> 8;
  bf16x8 Qb[2][2];
  load_q(p, b, g, tw, Qb);
  int tq[2];
#pragma unroll
  for (int ct = 0; ct < 2; ++ct) tq[ct] = tw + ct * 4 + (c16 >> 2);
  __syncthreads();
  bf16_t* Km = (bf16_t*)(smem + 36864);
  if (tid < 128) {
    int row = tid >> 3, cc = tid & 7;
    *(u32x4*)(Km + row * 72 + cc * 8) = *(const u32x4*)((const bf16_t*)(p.ws + OFF_KMEAN) + (size_t)bg * 16 * 64 + row * 64 + cc * 8);
  }
  __syncthreads();
  unsigned selbits[2];
#pragma unroll
  for (int ct = 0; ct < 2; ++ct) {
    f32x4 sg = f32x4{0.f, 0.f, 0.f, 0.f};
#pragma unroll
    for (int ks = 0; ks < 2; ++ks) {
      bf16x8 a = *(const bf16x8*)(Km + c16 * 72 + ks * 32 + lg * 8);
      sg = mfma16(a, Qb[ct][ks], sg);
    }
    f32x4 ot;
#pragma unroll
    for (int j = 0; j < 4; ++j) ot[j] = __shfl_xor(sg[j], 16);
    const bool odd = (lg & 1) != 0;
    float v0 = odd ? ot[0] : sg[0], v1 = odd ? ot[1] : sg[1], v2 = odd ? ot[2] : sg[2], v3 = odd ? ot[3] : sg[3];
    float v4 = odd ? sg[0] : ot[0], v5 = odd ? sg[1] : ot[1], v6 = odd ? sg[2] : ot[2], v7 = odd ? sg[3] : ot[3];
    unsigned sel = 0;
#pragma unroll
    for (int it = 0; it < 3; ++it) {
      float bv = -3.0e38f;
      int best = -1;
#define CAND(J, V) if ((J) < own && !((sel >> (J)) & 1u) && (V) > bv) { bv = (V); best = (J); }
      CAND(0, v0) CAND(1, v1) CAND(2, v2) CAND(3, v3) CAND(4, v4) CAND(5, v5) CAND(6, v6) CAND(7, v7)
#undef CAND
      if (best >= 0) sel |= 1u << best;
    }
    selbits[ct] = (unsigned)__shfl((int)sel, c16);
  }
  int buf = 0;
  f32x4 O[4][2];
  float mrun[2] = {NEG, NEG}, lrun[2] = {0.f, 0.f};
#pragma unroll
  for (int dt = 0; dt < 4; ++dt) { O[dt][0] = f32x4{0.f, 0.f, 0.f, 0.f}; O[dt][1] = f32x4{0.f, 0.f, 0.f, 0.f}; }
  const bf16_t* Kg = (const bf16_t*)(p.ws + OFF_KS) + (size_t)b * 2048 * 256 + g * 64;
  const bf16_t* VTg = (const bf16_t*)(p.ws + OFF_VST) + (size_t)bg * 64 * 2048;
  attn_range<2>(Kg, VTg, 0, t0 >> 6, smem, buf, Qb, O, mrun, lrun, tq, selbits, own);
#pragma unroll
  for (int ct = 0; ct < 2; ++ct) {
    float l = lrun[ct];
    l += __shfl_xor(l, 16);
    l += __shfl_xor(l, 32);
    const float sc = 1.f / fmaxf(l, 1e-30f);
#pragma unroll
    for (int dt = 0; dt < 4; ++dt) O[dt][ct] *= sc;
  }
  store_y(p, b, g, tw, O);
}

DI void outproj_tile(const Params& p, int layer, const float* __restrict__ xin, int tile, char* smem) {
  const bool nsa = (layer & 1) == 0;
  const int lj = layer >> 1;
  const int mtile = tile >> 3, ntile = tile & 7;
  const int m0 = mtile * 128, n0 = ntile * 128;
  const int tid = tidx(), lane = tid & 63, w = tid >> 6, wm = w >> 1, wn = w & 1, c16 = lane & 15, lg = lane >> 4;
  const bf16_t* A = (const bf16_t*)(p.ws + OFF_H);
  const bf16_t* Bt = (const bf16_t*)(p.ws + (nsa ? OFF_WT_NSA_OUT : OFF_WT_MOBA_OUT)) + (size_t)lj * 1024 * 1024;
  unsigned aoff[4];
#pragma unroll
  for (int i = 0; i < 4; ++i) aoff[i] = (unsigned)(m0 + (tid >> 3) + 32 * i) * 1024u;
  f32x4 acc[4][4];
  gemm_mainloop<true>(A, aoff, 64, Bt, 1024, n0, smem, acc);
  const int b = m0 >> 11;
  const float* gatev = (const float*)(p.ws + OFF_MOD) + (size_t)(layer * 16 + b) * 3072 + 2048;
#pragma unroll
  for (int nt = 0; nt < 4; ++nt) {
    const int n = n0 + wn * 64 + nt * 16 + lg * 4;
    const float4 gv = *(const float4*)(gatev + n);
#pragma unroll
    for (int mt = 0; mt < 4; ++mt) {
      const int m = m0 + wm * 64 + mt * 16 + c16;
      const float4 xv = *(const float4*)(xin + (size_t)m * 1024 + n);
      float4 o;
      o.x = xv.x + gv.x * acc[nt][mt][0];
      o.y = xv.y + gv.y * acc[nt][mt][1];
      o.z = xv.z + gv.z * acc[nt][mt][2];
      o.w = xv.w + gv.w * acc[nt][mt][3];
      *(float4*)(p.out + (size_t)m * 1024 + n) = o;
    }
  }
}

DI void run_phase(const Params& pin, int layer, int ph, char* smem) {
  Params p = pin;
  asm volatile("" : "+s"(p.ws), "+s"(p.out));
  const int G = gridDim.x, bid = blockIdx.x;
  const bool nsa = (layer & 1) == 0;
  const int lj = layer >> 1;
  const float* xin = layer == 0 ? p.x : p.out;
  if (ph == 0) {
    for (int it = bid; it < NW_TOTAL; it += G) phaseW_item(p, it, smem);
  } else if (ph == 1) {
    for (int it = bid; it < NTOK / 4; it += G) prep_item(p, layer, xin, it);
  } else if (ph == 2) {
    const int n = 256 * (nsa ? 29 : 20);
    for (int it = bid; it < n; it += G) inproj_tile(p, layer, it, smem);
  } else if (ph == 3) {
    if (nsa) { for (int it = bid; it < 256; it += G) cmp1_tile(p, lj, it, smem); }
    else { for (int it = bid; it < 512; it += G) kmean_item(p, it, smem); }
  } else if (ph == 4) {
    if (nsa) for (int it = bid; it < 256; it += G) cmp2_item(p, lj, it, smem);
  } else if (ph == 5) {
#ifndef ONLY_MOBA
    if (nsa) { for (int it = bid; it < 4096; it += G) nsa_attn_item(p, it, smem); }
#endif
#ifndef ONLY_NSA
    if (!nsa) { for (int it = bid; it < 4096; it += G) moba_attn_item(p, it, smem); }
#endif
  } else if (ph == 6) {
    for (int it = bid; it < 2048; it += G) outproj_tile(p, layer, xin, it, smem);
  }
}

#if MULTI_LAUNCH
template <int PH>
__global__ void __launch_bounds__(256, 2) phase_kernel(Params p, int layer) {
  __shared__ __attribute__((aligned(16))) char smem[SMEM_BYTES];
  run_phase(p, layer, PH, smem);
}
#else
__global__ void __launch_bounds__(256, 2) mega_kernel(Params p) {
  __shared__ __attribute__((aligned(16))) char smem[SMEM_BYTES];
  __shared__ u32x4 xb_words;
  cg::grid_group grid = cg::this_grid();
  if (__builtin_amdgcn_workitem_id_x() == 0) xb_words = u32x4{0u, 0u, 0u, 0u};
  __syncthreads();
  XcdBarrier xb = xcd_barrier_post((unsigned*)(p.ws + OFF_BAR), (volatile LAS unsigned*)&xb_words);
  run_phase(p, 0, 0, smem);
  grid.sync();
  for (int layer = 0; layer < 4; ++layer) {
    const bool nsa = (layer & 1) == 0;
    run_phase(p, layer, 1, smem);
    xcd_barrier(xb);
    run_phase(p, layer, 2, smem);
    xcd_barrier(xb);
    run_phase(p, layer, 3, smem);
    xcd_barrier(xb);
    if (nsa) {
      run_phase(p, layer, 4, smem);
      xcd_barrier(xb);
    }
    run_phase(p, layer, 5, smem);
    xcd_barrier(xb);
    run_phase(p, layer, 6, smem);
    if (layer < 3) xcd_barrier(xb);
  }
}
#endif

extern "C" void kernel_launch(void* const* d_in, const int* in_sizes, int n_in, void* d_out, int out_size, void* d_ws, size_t ws_size,
                              hipStream_t stream) {
  Params p{};
  p.x = (const float*)d_in[0];
  p.c = (const float*)d_in[1];
  p.pos = (const int*)d_in[2];
  p.norm_g = (const float*)d_in[3];
  p.ada_w = (const float*)d_in[4];
  p.ada_b = (const float*)d_in[5];
  p.nsa_w_in = (const float*)d_in[6];
  p.nsa_w_out = (const float*)d_in[7];
  p.nsa_qn = (const float*)d_in[8];
  p.nsa_kn = (const float*)d_in[9];
  p.cmp_pe = (const float*)d_in[10];
  p.cmp_w1 = (const float*)d_in[11];
  p.cmp_b1 = (const float*)d_in[12];
  p.cmp_w2 = (const float*)d_in[13];
  p.gate_b = (const float*)d_in[14];
  p.moba_w_in = (const float*)d_in[15];
  p.moba_w_out = (const float*)d_in[16];
  p.moba_qn = (const float*)d_in[17];
  p.moba_kn = (const float*)d_in[18];
  p.out = (float*)d_out;
  p.ws = (char*)d_ws;
  if (ws_size < WS_TOTAL) { fprintf(stderr, "workspace too small: %zu < %zu\n", ws_size, (size_t)WS_TOTAL); return; }
#if MULTI_LAUNCH
  const int G = 512;
  phase_kernel<0><<<G, 256, 0, stream>>>(p, 0);
  for (int layer = 0; layer < 4; ++layer) {
    phase_kernel<1><<<G, 256, 0, stream>>>(p, layer);
    phase_kernel<2><<<G, 256, 0, stream>>>(p, layer);
    phase_kernel<3><<<G, 256, 0, stream>>>(p, layer);
    if (!(layer & 1)) phase_kernel<4><<<G, 256, 0, stream>>>(p, layer);
    phase_kernel<5><<<G, 256, 0, stream>>>(p, layer);
    phase_kernel<6><<<G, 256, 0, stream>>>(p, layer);
  }
#else
  static int grid_blocks = 0;
  if (!grid_blocks) {
    int dev = 0, cus = 0, per_cu = 0;
    (void)hipGetDevice(&dev);
    (void)hipDeviceGetAttribute(&cus, hipDeviceAttributeMultiprocessorCount, dev);
    (void)hipOccupancyMaxActiveBlocksPerMultiprocessor(&per_cu, mega_kernel, 256, 0);
    if (per_cu > 2) per_cu = 2;
    grid_blocks = cus * per_cu;
  }
  (void)hipMemsetAsync((char*)d_ws + OFF_BAR, 0, BAR_BYTES, stream);
  void* args[] = {&p};
  hipError_t e = hipLaunchCooperativeKernel((void*)mega_kernel, dim3(grid_blocks), dim3(256), args, 0, stream);
  if (e != hipSuccess) fprintf(stderr, "cooperative launch failed: %s (grid %d)\n", hipGetErrorString(e), grid_blocks);
#endif
}
```

```cpp
#include <hip/hip_runtime.h>
#include <hip/hip_cooperative_groups.h>
#include <cstdio>
namespace cg = cooperative_groups;

#ifndef MULTI_LAUNCH
#define MULTI_LAUNCH 0
#endif

#define DI __device__ __forceinline__
typedef unsigned short bf16_t;
using bf16x8 = __attribute__((ext_vector_type(8))) short;
using f32x4 = __attribute__((ext_vector_type(4))) float;
typedef __bf16 bf16x2_t __attribute__((ext_vector_type(2)));
typedef float f32x2_t __attribute__((ext_vector_type(2)));
using u32x4 = __attribute__((ext_vector_type(4))) unsigned;
using u32x2 = __attribute__((ext_vector_type(2))) unsigned;

constexpr int DM = 1024, NB = 16, SEQ = 2048, NTOK = NB * SEQ;
constexpr int NSA_IN = 3632, NSA_NP = 3584, MOBA_IN = 2560;
constexpr float EPS = 1e-6f;
constexpr float QSCALE = 0.125f * 1.4426950408889634f;
constexpr float NEG = -1e30f;

constexpr size_t SZ_WT_NSA_IN = (size_t)2 * NSA_NP * 1024 * 2;
constexpr size_t SZ_WT_SQ = (size_t)2 * 1024 * 1024 * 2;
constexpr size_t SZ_WT_MOBA_IN = (size_t)2 * MOBA_IN * 1024 * 2;
constexpr size_t SZ_WT_CMP1 = (size_t)4 * 256 * 2048 * 2;
constexpr size_t SZ_ACT = (size_t)NTOK * 1024 * 2;
constexpr size_t SZ_KV = (size_t)NTOK * 256 * 2;
constexpr size_t OFF_WT_NSA_IN = 0;
constexpr size_t OFF_WT_NSA_OUT = OFF_WT_NSA_IN + SZ_WT_NSA_IN;
constexpr size_t OFF_WT_MOBA_IN = OFF_WT_NSA_OUT + SZ_WT_SQ;
constexpr size_t OFF_WT_MOBA_OUT = OFF_WT_MOBA_IN + SZ_WT_MOBA_IN;
constexpr size_t OFF_WT_CMP1 = OFF_WT_MOBA_OUT + SZ_WT_SQ;
constexpr size_t OFF_B1EFF = OFF_WT_CMP1 + SZ_WT_CMP1;
constexpr size_t OFF_ROPE = OFF_B1EFF + 4096;
constexpr size_t OFF_MOD = OFF_ROPE + (size_t)NTOK * 16 * 4;
constexpr size_t OFF_H = OFF_MOD + (size_t)4 * 16 * 3072 * 4;
constexpr size_t OFF_Q = OFF_H + SZ_ACT;
constexpr size_t OFF_SZ = OFF_Q + SZ_ACT;
constexpr size_t OFF_KC = OFF_SZ + SZ_ACT;
constexpr size_t OFF_VC = OFF_KC + SZ_KV;
constexpr size_t OFF_KS = OFF_VC + SZ_KV;
constexpr size_t OFF_KW = OFF_KS + SZ_KV;
constexpr size_t OFF_VST = OFF_KW + SZ_KV;
constexpr size_t OFF_VWT = OFF_VST + SZ_KV;
constexpr size_t OFF_GATES = OFF_VWT + SZ_KV;
constexpr size_t OFF_HID = OFF_GATES + (size_t)NTOK * 48 * 4;
constexpr size_t OFF_KCMP = OFF_HID + (size_t)2 * 8192 * 256 * 2;
constexpr size_t OFF_VCMPT = OFF_KCMP + (size_t)64 * 128 * 64 * 2;
constexpr size_t OFF_KMEAN = OFF_VCMPT + (size_t)64 * 128 * 64 * 2;
constexpr size_t OFF_WT_GL = OFF_KMEAN + (size_t)64 * 16 * 64 * 2;
constexpr size_t OFF_BAR = OFF_WT_GL + (size_t)2 * 128 * 1024 * 2;
constexpr size_t BAR_BYTES = 3456 * 4;
constexpr size_t WS_TOTAL = OFF_BAR + 16384;

struct Params {
  const float *x, *c;
  const int* pos;
  const float *norm_g, *ada_w, *ada_b, *nsa_w_in, *nsa_w_out, *nsa_qn, *nsa_kn, *cmp_pe, *cmp_w1, *cmp_b1, *cmp_w2, *gate_b,
      *moba_w_in, *moba_w_out, *moba_qn, *moba_kn;
  float* out;
  char* ws;
};

constexpr int SMEM_BYTES = 73728;

DI int tidx() {
  int t = __builtin_amdgcn_workitem_id_x() & 255;
  asm volatile("" : "+v"(t));
  return t;
}
DI int vhalf() { return __builtin_amdgcn_readfirstlane(__builtin_amdgcn_workitem_id_x() >> 8); }
DI unsigned pack_bf2(float a, float b) {
  f32x2_t v = {a, b};
  bf16x2_t r = __builtin_convertvector(v, bf16x2_t);
  return __builtin_bit_cast(unsigned, r);
}
DI float bf2f(bf16_t v) { return __uint_as_float(((unsigned)v) << 16); }
DI float bflo(unsigned u) { return __uint_as_float(u << 16); }
DI float bfhi(unsigned u) { return __uint_as_float(u & 0xffff0000u); }
DI f32x4 mfma16(bf16x8 a, bf16x8 b, f32x4 c) { return __builtin_amdgcn_mfma_f32_16x16x32_bf16(a, b, c, 0, 0, 0); }
DI float fexp2(float x) { return __builtin_amdgcn_exp2f(x); }
DI float sigmoidf_(float x) { return 1.f / (1.f + __expf(-x)); }
DI float siluf_(float x) { return x / (1.f + __expf(-x)); }
DI float geluf_(float x) {
  float u = 0.7978845608028654f * (x + 0.044715f * x * x * x);
  float t = 1.f - 2.f / (__expf(2.f * u) + 1.f);
  return 0.5f * x * (1.f + t);
}


#define XB_TMO      128
#define XB_XCNT(j)  (256  + 64 * (j))
#define XB_XSUB(j)  (1280 + 64 * (j))
#define XB_XGEN(j)  (2304 + 64 * (j))
#define XB_TOP      3328
#define XB_TOPGEN   3392
#define XB_SPIN_CAP (1u << 22)
#define LAS __attribute__((address_space(3)))
DI unsigned xb_ld(unsigned* p) { return __hip_atomic_load(p, __ATOMIC_RELAXED, __HIP_MEMORY_SCOPE_AGENT); }
DI unsigned xb_add(unsigned* p, unsigned v) { return __hip_atomic_fetch_add(p, v, __ATOMIC_RELAXED, __HIP_MEMORY_SCOPE_AGENT); }
DI unsigned xb_xcc_id() { return (unsigned)__builtin_amdgcn_s_getreg((3 << 11) | 20) & 0xFu; }
#define XB_SPIN(cond, bar) do { unsigned _sp = 0; while (cond) { __builtin_amdgcn_s_sleep(1); \
    if ((++_sp & 255u) == 0u) { if (xb_ld(&(bar)[XB_TMO])) break; if (_sp > XB_SPIN_CAP) { atomicAdd(&(bar)[XB_TMO], 1u); break; } } } } while (0)
struct XcdBarrier { unsigned* bar; unsigned x; volatile LAS unsigned* st; };
DI XcdBarrier xcd_barrier_post(unsigned* bar, volatile LAS unsigned* st) {
  XcdBarrier b; b.bar = bar; b.x = xb_xcc_id(); b.st = st;
  if (__builtin_amdgcn_workitem_id_x() == 0) (void)xb_add(&bar[XB_XCNT(b.x)], 1u);
  return b;
}
DI void xcd_barrier_complete(unsigned* bar, unsigned x, unsigned& nloc, unsigned& nx) {
  const unsigned G = gridDim.x * gridDim.y * gridDim.z;
  unsigned sum, cnt, mine, sp = 0u;
  for (;;) {
    sum = 0u; cnt = 0u; mine = 0u;
#pragma unroll
    for (unsigned j = 0; j < 16; ++j) { const unsigned c = xb_ld(&bar[XB_XCNT(j)]); sum += c; cnt += (c > 0u) ? 1u : 0u; mine = (j == x) ? c : mine; }
    if (sum == G) break;
    __builtin_amdgcn_s_sleep(1);
    if ((++sp & 255u) == 0u) { if (xb_ld(&bar[XB_TMO])) break; if (sp > XB_SPIN_CAP) { atomicAdd(&bar[XB_TMO], 1u); break; } }
  }
  nloc = mine > 0u ? mine : 1u; nx = cnt > 0u ? cnt : 1u;
}
DI void xcd_barrier(const XcdBarrier& b) {
  asm volatile("s_waitcnt vmcnt(0)" ::: "memory");
  __syncthreads();
  if (__builtin_amdgcn_workitem_id_x() == 0) {
    unsigned* bar = b.bar;
    __builtin_amdgcn_s_waitcnt(0);
    unsigned nloc = b.st[0], nx = b.st[1];
    if (nloc == 0u) { xcd_barrier_complete(bar, b.x, nloc, nx); b.st[0] = nloc; b.st[1] = nx; }
    const unsigned old = xb_add(&bar[XB_XSUB(b.x)], 1u);
    const unsigned gen = old / nloc;
    if (old + 1u == (gen + 1u) * nloc) {
      __builtin_amdgcn_fence(__ATOMIC_RELEASE, "agent");
      asm volatile("s_waitcnt vmcnt(0)" ::: "memory");
      const unsigned og = xb_add(&bar[XB_TOP], 1u);
      const unsigned tg = og / nx;
      if (og + 1u == (tg + 1u) * nx) xb_add(&bar[XB_TOPGEN], 1u);
      else XB_SPIN(xb_ld(&bar[XB_TOPGEN]) == tg, bar);
      __builtin_amdgcn_fence(__ATOMIC_ACQUIRE, "agent");
      xb_add(&bar[XB_XGEN(b.x)], 1u);
      asm volatile("s_waitcnt vmcnt(0)" ::: "memory");
    } else {
      XB_SPIN(xb_ld(&bar[XB_XGEN(b.x)]) == gen, bar);
      __builtin_amdgcn_fence(__ATOMIC_ACQUIRE, "agent");
      asm volatile("s_waitcnt vmcnt(0)" ::: "memory");
    }
  }
  __syncthreads();
}

DI void ada_item(const Params& p, int item, char* smem) {
  const int tid = tidx();
  const int l = item / 48, n0 = (item % 48) * 64;
  float* cond = (float*)smem;
  __syncthreads();
  for (int i = tid; i < 16 * 1024; i += 256) {
    int b = i >> 10, k = i & 1023;
    float v = p.c[i];
    cond[k * 16 + b] = siluf_(v);
  }
  __syncthreads();
  const int kq = tid >> 6, col = tid & 63;
  float acc[16];
#pragma unroll
  for (int b = 0; b < 16; ++b) acc[b] = 0.f;
  const float* w = p.ada_w + (size_t)l * 1024 * 3072 + n0 + col;
#pragma unroll 4
  for (int k = kq * 256; k < kq * 256 + 256; ++k) {
    float wv = w[(size_t)k * 3072];
    const float4* cp = (const float4*)(cond + k * 16);
    float4 c0 = cp[0], c1 = cp[1], c2 = cp[2], c3 = cp[3];
    acc[0] += wv * c0.x; acc[1] += wv * c0.y; acc[2] += wv * c0.z; acc[3] += wv * c0.w;
    acc[4] += wv * c1.x; acc[5] += wv * c1.y; acc[6] += wv * c1.z; acc[7] += wv * c1.w;
    acc[8] += wv * c2.x; acc[9] += wv * c2.y; acc[10] += wv * c2.z; acc[11] += wv * c2.w;
    acc[12] += wv * c3.x; acc[13] += wv * c3.y; acc[14] += wv * c3.z; acc[15] += wv * c3.w;
  }
  __syncthreads();
  float* red = (float*)smem;
#pragma unroll
  for (int b = 0; b < 16; ++b) red[(kq * 16 + b) * 64 + col] = acc[b];
  __syncthreads();
  float* mod = (float*)(p.ws + OFF_MOD);
  for (int i = tid; i < 16 * 64; i += 256) {
    int b = i >> 6, cc = i & 63;
    float s = red[(0 * 16 + b) * 64 + cc] + red[(16 + b) * 64 + cc] + red[(32 + b) * 64 + cc] + red[(48 + b) * 64 + cc];
    mod[(size_t)(l * 16 + b) * 3072 + n0 + cc] = s + p.ada_b[l * 3072 + n0 + cc];
  }
}

DI void b1eff_item(const Params& p, int item, char* smem) {
  const int tid = tidx();
  const int li = item >> 4, h0 = (item & 15) * 16;
  const int kg = tid >> 4, hh = tid & 15;
  const float* W1 = p.cmp_w1 + (size_t)li * 2048 * 256;
  const float* pe = p.cmp_pe + li * 2048;
  float acc = 0.f;
#pragma unroll 8
  for (int k = kg * 128; k < kg * 128 + 128; ++k) acc += pe[k] * W1[(size_t)k * 256 + h0 + hh];
  float* red = (float*)smem;
  __syncthreads();
  red[kg * 16 + hh] = acc;
  __syncthreads();
  if (tid < 16) {
    float s = 0.f;
    for (int g = 0; g < 16; ++g) s += red[g * 16 + tid];
    ((float*)(p.ws + OFF_B1EFF))[li * 256 + h0 + tid] = s + p.cmp_b1[li * 256 + h0 + tid];
  }
}

DI void rope_item(const Params& p, int item) {
  const int idx = item * 256 + tidx();
  const int tok = idx >> 3, i = idx & 7;
  const float invf[8] = {1.0f, 0.1939227432012558f, 0.03760603070259094f, 0.007292664609849453f,
                         0.0014142135623842478f, 0.00027424818836152554f, 5.318296098266728e-05f, 1.0313386155758053e-05f};
  float f = i == 0 ? invf[0] : i == 1 ? invf[1] : i == 2 ? invf[2] : i == 3 ? invf[3] : i == 4 ? invf[4] : i == 5 ? invf[5] : i == 6 ? invf[6] : invf[7];
  float ang = (float)p.pos[tok] * f;
  double rev = (double)ang * 0.15915494309189535;
  double fr = rev - floor(rev);
  float frf = (float)fr;
  float* rope = (float*)(p.ws + OFF_ROPE);
  rope[(size_t)tok * 16 + i] = __builtin_amdgcn_cosf(frf);
  rope[(size_t)tok * 16 + 8 + i] = __builtin_amdgcn_sinf(frf);
}

DI void transpose_item(const float* __restrict__ src, int K, int Nsrc, bf16_t* __restrict__ dst, int k0, int n0, int mapmode, char* smem) {
  float* tile = (float*)smem;
  const int tid = tidx();
  __syncthreads();
#pragma unroll 4
  for (int i = 0; i < 16; ++i) {
    int kk = i * 4 + (tid >> 6), nn = tid & 63;
    int nd = n0 + nn, ns = nd;
    if (mapmode == 1 || mapmode == 2) {
      const int rho = nd & 255;
      ns = (nd & ~255) + 64 * ((rho >> 5) & 3) + 32 * (rho >> 7) + (rho & 31);
    }
    if (mapmode == 1) ns = ns < 2560 ? ns : ns + 48;
    if (mapmode == 3) ns = nd < 48 ? 2560 + nd : -1;
    float v = ns >= 0 ? src[(size_t)(k0 + kk) * Nsrc + ns] : 0.f;
    tile[kk * 65 + nn] = v;
  }
  __syncthreads();
#pragma unroll 4
  for (int i = 0; i < 16; ++i) {
    int nn = i * 4 + (tid >> 6), kk = tid & 63;
    float v = tile[kk * 65 + nn];
    unsigned u = pack_bf2(v, 0.f);
    dst[(size_t)(n0 + nn) * K + k0 + kk] = (bf16_t)(u & 0xffff);
  }
}

constexpr int NW_ADA = 192, NW_B1 = 64, NW_ROPE = 1024;
constexpr int NW_T_NSA_IN = 16 * 56, NW_T_SQ = 256, NW_T_MOBA_IN = 16 * 40, NW_T_CMP = 128, NW_T_GL = 16 * 2;
constexpr int NW_TRANS = 2 * NW_T_NSA_IN + 2 * NW_T_SQ + 2 * NW_T_MOBA_IN + 2 * NW_T_SQ + 4 * NW_T_CMP + 2 * NW_T_GL;
constexpr int NW_TOTAL = NW_ADA + NW_B1 + NW_ROPE + NW_TRANS;

DI void phaseW_item(const Params& p, int it, char* smem) {
  if (it < NW_ADA) { ada_item(p, it, smem); return; }
  it -= NW_ADA;
  if (it < NW_B1) { b1eff_item(p, it, smem); return; }
  it -= NW_B1;
  if (it < NW_ROPE) { rope_item(p, it); return; }
  it -= NW_ROPE;
  if (it < 2 * NW_T_NSA_IN) {
    int l = it / NW_T_NSA_IN, t = it % NW_T_NSA_IN;
    transpose_item(p.nsa_w_in + (size_t)l * 1024 * NSA_IN, 1024, NSA_IN, (bf16_t*)(p.ws + OFF_WT_NSA_IN) + (size_t)l * NSA_NP * 1024,
                   (t % 16) * 64, (t / 16) * 64, 1, smem);
    return;
  }
  it -= 2 * NW_T_NSA_IN;
  if (it < 2 * NW_T_SQ) {
    int l = it / NW_T_SQ, t = it % NW_T_SQ;
    transpose_item(p.nsa_w_out + (size_t)l * 1024 * 1024, 1024, 1024, (bf16_t*)(p.ws + OFF_WT_NSA_OUT) + (size_t)l * 1024 * 1024,
                   (t % 16) * 64, (t / 16) * 64, 2, smem);
    return;
  }
  it -= 2 * NW_T_SQ;
  if (it < 2 * NW_T_MOBA_IN) {
    int l = it / NW_T_MOBA_IN, t = it % NW_T_MOBA_IN;
    transpose_item(p.moba_w_in + (size_t)l * 1024 * MOBA_IN, 1024, MOBA_IN, (bf16_t*)(p.ws + OFF_WT_MOBA_IN) + (size_t)l * MOBA_IN * 1024,
                   (t % 16) * 64, (t / 16) * 64, 2, smem);
    return;
  }
  it -= 2 * NW_T_MOBA_IN;
  if (it < 2 * NW_T_SQ) {
    int l = it / NW_T_SQ, t = it % NW_T_SQ;
    transpose_item(p.moba_w_out + (size_t)l * 1024 * 1024, 1024, 1024, (bf16_t*)(p.ws + OFF_WT_MOBA_OUT) + (size_t)l * 1024 * 1024,
                   (t % 16) * 64, (t / 16) * 64, 2, smem);
    return;
  }
  it -= 2 * NW_T_SQ;
  if (it < 4 * NW_T_CMP) {
    int li = it / NW_T_CMP, t = it % NW_T_CMP;
    transpose_item(p.cmp_w1 + (size_t)li * 2048 * 256, 2048, 256, (bf16_t*)(p.ws + OFF_WT_CMP1) + (size_t)li * 256 * 2048,
                   (t % 32) * 64, (t / 32) * 64, 0, smem);
    return;
  }
  it -= 4 * NW_T_CMP;
  {
    int l = it / NW_T_GL, t = it % NW_T_GL;
    transpose_item(p.nsa_w_in + (size_t)l * 1024 * NSA_IN, 1024, NSA_IN, (bf16_t*)(p.ws + OFF_WT_GL) + (size_t)l * 128 * 1024,
                   (t % 16) * 64, (t / 16) * 64, 3, smem);
  }
}

DI void prep_item(const Params& p, int layer, const float* __restrict__ xin, int item) {
  const int lane = tidx() & 63, w = tidx() >> 6;
  const int tok = item * 4 + w;
  const int b = tok >> 11;
  const float4* xr = (const float4*)(xin + (size_t)tok * 1024);
  float4 v[4];
  float ss = 0.f;
#pragma unroll
  for (int i = 0; i < 4; ++i) {
    v[i] = xr[lane + i * 64];
    ss += v[i].x * v[i].x + v[i].y * v[i].y + v[i].z * v[i].z + v[i].w * v[i].w;
  }
#pragma unroll
  for (int o = 32; o >= 1; o >>= 1) ss += __shfl_xor(ss, o);
  const float rstd = __builtin_amdgcn_rsqf(ss * (1.f / 1024.f) + EPS);
  const float* mod = (const float*)(p.ws + OFF_MOD) + (size_t)(layer * 16 + b) * 3072;
  const float4* g4 = (const float4*)(p.norm_g + layer * 1024);
  const float4* sh4 = (const float4*)(mod);
  const float4* sc4 = (const float4*)(mod + 1024);
  u32x2* hr = (u32x2*)((bf16_t*)(p.ws + OFF_H) + (size_t)tok * 1024);
#pragma unroll
  for (int i = 0; i < 4; ++i) {
    int c = lane + i * 64;
    float4 g = g4[c], sh = sh4[c], sc = sc4[c];
    float a0 = v[i].x * rstd * g.x * (1.f + sc.x) + sh.x;
    float a1 = v[i].y * rstd * g.y * (1.f + sc.y) + sh.y;
    float a2 = v[i].z * rstd * g.z * (1.f + sc.z) + sh.z;
    float a3 = v[i].w * rstd * g.w * (1.f + sc.w) + sh.w;
    u32x2 o;
    o.x = pack_bf2(a0, a1);
    o.y = pack_bf2(a2, a3);
    hr[c] = o;
  }
}

template <bool SWAP>
DI void gemm_mainloop(const bf16_t* __restrict__ A, const unsigned (&aoff)[4], int a_kstride, const bf16_t* __restrict__ Bt, int K, int n0,
                      char* smem, f32x4 (&acc)[4][4]) {
  bf16_t* sA = (bf16_t*)smem;
  bf16_t* sB = (bf16_t*)(smem + 36864);
  const int tid = tidx(), lane = tid & 63, w = tid >> 6;
  const int wm = w >> 1, wn = w & 1, c16 = lane & 15, lg = lane >> 4;
  const int r0 = tid >> 3, c8 = tid & 7;
  const int nk = K >> 6;
  u32x4 ra[4], rb[4];
  const bf16_t* bbase = Bt + (size_t)(n0 + r0) * K + c8 * 8;
#pragma unroll
  for (int i = 0; i < 4; ++i) {
    ra[i] = *(const u32x4*)(A + aoff[i] + c8 * 8);
    rb[i] = *(const u32x4*)(bbase + (size_t)i * 32 * K);
  }
#pragma unroll
  for (int a = 0; a < 4; ++a)
#pragma unroll
    for (int b = 0; b < 4; ++b) acc[a][b] = f32x4{0.f, 0.f, 0.f, 0.f};
  __syncthreads();
  for (int kt = 0; kt < nk; ++kt) {
    const int buf = kt & 1;
    bf16_t* cA = sA + buf * (128 * 72);
    bf16_t* cB = sB + buf * (128 * 72);
#pragma unroll
    for (int i = 0; i < 4; ++i) {
      *(u32x4*)(cA + (r0 + 32 * i) * 72 + c8 * 8) = ra[i];
      *(u32x4*)(cB + (r0 + 32 * i) * 72 + c8 * 8) = rb[i];
    }
    __syncthreads();
    if (kt + 1 < nk) {
#pragma unroll
      for (int i = 0; i < 4; ++i) {
        ra[i] = *(const u32x4*)(A + aoff[i] + (size_t)(kt + 1) * a_kstride + c8 * 8);
        rb[i] = *(const u32x4*)(bbase + (size_t)i * 32 * K + (kt + 1) * 64);
      }
    }
#pragma unroll
    for (int ks = 0; ks < 2; ++ks) {
      bf16x8 af[4], bfr[4];
#pragma unroll
      for (int mt = 0; mt < 4; ++mt) af[mt] = *(const bf16x8*)(cA + (wm * 64 + mt * 16 + c16) * 72 + ks * 32 + lg * 8);
#pragma unroll
      for (int nt = 0; nt < 4; ++nt) bfr[nt] = *(const bf16x8*)(cB + (wn * 64 + nt * 16 + c16) * 72 + ks * 32 + lg * 8);
#pragma unroll
      for (int mt = 0; mt < 4; ++mt)
#pragma unroll
        for (int nt = 0; nt < 4; ++nt) {
          if (SWAP) acc[nt][mt] = mfma16(bfr[nt], af[mt], acc[nt][mt]);
          else acc[mt][nt] = mfma16(af[mt], bfr[nt], acc[mt][nt]);
        }
    }
  }
}

DI void epi_normrope(f32x4 (&acc)[4][4], int m_base  , int ncol_base  ,
                     bf16_t* __restrict__ dst, int ld, const float* __restrict__ gw, const float* __restrict__ rope, float oscale) {
  const int lane = tidx() & 63, c16 = lane & 15, lg = lane >> 4;
  float gwv[4][4];
#pragma unroll
  for (int nt = 0; nt < 4; ++nt)
#pragma unroll
    for (int j = 0; j < 4; ++j) gwv[nt][j] = gw[nt * 16 + lg * 4 + j];
#pragma unroll
  for (int mt = 0; mt < 4; ++mt) {
    const int m = m_base + mt * 16 + c16;
    float ss = 0.f;
#pragma unroll
    for (int nt = 0; nt < 4; ++nt)
#pragma unroll
      for (int j = 0; j < 4; ++j) ss += acc[nt][mt][j] * acc[nt][mt][j];
    ss += __shfl_xor(ss, 16);
    ss += __shfl_xor(ss, 32);
    const float rstd = __builtin_amdgcn_rsqf(ss * (1.f / 64.f) + EPS);
    float v[4][4];
#pragma unroll
    for (int nt = 0; nt < 4; ++nt)
#pragma unroll
      for (int j = 0; j < 4; ++j) v[nt][j] = acc[nt][mt][j] * rstd * gwv[nt][j];
    const float4 cs = *(const float4*)(rope + (size_t)m * 16 + (lg & 1) * 4);
    const float4 sn = *(const float4*)(rope + (size_t)m * 16 + 8 + (lg & 1) * 4);
    const float csv[4] = {cs.x, cs.y, cs.z, cs.w};
    const float snv[4] = {sn.x, sn.y, sn.z, sn.w};
#pragma unroll
    for (int j = 0; j < 4; ++j) {
      float mine = v[0][j];
      float other = __shfl_xor(mine, 32);
      float r = (lg < 2) ? (mine * csv[j] - other * snv[j]) : (mine * csv[j] + other * snv[j]);
      v[0][j] = r;
    }
#pragma unroll
    for (int nt = 0; nt < 4; ++nt) {
      u32x2 o;
      o.x = pack_bf2(v[nt][0] * oscale, v[nt][1] * oscale);
      o.y = pack_bf2(v[nt][2] * oscale, v[nt][3] * oscale);
      *(u32x2*)(dst + (size_t)m * ld + ncol_base + nt * 16 + lg * 4) = o;
    }
  }
}

template <int MODE>
DI void epi_store_bf16(f32x4 (&acc)[4][4], int m_base, int ncol_base, bf16_t* __restrict__ dst, int ld, const float* __restrict__ bias) {
  const int lane = tidx() & 63, c16 = lane & 15, lg = lane >> 4;
#pragma unroll
  for (int mt = 0; mt < 4; ++mt) {
    const int m = m_base + mt * 16 + c16;
#pragma unroll
    for (int nt = 0; nt < 4; ++nt) {
      float v[4];
#pragma unroll
      for (int j = 0; j < 4; ++j) {
        float a = acc[nt][mt][j];
        if (MODE == 1) a = siluf_(a);
        if (MODE == 2) a = geluf_(a + bias[ncol_base + nt * 16 + lg * 4 + j]);
        v[j] = a;
      }
      u32x2 o;
      o.x = pack_bf2(v[0], v[1]);
      o.y = pack_bf2(v[2], v[3]);
      *(u32x2*)(dst + (size_t)m * ld + ncol_base + nt * 16 + lg * 4) = o;
    }
  }
}

DI void epi_store_vt(f32x4 (&acc)[4][4], int m_base, int col_base, bf16_t* __restrict__ vt) {
  const int lane = tidx() & 63, c16 = lane & 15, lg = lane >> 4;
#pragma unroll
  for (int mt = 0; mt < 4; ++mt) {
    const int m = m_base + mt * 16 + lg * 4;
    const int b = m >> 11, s = m & 2047;
#pragma unroll
    for (int nt = 0; nt < 4; ++nt) {
      const int col = col_base + nt * 16 + c16;
      const int gh = col >> 6, d = col & 63;
      u32x2 o;
      o.x = pack_bf2(acc[mt][nt][0], acc[mt][nt][1]);
      o.y = pack_bf2(acc[mt][nt][2], acc[mt][nt][3]);
      *(u32x2*)(vt + ((size_t)((b * 4 + gh) * 64 + d)) * 2048 + s) = o;
    }
  }
}

namespace g8 {
constexpr int BM = 256, BK = 64, HALF = 128, HTB = HALF * BK * 2, NXCD = 8, WGM = 8;
DI int lds_byte(int r, int c) { const int st = (r >> 4) * 2 + (c >> 5), rr = r & 15, cc = c & 31, ob = rr * 64 + cc * 2; return st * 1024 + (ob ^ (((ob >> 9) & 1) << 5)); }
DI void stage_rc(int b, int& R, int& C) { const int st = b / 1024, sb = b % 1024, swz = sb ^ (((sb >> 9) & 1) << 5); R = (st >> 1) * 16 + swz / 64; C = (st & 1) * 32 + (swz % 64) / 2; }
struct Unit { int pm, pn; };
struct StaticOrder {
  int nM, nN, nwg, G, c;
  DI void init(int M, int N, int G_, int c_) { nM = M / BM; nN = N / BM; nwg = nM * nN; G = G_; c = c_; }
  DI bool next(int i, Unit& u) const {
    const long L = (long)i * G + c; if (L >= nwg) return false;
    int wgid = (int)L; { const int q = nwg / NXCD, r = nwg % NXCD, xcd = wgid % NXCD, off = wgid / NXCD; wgid = (xcd < r ? xcd * (q + 1) : r * (q + 1) + (xcd - r) * q) + off; }
    const int nig = WGM * nN, gid = wgid / nig, fm = gid * WGM, gsz = (nM - fm) < WGM ? (nM - fm) : WGM;
    u.pm = fm + ((wgid % nig) % gsz); u.pn = (wgid % nig) / gsz; return true;
  }
};
template <class Epi>
DI void gemm_phase(LAS unsigned char* lds, const bf16_t* gA, const bf16_t* gBt, int K, const StaticOrder& S, const Epi& E) {
  int tid = __builtin_amdgcn_workitem_id_x();
  asm volatile("" : "+v"(tid));
  const int wid = __builtin_amdgcn_readfirstlane(tid >> 6), lane = tid & 63, wr = wid >> 2, wc = wid & 3, fr = lane & 15, fq = lane >> 4;
  const int nt = K / BK;
  unsigned voffA[2], voffB[2];
#pragma unroll
  for (int i = 0; i < 2; ++i) { int R, C; stage_rc(tid * 16 + i * 8192, R, C); voffA[i] = (unsigned)(R * K + C) * 2u; voffB[i] = voffA[i]; }
  const size_t kstep = (size_t)(BK * 2);
  const size_t hstep = (size_t)HALF * K * 2;
  const size_t tstep = 2 * hstep;
  const unsigned ldsw = (unsigned)wid * 1024u;
  const int aoff = lds_byte(wr * 64 + fr, fq * 8), boff = lds_byte(wc * 32 + fr, fq * 8);
#define G8_SA(b, h) (((b) * 2 + (h)) * HTB)
#define G8_SB(b, h) ((4 + (b) * 2 + (h)) * HTB)
#define G8_STAGE(bufoff, gbase, voff) do { _Pragma("unroll") for (int _i = 0; _i < 2; ++_i) \
    __builtin_amdgcn_global_load_lds((const unsigned*)((const char*)(gbase) + (voff)[_i]), (LAS unsigned*)(lds + (bufoff) + ldsw + _i * 8192), 16, 0, 0); } while (0)
#define G8_LDA(dst, b, h) do { _Pragma("unroll") for (int m = 0; m < 4; ++m) _Pragma("unroll") for (int k = 0; k < 2; ++k) dst[m][k] = *(const LAS bf16x8*)(lds + G8_SA(b, h) + aoff + m * 2048 + k * 1024); } while (0)
#define G8_LDB(dst, b, h) do { _Pragma("unroll") for (int n = 0; n < 2; ++n) _Pragma("unroll") for (int k = 0; k < 2; ++k) dst[n][k] = *(const LAS bf16x8*)(lds + G8_SB(b, h) + boff + n * 2048 + k * 1024); } while (0)
#define G8_MMA(ai, bj, At, Bt) do { __builtin_amdgcn_s_setprio(1); _Pragma("unroll") for (int m = 0; m < 4; ++m) _Pragma("unroll") for (int n = 0; n < 2; ++n) _Pragma("unroll") for (int k = 0; k < 2; ++k) \
    acc[ai][bj][m][n] = __builtin_amdgcn_mfma_f32_16x16x32_bf16(Bt[n][k], At[m][k], acc[ai][bj][m][n], 0, 0, 0); __builtin_amdgcn_s_setprio(0); } while (0)
#define G8_WAIT_V(n) asm volatile("s_waitcnt vmcnt(" #n ")" ::: "memory")
#define G8_WAIT_L(n) asm volatile("s_waitcnt lgkmcnt(" #n ")" ::: "memory")
#define G8_BAR __builtin_amdgcn_s_barrier()
#define G8_SCHED __builtin_amdgcn_sched_barrier(0)
  Unit cur, nxt; int ui = 0;
  if (!S.next(0, cur)) return;
  f32x4 acc[2][2][4][2];
#pragma unroll
  for (int a = 0; a < 2; ++a)
#pragma unroll
    for (int b = 0; b < 2; ++b)
#pragma unroll
      for (int m = 0; m < 4; ++m)
#pragma unroll
        for (int n = 0; n < 2; ++n) acc[a][b][m][n] = (f32x4){0.f, 0.f, 0.f, 0.f};
  bf16x8 At[4][2], B0[2][2], B1[2][2];
  const char* cA = (const char*)gA + (size_t)cur.pm * tstep; const char* cB = (const char*)gBt + (size_t)cur.pn * tstep;
  G8_STAGE(G8_SB(0, 0), cB, voffB); G8_STAGE(G8_SA(0, 0), cA, voffA); G8_STAGE(G8_SB(0, 1), cB + hstep, voffB); G8_STAGE(G8_SA(0, 1), cA + hstep, voffA);
  if (wr == 1) G8_BAR;
  G8_WAIT_V(4); G8_BAR;
  G8_STAGE(G8_SB(1, 0), cB + kstep, voffB); G8_STAGE(G8_SA(1, 0), cA + kstep, voffA); G8_STAGE(G8_SB(1, 1), cB + hstep + kstep, voffB);
  G8_WAIT_V(6); G8_BAR;
  for (;;) {
    const bool has_next = S.next(ui + 1, nxt);
    const char* nA = has_next ? (const char*)gA + (size_t)nxt.pm * tstep : cA; const char* nB = has_next ? (const char*)gBt + (size_t)nxt.pn * tstep : cB;
    for (int t = 0; t < nt; t += 2) {
      const bool last = (t == nt - 2);
      const char* a1 = cA + (size_t)(t + 1) * kstep;
      const char* a2 = last ? nA : cA + (size_t)(t + 2) * kstep; const char* b2 = last ? nB : cB + (size_t)(t + 2) * kstep;
      const char* a3 = a2 + kstep; const char* b3 = b2 + kstep;
      G8_LDB(B0, 0, 0); G8_SCHED; G8_LDA(At, 0, 0); G8_STAGE(G8_SA(1, 1), a1 + hstep, voffA);
      G8_WAIT_L(8); G8_BAR; G8_WAIT_L(0); G8_MMA(0, 0, At, B0); G8_BAR; G8_SCHED;
      G8_LDB(B1, 0, 1); G8_STAGE(G8_SB(0, 0), b2, voffB);
      G8_BAR; G8_WAIT_L(0); G8_MMA(0, 1, At, B1); G8_BAR;
      G8_LDA(At, 0, 1); G8_STAGE(G8_SA(0, 0), a2, voffA);
      G8_BAR; G8_WAIT_L(0); G8_MMA(1, 0, At, B0); G8_BAR; G8_SCHED;
      G8_STAGE(G8_SB(0, 1), b2 + hstep, voffB);
      G8_WAIT_V(6); G8_BAR; G8_MMA(1, 1, At, B1); G8_BAR;
      G8_LDB(B0, 1, 0); G8_SCHED; G8_LDA(At, 1, 0); G8_STAGE(G8_SA(0, 1), a2 + hstep, voffA);
      G8_WAIT_L(8); G8_BAR; G8_WAIT_L(0); G8_MMA(0, 0, At, B0); G8_BAR; G8_SCHED;
      G8_LDB(B1, 1, 1); G8_STAGE(G8_SB(1, 0), b3, voffB);
      G8_BAR; G8_WAIT_L(0); G8_MMA(0, 1, At, B1); G8_BAR;
      G8_LDA(At, 1, 1); G8_STAGE(G8_SA(1, 0), a3, voffA);
      G8_BAR; G8_WAIT_L(0); G8_MMA(1, 0, At, B0); G8_BAR; G8_SCHED;
      G8_STAGE(G8_SB(1, 1), b3 + hstep, voffB);
      G8_WAIT_V(6); G8_BAR; G8_MMA(1, 1, At, B1); G8_BAR;
    }
    E(acc, cur, wr, wc, fr, fq);
    if (!has_next) break;
#pragma unroll
    for (int a = 0; a < 2; ++a)
#pragma unroll
      for (int b = 0; b < 2; ++b)
#pragma unroll
        for (int m = 0; m < 4; ++m)
#pragma unroll
          for (int n = 0; n < 2; ++n) acc[a][b][m][n] = (f32x4){0.f, 0.f, 0.f, 0.f};
    cur = nxt; cA = nA; cB = nB; ++ui;
  }
  G8_WAIT_V(0);
  if (wr == 0) G8_BAR;
  G8_BAR;
#undef G8_SA
#undef G8_SB
#undef G8_STAGE
#undef G8_LDA
#undef G8_LDB
#undef G8_MMA
#undef G8_WAIT_V
#undef G8_WAIT_L
#undef G8_BAR
#undef G8_SCHED
}
}

typedef const f32x4 (&Acc8)[2][2][4][2];
DI void epi8_normrope(Acc8 acc, int row0, int colbase, bf16_t* __restrict__ dst, int ld, const float* __restrict__ gw, const float* __restrict__ rope,
                      float oscale, int fq) {
  float gwv[2][2][4];
#pragma unroll
  for (int bj = 0; bj < 2; ++bj)
#pragma unroll
    for (int n = 0; n < 2; ++n)
#pragma unroll
      for (int j = 0; j < 4; ++j) gwv[bj][n][j] = gw[32 * bj + 16 * n + 4 * fq + j];
#pragma unroll
  for (int am = 0; am < 4; ++am) {
    const int ai = am >> 1;
    f32x4 csv[2], snv[2];
#pragma unroll
    for (int mm = 0; mm < 2; ++mm) {
      const int r = row0 + 128 * ai + 16 * ((am & 1) * 2 + mm);
      csv[mm] = *(const f32x4*)(rope + (size_t)r * 16 + (fq & 1) * 4);
      snv[mm] = *(const f32x4*)(rope + (size_t)r * 16 + 8 + (fq & 1) * 4);
    }
#pragma unroll
    for (int mm = 0; mm < 2; ++mm) {
      const int m = (am & 1) * 2 + mm;
      const int r = row0 + 128 * ai + 16 * m;
      float ss = 0.f;
#pragma unroll
      for (int bj = 0; bj < 2; ++bj)
#pragma unroll
        for (int n = 0; n < 2; ++n)
#pragma unroll
          for (int j = 0; j < 4; ++j) ss += acc[ai][bj][m][n][j] * acc[ai][bj][m][n][j];
      ss += __shfl_xor(ss, 16);
      ss += __shfl_xor(ss, 32);
      const float rstd = __builtin_amdgcn_rsqf(ss * (1.f / 64.f) + EPS);
      float v[2][2][4];
#pragma unroll
      for (int bj = 0; bj < 2; ++bj)
#pragma unroll
        for (int n = 0; n < 2; ++n)
#pragma unroll
          for (int j = 0; j < 4; ++j) v[bj][n][j] = acc[ai][bj][m][n][j] * rstd * gwv[bj][n][j];
      const f32x4 cs = csv[mm], sn = snv[mm];
#pragma unroll
      for (int j = 0; j < 4; ++j) {
        const float mine = v[0][0][j];
        const float other = __shfl_xor(mine, 32);
        v[0][0][j] = (fq < 2) ? (mine * cs[j] - other * sn[j]) : (mine * cs[j] + other * sn[j]);
      }
#pragma unroll
      for (int bj = 0; bj < 2; ++bj)
#pragma unroll
        for (int n = 0; n < 2; ++n) {
          u32x2 o;
          o.x = pack_bf2(v[bj][n][0] * oscale, v[bj][n][1] * oscale);
          o.y = pack_bf2(v[bj][n][2] * oscale, v[bj][n][3] * oscale);
          *(u32x2*)(dst + (size_t)r * ld + colbase + 32 * bj + 16 * n + 4 * fq) = o;
        }
    }
  }
}
template <int MODE>
DI void epi8_store_bf16(Acc8 acc, int row0, int colbase, bf16_t* __restrict__ dst, int ld, int fq) {
#pragma unroll
  for (int ai = 0; ai < 2; ++ai)
#pragma unroll
    for (int m = 0; m < 4; ++m) {
      const int r = row0 + 128 * ai + 16 * m;
#pragma unroll
      for (int bj = 0; bj < 2; ++bj)
#pragma unroll
        for (int n = 0; n < 2; ++n) {
          float v[4];
#pragma unroll
          for (int j = 0; j < 4; ++j) { float a = acc[ai][bj][m][n][j]; if (MODE == 1) a = siluf_(a); v[j] = a; }
          u32x2 o;
          o.x = pack_bf2(v[0], v[1]);
          o.y = pack_bf2(v[2], v[3]);
          *(u32x2*)(dst + (size_t)r * ld + colbase + 32 * bj + 16 * n + 4 * fq) = o;
        }
    }
}
DI void epi8_store_vt(Acc8 acc, int row0, int gh, bf16_t* __restrict__ vt, int fr, int fq) {
  const int q = fr & 3;
  const bool odd = (q & 1) != 0, upper = q >= 2;
  const int dsel = 2 * (q & 1) + (q >> 1);
#pragma unroll
  for (int ai = 0; ai < 2; ++ai)
#pragma unroll
    for (int m = 0; m < 4; ++m) {
      const int r = row0 + 128 * ai + 16 * m;
      const int b = r >> 11, sb = (r & 2047) - q;
#pragma unroll
      for (int bj = 0; bj < 2; ++bj)
#pragma unroll
        for (int n = 0; n < 2; ++n) {
          const float v0 = acc[ai][bj][m][n][0], v1 = acc[ai][bj][m][n][1], v2 = acc[ai][bj][m][n][2], v3 = acc[ai][bj][m][n][3];
          const float s0 = odd ? v0 : v2, s1 = odd ? v1 : v3;
          const float r0 = __shfl_xor(s0, 1), r1 = __shfl_xor(s1, 1);
          const float w0 = odd ? r0 : v0, w1 = odd ? r1 : v1, w2 = odd ? v2 : r0, w3 = odd ? v3 : r1;
          const float t0 = upper ? w0 : w1, t1 = upper ? w2 : w3;
          const float x0 = __shfl_xor(t0, 2), x1 = __shfl_xor(t1, 2);
          const float o0 = upper ? x0 : w0, o1 = upper ? x1 : w2, o2 = upper ? w1 : x0, o3 = upper ? w3 : x1;
          const int d = 32 * bj + 16 * n + 4 * fq + dsel;
          u32x2 o;
          o.x = pack_bf2(o0, o1);
          o.y = pack_bf2(o2, o3);
          *(u32x2*)(vt + ((size_t)((b * 4 + gh) * 64 + d)) * 2048 + sb) = o;
        }
    }
}

struct InProjEpi {
  Params p; int layer;
  DI void operator()(Acc8 acc, const g8::Unit& u, int wr, int wc, int fr, int fq) const {
    const bool nsa = (layer & 1) == 0;
    const int lj = layer >> 1;
    const int pn = u.pn;
    const int row0 = u.pm * 256 + wr * 64 + fr;
    const float* rope = (const float*)(p.ws + OFF_ROPE);
    if (pn < 4) {
      epi8_normrope(acc, row0, pn * 256 + wc * 64, (bf16_t*)(p.ws + OFF_Q), 1024, (nsa ? p.nsa_qn : p.moba_qn) + lj * 64, rope, QSCALE, fq);
    } else if (nsa) {
      if (pn == 4) epi8_store_bf16<0>(acc, row0, wc * 64, (bf16_t*)(p.ws + OFF_KC), 256, fq);
      else if (pn == 5) epi8_store_bf16<0>(acc, row0, wc * 64, (bf16_t*)(p.ws + OFF_VC), 256, fq);
      else if (pn == 6) epi8_normrope(acc, row0, wc * 64, (bf16_t*)(p.ws + OFF_KS), 256, p.nsa_kn + (lj * 3 + 1) * 64, rope, 1.0f, fq);
      else if (pn == 7) epi8_store_vt(acc, row0, wc, (bf16_t*)(p.ws + OFF_VST), fr, fq);
      else if (pn == 8) epi8_normrope(acc, row0, wc * 64, (bf16_t*)(p.ws + OFF_KW), 256, p.nsa_kn + (lj * 3 + 2) * 64, rope, 1.0f, fq);
      else if (pn == 9) epi8_store_vt(acc, row0, wc, (bf16_t*)(p.ws + OFF_VWT), fr, fq);
      else epi8_store_bf16<1>(acc, row0, (pn - 10) * 256 + wc * 64, (bf16_t*)(p.ws + OFF_SZ), 1024, fq);
    } else {
      if (pn == 4) epi8_normrope(acc, row0, wc * 64, (bf16_t*)(p.ws + OFF_KS), 256, p.moba_kn + lj * 64, rope, 1.0f, fq);
      else if (pn == 5) epi8_store_vt(acc, row0, wc, (bf16_t*)(p.ws + OFF_VST), fr, fq);
      else epi8_store_bf16<1>(acc, row0, (pn - 6) * 256 + wc * 64, (bf16_t*)(p.ws + OFF_SZ), 1024, fq);
    }
  }
};
struct OutProjEpi {
  Params p; int layer; const float* xin;
  DI void operator()(Acc8 acc, const g8::Unit& u, int wr, int wc, int fr, int fq) const {
    const int row0 = u.pm * 256 + wr * 64 + fr;
    const int b = (u.pm * 256) >> 11;
    const float* gatev = (const float*)(p.ws + OFF_MOD) + (size_t)(layer * 16 + b) * 3072 + 2048;
#pragma unroll
    for (int bj = 0; bj < 2; ++bj)
#pragma unroll
      for (int n = 0; n < 2; ++n) {
        const int c = u.pn * 256 + wc * 64 + 32 * bj + 16 * n + 4 * fq;
        const f32x4 gv = *(const f32x4*)(gatev + c);
#pragma unroll
        for (int ai = 0; ai < 2; ++ai) {
          f32x4 xv[4];
#pragma unroll
          for (int m = 0; m < 4; ++m) xv[m] = *(const f32x4*)(xin + (size_t)(row0 + 128 * ai + 16 * m) * 1024 + c);
#pragma unroll
          for (int m = 0; m < 4; ++m) *(f32x4*)(p.out + (size_t)(row0 + 128 * ai + 16 * m) * 1024 + c) = xv[m] + gv * acc[ai][bj][m][n];
        }
      }
  }
};

DI void gates_tile(const Params& p, int lj, int tile, char* smem) {
  const int m0 = tile * 128;
  const int tid = tidx(), lane = tid & 63, w = tid >> 6, wm = w >> 1, wn = w & 1, c16 = lane & 15, lg = lane >> 4;
  const bf16_t* A = (const bf16_t*)(p.ws + OFF_H);
  const bf16_t* Bt = (const bf16_t*)(p.ws + OFF_WT_GL) + (size_t)lj * 128 * 1024;
  unsigned aoff[4];
#pragma unroll
  for (int i = 0; i < 4; ++i) aoff[i] = (unsigned)(m0 + (tid >> 3) + 32 * i) * 1024u;
  f32x4 acc[4][4];
  gemm_mainloop<true>(A, aoff, 64, Bt, 1024, 0, smem, acc);
  float* gates = (float*)(p.ws + OFF_GATES);
  const float* gb = p.gate_b + lj * 48;
  if (wn == 0) {
#pragma unroll
    for (int mt = 0; mt < 4; ++mt) {
      const int m = m0 + wm * 64 + mt * 16 + c16;
#pragma unroll
      for (int nt = 0; nt < 3; ++nt) {
        const int nl = nt * 16 + lg * 4;
        f32x4 o;
        o[0] = sigmoidf_(acc[nt][mt][0] + gb[nl + 0]);
        o[1] = sigmoidf_(acc[nt][mt][1] + gb[nl + 1]);
        o[2] = sigmoidf_(acc[nt][mt][2] + gb[nl + 2]);
        o[3] = sigmoidf_(acc[nt][mt][3] + gb[nl + 3]);
        *(f32x4*)(gates + (size_t)m * 48 + nl) = o;
      }
    }
  }
}

DI void cmp1_tile(const Params& p, int lj, int tile, char* smem) {
  const int i = tile >> 7, t = tile & 127;
  const int mtile = t >> 1, ntile = t & 1;
  const int m0 = mtile * 128, n0 = ntile * 128;
  const int tid = tidx(), w = tid >> 6, wm = w >> 1, wn = w & 1;
  const bf16_t* A = (const bf16_t*)(p.ws + (i == 0 ? OFF_KC : OFF_VC));
  const bf16_t* Bt = (const bf16_t*)(p.ws + OFF_WT_CMP1) + (size_t)(lj * 2 + i) * 256 * 2048;
  unsigned aoff[4];
#pragma unroll
  for (int q = 0; q < 4; ++q) {
    int m = m0 + (tid >> 3) + 32 * q;
    int g = m & 3, n = (m >> 2) & 127, b = m >> 9;
    if (n > 126) n = 126;
    aoff[q] = (unsigned)((b * 2048 + 16 * n) * 256 + g * 64);
  }
  f32x4 acc[4][4];
  gemm_mainloop<true>(A, aoff, 256, Bt, 2048, n0, smem, acc);
  bf16_t* hid = (bf16_t*)(p.ws + OFF_HID) + (size_t)i * 8192 * 256;
  const float* b1 = (const float*)(p.ws + OFF_B1EFF) + (lj * 2 + i) * 256;
  epi_store_bf16<2>(acc, m0 + wm * 64, n0 + wn * 64, hid, 256, b1);
}

DI void cmp2_item(const Params& p, int lj, int item, char* smem) {
  const int tid = tidx();
  const int i = item >> 7, rt = item & 127;
  float* w2s = (float*)smem;
  const float* W2 = p.cmp_w2 + (size_t)(lj * 2 + i) * 256 * 64;
  __syncthreads();
  for (int q = tid; q < 256 * 64 / 4; q += 256) ((float4*)w2s)[q] = ((const float4*)W2)[q];
  __syncthreads();
  const int row = tid >> 2, cq = tid & 3;
  const int m = rt * 64 + row;
  const bf16_t* hid = (const bf16_t*)(p.ws + OFF_HID) + ((size_t)i * 8192 + m) * 256;
  float acc[16];
#pragma unroll
  for (int d = 0; d < 16; ++d) acc[d] = 0.f;
  for (int k8 = 0; k8 < 32; ++k8) {
    u32x4 hv = *(const u32x4*)(hid + k8 * 8);
    float hf[8] = {bflo(hv.x), bfhi(hv.x), bflo(hv.y), bfhi(hv.y), bflo(hv.z), bfhi(hv.z), bflo(hv.w), bfhi(hv.w)};
#pragma unroll
    for (int kk = 0; kk < 8; ++kk) {
      const float4* wr = (const float4*)(w2s + (k8 * 8 + kk) * 64 + cq * 16);
      float4 w0 = wr[0], w1 = wr[1], w2 = wr[2], w3 = wr[3];
      float h = hf[kk];
      acc[0] += h * w0.x; acc[1] += h * w0.y; acc[2] += h * w0.z; acc[3] += h * w0.w;
      acc[4] += h * w1.x; acc[5] += h * w1.y; acc[6] += h * w1.z; acc[7] += h * w1.w;
      acc[8] += h * w2.x; acc[9] += h * w2.y; acc[10] += h * w2.z; acc[11] += h * w2.w;
      acc[12] += h * w3.x; acc[13] += h * w3.y; acc[14] += h * w3.z; acc[15] += h * w3.w;
    }
  }
  const int g = m & 3, n = (m >> 2) & 127, b = m >> 9;
  const bool valid = n < 127;
  if (i == 0) {
    float ss = 0.f;
#pragma unroll
    for (int d = 0; d < 16; ++d) ss += acc[d] * acc[d];
    ss += __shfl_xor(ss, 1);
    ss += __shfl_xor(ss, 2);
    const float rstd = __builtin_amdgcn_rsqf(ss * (1.f / 64.f) + EPS);
    const float* gw = p.nsa_kn + (lj * 3 + 0) * 64 + cq * 16;
#pragma unroll
    for (int d = 0; d < 16; ++d) acc[d] = acc[d] * rstd * gw[d];
    if (cq == 0) {
      const int tokc = b * 2048 + (valid ? 16 * n + 31 : 2047);
      const float* rp = (const float*)(p.ws + OFF_ROPE) + (size_t)tokc * 16;
#pragma unroll
      for (int d = 0; d < 8; ++d) {
        float c = rp[d], s = rp[8 + d];
        float x1 = acc[d], x2 = acc[d + 8];
        acc[d] = x1 * c - x2 * s;
        acc[d + 8] = x2 * c + x1 * s;
      }
    }
    bf16_t* dst = (bf16_t*)(p.ws + OFF_KCMP) + ((size_t)((b * 4 + g) * 128 + n)) * 64 + cq * 16;
    u32x4 o0, o1;
    if (valid) {
      o0.x = pack_bf2(acc[0], acc[1]); o0.y = pack_bf2(acc[2], acc[3]); o0.z = pack_bf2(acc[4], acc[5]); o0.w = pack_bf2(acc[6], acc[7]);
      o1.x = pack_bf2(acc[8], acc[9]); o1.y = pack_bf2(acc[10], acc[11]); o1.z = pack_bf2(acc[12], acc[13]); o1.w = pack_bf2(acc[14], acc[15]);
    } else {
      o0 = u32x4{0u, 0u, 0u, 0u}; o1 = o0;
    }
    *(u32x4*)(dst) = o0;
    *(u32x4*)(dst + 8) = o1;
  } else {
    bf16_t* dst = (bf16_t*)(p.ws + OFF_VCMPT) + ((size_t)((b * 4 + g) * 64 + cq * 16)) * 128 + n;
#pragma unroll
    for (int d = 0; d < 16; ++d) {
      unsigned u = pack_bf2(valid ? acc[d] : 0.f, 0.f);
      dst[(size_t)d * 128] = (bf16_t)(u & 0xffff);
    }
  }
}

DI void kmean_item(const Params& p, int item, char* smem) {
  const int tid = tidx();
  const int blk = item & 7, g = (item >> 3) & 3, b = item >> 5;
  const int d8 = tid & 7, rg = tid >> 3;
  const bf16_t* K = (const bf16_t*)(p.ws + OFF_KS) + ((size_t)(b * 2048 + blk * 256)) * 256 + g * 64 + d8 * 8;
  float s[8];
#pragma unroll
  for (int q = 0; q < 8; ++q) s[q] = 0.f;
#pragma unroll
  for (int r = 0; r < 8; ++r) {
    u32x4 v = *(const u32x4*)(K + (size_t)(rg + 32 * r) * 256);
    s[0] += bflo(v.x); s[1] += bfhi(v.x); s[2] += bflo(v.y); s[3] += bfhi(v.y);
    s[4] += bflo(v.z); s[5] += bfhi(v.z); s[6] += bflo(v.w); s[7] += bfhi(v.w);
  }
  float* red = (float*)smem;
  __syncthreads();
#pragma unroll
  for (int q = 0; q < 8; ++q) red[rg * 64 + d8 * 8 + q] = s[q];
  __syncthreads();
  if (tid < 64) {
    float t = 0.f;
    for (int r = 0; r < 32; ++r) t += red[r * 64 + tid];
    bf16_t* km = (bf16_t*)(p.ws + OFF_KMEAN) + (size_t)((b * 4 + g) * 16) * 64;
    km[blk * 64 + tid] = (bf16_t)(pack_bf2(t * (1.f / 256.f), 0.f) & 0xffff);
    km[(8 + blk) * 64 + tid] = 0;
  }
}

template <bool NOMASK, bool FIXED>
DI void attn_block64(const bf16_t* __restrict__ Ks, const bf16_t* __restrict__ Vs, const bf16x8 (&Qb)[2][2], f32x4 (&O)[4][2], float (&mrun)[2],
                     float (&lrun)[2], const int (&lo)[2], const int (&hi)[2]) {
  const int lane = tidx() & 63, c16 = lane & 15, lg = lane >> 4;
  f32x4 Sx[4][2];
#pragma unroll
  for (int kt = 0; kt < 4; ++kt) {
    Sx[kt][0] = f32x4{0.f, 0.f, 0.f, 0.f};
    Sx[kt][1] = f32x4{0.f, 0.f, 0.f, 0.f};
#pragma unroll
    for (int ks = 0; ks < 2; ++ks) {
      bf16x8 a = *(const bf16x8*)(Ks + (kt * 16 + c16) * 72 + ks * 32 + lg * 8);
      Sx[kt][0] = mfma16(a, Qb[0][ks], Sx[kt][0]);
      Sx[kt][1] = mfma16(a, Qb[1][ks], Sx[kt][1]);
    }
  }
  if (FIXED) {
#pragma unroll
    for (int ct = 0; ct < 2; ++ct) {
      float rs = 0.f;
#pragma unroll
      for (int kt = 0; kt < 4; ++kt)
#pragma unroll
        for (int j = 0; j < 4; ++j) {
          float s = Sx[kt][ct][j];
          if (!NOMASK) {
            const int idx = kt * 16 + j;
            s = (idx > lo[ct] && idx <= hi[ct]) ? s : NEG;
          }
          const float pv = fexp2(s);
          Sx[kt][ct][j] = pv;
          rs += pv;
        }
      lrun[ct] += rs;
    }
  } else {
#pragma unroll
  for (int ct = 0; ct < 2; ++ct) {
    float mx = NEG;
#pragma unroll
    for (int kt = 0; kt < 4; ++kt)
#pragma unroll
      for (int j = 0; j < 4; ++j) {
        float s = Sx[kt][ct][j];
        if (!NOMASK) {
          const int idx = kt * 16 + j;
          s = (idx > lo[ct] && idx <= hi[ct]) ? s : NEG;
          Sx[kt][ct][j] = s;
        }
        mx = fmaxf(mx, s);
      }
    mx = fmaxf(mx, __shfl_xor(mx, 16));
    mx = fmaxf(mx, __shfl_xor(mx, 32));
    const float mn = fmaxf(mrun[ct], mx);
    const float alpha = fexp2(mrun[ct] - mn);
    mrun[ct] = mn;
    const float msafe = mn < -1e29f ? 0.f : mn;
    float rs = 0.f;
#pragma unroll
    for (int kt = 0; kt < 4; ++kt)
#pragma unroll
      for (int j = 0; j < 4; ++j) {
        float pv = fexp2(Sx[kt][ct][j] - msafe);
        Sx[kt][ct][j] = pv;
        rs += pv;
      }
    lrun[ct] = lrun[ct] * alpha + rs;
#pragma unroll
    for (int dt = 0; dt < 4; ++dt) O[dt][ct] *= alpha;
  }
  }
#pragma unroll
  for (int kp = 0; kp < 2; ++kp) {
    bf16x8 Pb[2];
#pragma unroll
    for (int ct = 0; ct < 2; ++ct) {
      u32x4 u;
      u.x = pack_bf2(Sx[2 * kp][ct][0], Sx[2 * kp][ct][1]);
      u.y = pack_bf2(Sx[2 * kp][ct][2], Sx[2 * kp][ct][3]);
      u.z = pack_bf2(Sx[2 * kp + 1][ct][0], Sx[2 * kp + 1][ct][1]);
      u.w = pack_bf2(Sx[2 * kp + 1][ct][2], Sx[2 * kp + 1][ct][3]);
      Pb[ct] = __builtin_bit_cast(bf16x8, u);
    }
#pragma unroll
    for (int dt = 0; dt < 4; ++dt) {
      u32x2 v0 = *(const u32x2*)(Vs + (dt * 16 + c16) * 72 + kp * 32 + lg * 4);
      u32x2 v1 = *(const u32x2*)(Vs + (dt * 16 + c16) * 72 + kp * 32 + 16 + lg * 4);
      u32x4 u = u32x4{v0.x, v0.y, v1.x, v1.y};
      bf16x8 va = __builtin_bit_cast(bf16x8, u);
      O[dt][0] = mfma16(va, Pb[0], O[dt][0]);
      O[dt][1] = mfma16(va, Pb[1], O[dt][1]);
    }
  }
}

template <int MODE, bool FIXED>
DI void attn_range(const bf16_t* __restrict__ Kg, const bf16_t* __restrict__ VTg, int j0, int j1, char* smem, int& buf, const bf16x8 (&Qb)[2][2],
                   f32x4 (&O)[4][2], float (&mrun)[2], float (&lrun)[2], const int (&tq)[2], const unsigned (&selbits)[2], int own) {
  const int tid = tidx(), lane = tid & 63, lg = lane >> 4;
  const int r0 = tid >> 3, c8 = tid & 7;
  bf16_t* sK = (bf16_t*)smem;
  bf16_t* sV = (bf16_t*)(smem + 18432);
  u32x4 rk[2], rv[2];
  if (j0 <= j1) {
#pragma unroll
    for (int i = 0; i < 2; ++i) {
      rk[i] = *(const u32x4*)(Kg + (size_t)(j0 * 64 + r0 + 32 * i) * 256 + c8 * 8);
      rv[i] = *(const u32x4*)(VTg + (size_t)(r0 + 32 * i) * 2048 + j0 * 64 + c8 * 8);
    }
  }
  for (int j = j0; j <= j1; ++j) {
    bf16_t* cK = sK + buf * (64 * 72);
    bf16_t* cV = sV + buf * (64 * 72);
#pragma unroll
    for (int i = 0; i < 2; ++i) {
      *(u32x4*)(cK + (r0 + 32 * i) * 72 + c8 * 8) = rk[i];
      *(u32x4*)(cV + (r0 + 32 * i) * 72 + c8 * 8) = rv[i];
    }
    __syncthreads();
    if (j + 1 <= j1) {
#pragma unroll
      for (int i = 0; i < 2; ++i) {
        rk[i] = *(const u32x4*)(Kg + (size_t)((j + 1) * 64 + r0 + 32 * i) * 256 + c8 * 8);
        rv[i] = *(const u32x4*)(VTg + (size_t)(r0 + 32 * i) * 2048 + (j + 1) * 64 + c8 * 8);
      }
    }
    int lo[2], hi[2];
    const int kb = j * 64;
#pragma unroll
    for (int ct = 0; ct < 2; ++ct) {
      const int rel = tq[ct] - kb - lg * 4;
      if (MODE == 0) {
        hi[ct] = ((selbits[ct] >> j) & 1u) ? (j < j1 ? 1000 : rel) : -1;
        lo[ct] = -1000;
      } else if (MODE == 1) {
        hi[ct] = rel;
        lo[ct] = rel - 256;
      } else {
        const int jb = j >> 2;
        if (jb < own) hi[ct] = ((selbits[ct] >> jb) & 1u) ? 1000 : -1;
        else hi[ct] = (j < j1 ? 1000 : rel);
        lo[ct] = -1000;
      }
    }
    const bool act = (hi[0] >= 0 && lo[0] < 63) || (hi[1] >= 0 && lo[1] < 63);
    if (__any(act)) {
      const bool full = hi[0] >= 63 && lo[0] < 0 && hi[1] >= 63 && lo[1] < 0;
      if (__all(full)) attn_block64<true, FIXED>(cK, cV, Qb, O, mrun, lrun, lo, hi);
      else attn_block64<false, FIXED>(cK, cV, Qb, O, mrun, lrun, lo, hi);
    }
    buf ^= 1;
  }
}

DI void load_q(const Params& p, int b, int g, int tw  , bf16x8 (&Qb)[2][2]) {
  const int lane = tidx() & 63, c16 = lane & 15, lg = lane >> 4;
  const bf16_t* q = (const bf16_t*)(p.ws + OFF_Q);
#pragma unroll
  for (int ct = 0; ct < 2; ++ct) {
    const int t = tw + ct * 4 + (c16 >> 2), head = g * 4 + (c16 & 3);
    const bf16_t* qp = q + ((size_t)(b * 2048 + t)) * 1024 + head * 64 + lg * 8;
    Qb[ct][0] = *(const bf16x8*)(qp);
    Qb[ct][1] = *(const bf16x8*)(qp + 32);
  }
}

DI void store_y(const Params& p, int b, int g, int tw, const f32x4 (&Ot)[4][2]) {
  const int lane = tidx() & 63, c16 = lane & 15, lg = lane >> 4;
  const bf16_t* sz = (const bf16_t*)(p.ws + OFF_SZ);
  bf16_t* y = (bf16_t*)(p.ws + OFF_H);
#pragma unroll
  for (int ct = 0; ct < 2; ++ct) {
    const int t = tw + ct * 4 + (c16 >> 2), head = g * 4 + (c16 & 3);
    const size_t base = ((size_t)(b * 2048 + t)) * 1024 + head * 64 + lg * 4;
#pragma unroll
    for (int dt = 0; dt < 4; ++dt) {
      u32x2 zz = *(const u32x2*)(sz + base + dt * 16);
      u32x2 o;
      o.x = pack_bf2(Ot[dt][ct][0] * bflo(zz.x), Ot[dt][ct][1] * bfhi(zz.x));
      o.y = pack_bf2(Ot[dt][ct][2] * bflo(zz.y), Ot[dt][ct][3] * bfhi(zz.y));
      *(u32x2*)(y + base + dt * 16) = o;
    }
  }
}

template <bool FIXED>
DI void nsa_attn_item(const Params& p, int item, char* smem) {
  const int tid = tidx(), lane = tid & 63, w = tid >> 6, c16 = lane & 15, lg = lane >> 4;
  const int bg = item & 63, qb = 63 - (item >> 6);
  const int b = bg >> 2, g = bg & 3;
  const int t0 = qb * 32, tw = t0 + w * 8;
  const int cur = t0 >> 6;
  unsigned* selm = (unsigned*)(smem + 36864);
  float* imp_main = (float*)(smem + 36992);
  float* imp_carry = (float*)(smem + 36992 + 4224);
  f32x4* Otl = (f32x4*)(smem + 36992) + tid;
  bf16x8 Qb[2][2];
  load_q(p, b, g, tw, Qb);
  int tq[2];
  float gate[2][3];
  const float* gates = (const float*)(p.ws + OFF_GATES);
#pragma unroll
  for (int ct = 0; ct < 2; ++ct) {
    tq[ct] = tw + ct * 4 + (c16 >> 2);
    const float* gp = gates + ((size_t)(b * 2048 + tq[ct])) * 48 + (g * 4 + (c16 & 3)) * 3;
    gate[ct][0] = gp[0]; gate[ct][1] = gp[1]; gate[ct][2] = gp[2];
  }
  __syncthreads();
  bf16_t* Kc = (bf16_t*)smem;
  bf16_t* VcT = (bf16_t*)(smem + 18432);
  {
    const bf16_t* kc = (const bf16_t*)(p.ws + OFF_KCMP) + (size_t)bg * 128 * 64;
    const bf16_t* vc = (const bf16_t*)(p.ws + OFF_VCMPT) + (size_t)bg * 64 * 128;
#pragma unroll
    for (int i = 0; i < 4; ++i) {
      int ch = tid + i * 256;
      int row = ch >> 3, cc = ch & 7;
      *(u32x4*)(Kc + row * 72 + cc * 8) = *(const u32x4*)(kc + row * 64 + cc * 8);
      int rv = ch >> 4, cv = ch & 15;
      *(u32x4*)(VcT + rv * 136 + cv * 8) = *(const u32x4*)(vc + rv * 128 + cv * 8);
    }
  }
  __syncthreads();
  f32x4 Ot[4][2];
#pragma unroll
  for (int ct = 0; ct < 2; ++ct) {
    f32x4 Sx[8];
#pragma unroll
    for (int kt = 0; kt < 8; ++kt) {
      Sx[kt] = f32x4{0.f, 0.f, 0.f, 0.f};
#pragma unroll
      for (int ks = 0; ks < 2; ++ks) {
        bf16x8 a = *(const bf16x8*)(Kc + (kt * 16 + c16) * 72 + ks * 32 + lg * 8);
        Sx[kt] = mfma16(a, Qb[ct][ks], Sx[kt]);
      }
    }
    {
      const int hi = ((tq[ct] - 31) >> 4) - lg * 4;
      float mx = NEG;
#pragma unroll
      for (int kt = 0; kt < 8; ++kt)
#pragma unroll
        for (int j = 0; j < 4; ++j) {
          float s = (kt * 16 + j <= hi) ? Sx[kt][j] : NEG;
          Sx[kt][j] = s;
          mx = fmaxf(mx, s);
        }
      mx = fmaxf(mx, __shfl_xor(mx, 16));
      mx = fmaxf(mx, __shfl_xor(mx, 32));
      const float msafe = mx < -1e29f ? 0.f : mx;
      float rs = 0.f;
#pragma unroll
      for (int kt = 0; kt < 8; ++kt)
#pragma unroll
        for (int j = 0; j < 4; ++j) {
          float pv = fexp2(Sx[kt][j] - msafe);
          Sx[kt][j] = pv;
          rs += pv;
        }
      rs += __shfl_xor(rs, 16);
      rs += __shfl_xor(rs, 32);
      const float inv = 1.f / fmaxf(rs, 1e-30f);
      const int qloc = w * 8 + ct * 4 + (c16 >> 2);
#pragma unroll
      for (int kt = 0; kt < 8; ++kt) {
#pragma unroll
        for (int j = 0; j < 4; ++j) Sx[kt][j] *= inv;
        float a = Sx[kt][0] + Sx[kt][1] + Sx[kt][2] + 0.5f * Sx[kt][3];
        float c = 0.5f * Sx[kt][3];
        a += __shfl_xor(a, 1);
        a += __shfl_xor(a, 2);
        c += __shfl_xor(c, 1);
        c += __shfl_xor(c, 2);
        if ((c16 & 3) == 0) {
          const int mi = kt * 4 + lg;
          imp_main[qloc * 33 + mi] = a;
          imp_carry[qloc * 34 + mi + 1] = c;
        }
      }
    }
    f32x4 O[4];
#pragma unroll
    for (int dt = 0; dt < 4; ++dt) O[dt] = f32x4{0.f, 0.f, 0.f, 0.f};
#pragma unroll
    for (int kp = 0; kp < 4; ++kp) {
      u32x4 u;
      u.x = pack_bf2(Sx[2 * kp][0], Sx[2 * kp][1]);
      u.y = pack_bf2(Sx[2 * kp][2], Sx[2 * kp][3]);
      u.z = pack_bf2(Sx[2 * kp + 1][0], Sx[2 * kp + 1][1]);
      u.w = pack_bf2(Sx[2 * kp + 1][2], Sx[2 * kp + 1][3]);
      bf16x8 Pb = __builtin_bit_cast(bf16x8, u);
#pragma unroll
      for (int dt = 0; dt < 4; ++dt) {
        u32x2 v0 = *(const u32x2*)(VcT + (dt * 16 + c16) * 136 + kp * 32 + lg * 4);
        u32x2 v1 = *(const u32x2*)(VcT + (dt * 16 + c16) * 136 + kp * 32 + 16 + lg * 4);
        u32x4 uu = u32x4{v0.x, v0.y, v1.x, v1.y};
        bf16x8 va = __builtin_bit_cast(bf16x8, uu);
        O[dt] = mfma16(va, Pb, O[dt]);
      }
    }
#pragma unroll
    for (int dt = 0; dt < 4; ++dt) Ot[dt][ct] = O[dt] * gate[ct][0];
  }
  __syncthreads();
  if (tid < 32) {
    unsigned mask = 1u | (1u << cur);
    if (cur >= 1) mask |= 1u << (cur - 1);
    const int need = 8 - __popc(mask);
    for (int it = 0; it < need; ++it) {
      float bv = -1.f;
      int best = -1;
      for (int j = 1; j <= cur - 2; ++j) {
        if (!((mask >> j) & 1u)) {
          float v = imp_main[tid * 33 + j] + imp_carry[tid * 34 + j];
          if (v > bv) { bv = v; best = j; }
        }
      }
      if (best < 0) break;
      mask |= 1u << best;
    }
    selm[tid] = mask;
  }
  __syncthreads();
  unsigned selbits[2];
#pragma unroll
  for (int ct = 0; ct < 2; ++ct) selbits[ct] = selm[w * 8 + ct * 4 + (c16 >> 2)];
#pragma unroll
  for (int dt = 0; dt < 4; ++dt)
#pragma unroll
    for (int ct = 0; ct < 2; ++ct) Otl[(dt * 2 + ct) * 256] = Ot[dt][ct];
  int buf = 0;
  {
    f32x4 O[4][2];
    float mrun[2] = {NEG, NEG}, lrun[2] = {0.f, 0.f};
#pragma unroll
    for (int dt = 0; dt < 4; ++dt) { O[dt][0] = f32x4{0.f, 0.f, 0.f, 0.f}; O[dt][1] = f32x4{0.f, 0.f, 0.f, 0.f}; }
    const bf16_t* Kg = (const bf16_t*)(p.ws + OFF_KS) + (size_t)b * 2048 * 256 + g * 64;
    const bf16_t* VTg = (const bf16_t*)(p.ws + OFF_VST) + (size_t)bg * 64 * 2048;
    attn_range<0, FIXED>(Kg, VTg, 0, cur, smem, buf, Qb, O, mrun, lrun, tq, selbits, 0);
#pragma unroll
    for (int ct = 0; ct < 2; ++ct) {
      float l = lrun[ct];
      l += __shfl_xor(l, 16);
      l += __shfl_xor(l, 32);
      const float sc = gate[ct][1] / fmaxf(l, 1e-30f);
#pragma unroll
      for (int dt = 0; dt < 4; ++dt) Otl[(dt * 2 + ct) * 256] = Otl[(dt * 2 + ct) * 256] + O[dt][ct] * sc;
    }
  }
  {
    f32x4 O[4][2];
    float mrun[2] = {NEG, NEG}, lrun[2] = {0.f, 0.f};
#pragma unroll
    for (int dt = 0; dt < 4; ++dt) { O[dt][0] = f32x4{0.f, 0.f, 0.f, 0.f}; O[dt][1] = f32x4{0.f, 0.f, 0.f, 0.f}; }
    const bf16_t* Kg = (const bf16_t*)(p.ws + OFF_KW) + (size_t)b * 2048 * 256 + g * 64;
    const bf16_t* VTg = (const bf16_t*)(p.ws + OFF_VWT) + (size_t)bg * 64 * 2048;
    int jlo = t0 - 255;
    jlo = jlo < 0 ? 0 : (jlo >> 6);
    attn_range<1, FIXED>(Kg, VTg, jlo, cur, smem, buf, Qb, O, mrun, lrun, tq, selbits, 0);
#pragma unroll
    for (int ct = 0; ct < 2; ++ct) {
      float l = lrun[ct];
      l += __shfl_xor(l, 16);
      l += __shfl_xor(l, 32);
      const float sc = gate[ct][2] / fmaxf(l, 1e-30f);
#pragma unroll
      for (int dt = 0; dt < 4; ++dt) Ot[dt][ct] = Otl[(dt * 2 + ct) * 256] + O[dt][ct] * sc;
    }
  }
  store_y(p, b, g, tw, Ot);
}

template <bool FIXED>
DI void moba_attn_item(const Params& p, int item, char* smem) {
  const int tid = tidx(), lane = tid & 63, w = tid >> 6, c16 = lane & 15, lg = lane >> 4;
  const int bg = item & 63, qb = 63 - (item >> 6);
  const int b = bg >> 2, g = bg & 3;
  const int t0 = qb * 32, tw = t0 + w * 8;
  const int own = t0 >> 8;
  bf16x8 Qb[2][2];
  load_q(p, b, g, tw, Qb);
  int tq[2];
#pragma unroll
  for (int ct = 0; ct < 2; ++ct) tq[ct] = tw + ct * 4 + (c16 >> 2);
  __syncthreads();
  bf16_t* Km = (bf16_t*)(smem + 36864);
  if (tid < 128) {
    int row = tid >> 3, cc = tid & 7;
    *(u32x4*)(Km + row * 72 + cc * 8) = *(const u32x4*)((const bf16_t*)(p.ws + OFF_KMEAN) + (size_t)bg * 16 * 64 + row * 64 + cc * 8);
  }
  __syncthreads();
  unsigned selbits[2];
#pragma unroll
  for (int ct = 0; ct < 2; ++ct) {
    f32x4 sg = f32x4{0.f, 0.f, 0.f, 0.f};
#pragma unroll
    for (int ks = 0; ks < 2; ++ks) {
      bf16x8 a = *(const bf16x8*)(Km + c16 * 72 + ks * 32 + lg * 8);
      sg = mfma16(a, Qb[ct][ks], sg);
    }
    f32x4 ot;
#pragma unroll
    for (int j = 0; j < 4; ++j) ot[j] = __shfl_xor(sg[j], 16);
    const bool odd = (lg & 1) != 0;
    float v0 = odd ? ot[0] : sg[0], v1 = odd ? ot[1] : sg[1], v2 = odd ? ot[2] : sg[2], v3 = odd ? ot[3] : sg[3];
    float v4 = odd ? sg[0] : ot[0], v5 = odd ? sg[1] : ot[1], v6 = odd ? sg[2] : ot[2], v7 = odd ? sg[3] : ot[3];
    unsigned sel = 0;
#pragma unroll
    for (int it = 0; it < 3; ++it) {
      float bv = -3.0e38f;
      int best = -1;
#define CAND(J, V) if ((J) < own && !((sel >> (J)) & 1u) && (V) > bv) { bv = (V); best = (J); }
      CAND(0, v0) CAND(1, v1) CAND(2, v2) CAND(3, v3) CAND(4, v4) CAND(5, v5) CAND(6, v6) CAND(7, v7)
#undef CAND
      if (best >= 0) sel |= 1u << best;
    }
    selbits[ct] = (unsigned)__shfl((int)sel, c16);
  }
  int buf = 0;
  f32x4 O[4][2];
  float mrun[2] = {NEG, NEG}, lrun[2] = {0.f, 0.f};
#pragma unroll
  for (int dt = 0; dt < 4; ++dt) { O[dt][0] = f32x4{0.f, 0.f, 0.f, 0.f}; O[dt][1] = f32x4{0.f, 0.f, 0.f, 0.f}; }
  const bf16_t* Kg = (const bf16_t*)(p.ws + OFF_KS) + (size_t)b * 2048 * 256 + g * 64;
  const bf16_t* VTg = (const bf16_t*)(p.ws + OFF_VST) + (size_t)bg * 64 * 2048;
  attn_range<2, FIXED>(Kg, VTg, 0, t0 >> 6, smem, buf, Qb, O, mrun, lrun, tq, selbits, own);
#pragma unroll
  for (int ct = 0; ct < 2; ++ct) {
    float l = lrun[ct];
    l += __shfl_xor(l, 16);
    l += __shfl_xor(l, 32);
    const float sc = 1.f / fmaxf(l, 1e-30f);
#pragma unroll
    for (int dt = 0; dt < 4; ++dt) O[dt][ct] *= sc;
  }
  store_y(p, b, g, tw, O);
}

#ifndef PROBE_DUP
#define PROBE_DUP -1
#endif
DI void run_phase1(const Params& pin, int layer, int ph, char* smem);
DI void run_phase(const Params& pin, int layer, int ph, char* smem) {
  run_phase1(pin, layer, ph, smem);
  if (ph == PROBE_DUP) { __syncthreads(); run_phase1(pin, layer, ph, smem); }
}
DI void run_phase1(const Params& pin, int layer, int ph, char* smem_all) {
  Params p = pin;
  {
    size_t z = 0;
    asm volatile("" : "+s"(z));
    p.ws = pin.ws + z;
    p.out = pin.out + z;
  }
  const int half = vhalf();
  char* smem = smem_all + half * SMEM_BYTES;
  const int G = 2 * gridDim.x, bid = 2 * blockIdx.x + half;
  const bool nsa = (layer & 1) == 0;
  const int lj = layer >> 1;
  const float* xin = layer == 0 ? p.x : p.out;
  if (ph == 0) {
    for (int it = bid; it < NW_TOTAL; it += G) phaseW_item(p, it, smem);
  } else if (ph == 1) {
    for (int it = bid; it < NTOK / 4; it += G) prep_item(p, layer, xin, it);
  } else if (ph == 2) {
    g8::StaticOrder S;
    S.init(NTOK, nsa ? NSA_NP : MOBA_IN, gridDim.x, blockIdx.x);
    InProjEpi E{p, layer};
    const bf16_t* Bt = nsa ? (const bf16_t*)(p.ws + OFF_WT_NSA_IN) + (size_t)lj * NSA_NP * 1024
                           : (const bf16_t*)(p.ws + OFF_WT_MOBA_IN) + (size_t)lj * MOBA_IN * 1024;
    g8::gemm_phase(( LAS unsigned char*)smem_all, (const bf16_t*)(p.ws + OFF_H), Bt, 1024, S, E);
    if (nsa) {
      __syncthreads();
      for (int it = bid; it < 256; it += G) gates_tile(p, lj, it, smem);
    }
  } else if (ph == 3) {
    if (nsa) { for (int it = bid; it < 256; it += G) cmp1_tile(p, lj, it, smem); }
    else { for (int it = bid; it < 512; it += G) kmean_item(p, it, smem); }
  } else if (ph == 4) {
    if (nsa) for (int it = bid; it < 256; it += G) cmp2_item(p, lj, it, smem);
  } else if (ph == 5) {
    float gq, gk;
    {
      const int l64 = tidx() & 63;
      if (nsa) {
        gq = fabsf(p.nsa_qn[lj * 64 + l64]);
        gk = fmaxf(fabsf(p.nsa_kn[(lj * 3 + 1) * 64 + l64]), fabsf(p.nsa_kn[(lj * 3 + 2) * 64 + l64]));
      } else {
        gq = fabsf(p.moba_qn[lj * 64 + l64]);
        gk = fabsf(p.moba_kn[lj * 64 + l64]);
      }
#pragma unroll
      for (int o = 32; o >= 1; o >>= 1) { gq = fmaxf(gq, __shfl_xor(gq, o)); gk = fmaxf(gk, __shfl_xor(gk, o)); }
    }
    const bool fixed_ok = (11.8f * gq * gk) <= 100.f;
    if (nsa) {
      if (fixed_ok) { for (int it = bid; it < 4096; it += G) nsa_attn_item<true>(p, it, smem); }
      else { for (int it = bid; it < 4096; it += G) nsa_attn_item<false>(p, it, smem); }
    } else {
      if (fixed_ok) { for (int it = bid; it < 4096; it += G) moba_attn_item<true>(p, it, smem); }
      else { for (int it = bid; it < 4096; it += G) moba_attn_item<false>(p, it, smem); }
    }
  } else if (ph == 6) {
    g8::StaticOrder S;
    S.init(NTOK, 1024, gridDim.x, blockIdx.x);
    OutProjEpi E{p, layer, xin};
    const bf16_t* Bt = (const bf16_t*)(p.ws + (nsa ? OFF_WT_NSA_OUT : OFF_WT_MOBA_OUT)) + (size_t)lj * 1024 * 1024;
    g8::gemm_phase((LAS unsigned char*)smem_all, (const bf16_t*)(p.ws + OFF_H), Bt, 1024, S, E);
  }
}

#if MULTI_LAUNCH
template <int PH>
__global__ void __launch_bounds__(512, 2) phase_kernel(Params p, int layer) {
  __shared__ __attribute__((aligned(16))) char smem[2 * SMEM_BYTES];
  run_phase(p, layer, PH, smem);
}
#else
__global__ void __launch_bounds__(512, 2) mega_kernel(Params p) {
  __shared__ __attribute__((aligned(16))) char smem[2 * SMEM_BYTES];
  __shared__ u32x4 xb_words;
  cg::grid_group grid = cg::this_grid();
  if (__builtin_amdgcn_workitem_id_x() == 0) xb_words = u32x4{0u, 0u, 0u, 0u};
  __syncthreads();
  XcdBarrier xb = xcd_barrier_post((unsigned*)(p.ws + OFF_BAR), (volatile LAS unsigned*)&xb_words);
  run_phase(p, 0, 0, smem);
  grid.sync();
  for (int layer = 0; layer < 4; ++layer) {
    const bool nsa = (layer & 1) == 0;
    run_phase(p, layer, 1, smem);
    xcd_barrier(xb);
    run_phase(p, layer, 2, smem);
    xcd_barrier(xb);
    run_phase(p, layer, 3, smem);
    xcd_barrier(xb);
    if (nsa) {
      run_phase(p, layer, 4, smem);
      xcd_barrier(xb);
    }
    run_phase(p, layer, 5, smem);
    xcd_barrier(xb);
    run_phase(p, layer, 6, smem);
    if (layer < 3) xcd_barrier(xb);
  }
}
#endif

extern "C" void kernel_launch(void* const* d_in, const int* in_sizes, int n_in, void* d_out, int out_size, void* d_ws, size_t ws_size,
                              hipStream_t stream) {
  Params p{};
  p.x = (const float*)d_in[0];
  p.c = (const float*)d_in[1];
  p.pos = (const int*)d_in[2];
  p.norm_g = (const float*)d_in[3];
  p.ada_w = (const float*)d_in[4];
  p.ada_b = (const float*)d_in[5];
  p.nsa_w_in = (const float*)d_in[6];
  p.nsa_w_out = (const float*)d_in[7];
  p.nsa_qn = (const float*)d_in[8];
  p.nsa_kn = (const float*)d_in[9];
  p.cmp_pe = (const float*)d_in[10];
  p.cmp_w1 = (const float*)d_in[11];
  p.cmp_b1 = (const float*)d_in[12];
  p.cmp_w2 = (const float*)d_in[13];
  p.gate_b = (const float*)d_in[14];
  p.moba_w_in = (const float*)d_in[15];
  p.moba_w_out = (const float*)d_in[16];
  p.moba_qn = (const float*)d_in[17];
  p.moba_kn = (const float*)d_in[18];
  p.out = (float*)d_out;
  p.ws = (char*)d_ws;
  if (ws_size < WS_TOTAL) { fprintf(stderr, "workspace too small: %zu < %zu\n", ws_size, (size_t)WS_TOTAL); return; }
#if MULTI_LAUNCH
  const int G = 256;
  phase_kernel<0><<<G, 512, 0, stream>>>(p, 0);
  for (int layer = 0; layer < 4; ++layer) {
    phase_kernel<1><<<G, 512, 0, stream>>>(p, layer);
    phase_kernel<2><<<G, 512, 0, stream>>>(p, layer);
    phase_kernel<3><<<G, 512, 0, stream>>>(p, layer);
    if (!(layer & 1)) phase_kernel<4><<<G, 512, 0, stream>>>(p, layer);
    phase_kernel<5><<<G, 512, 0, stream>>>(p, layer);
    phase_kernel<6><<<G, 512, 0, stream>>>(p, layer);
  }
#else
  static int grid_blocks = 0;
  if (!grid_blocks) {
    int dev = 0, cus = 0, per_cu = 0;
    (void)hipGetDevice(&dev);
    (void)hipDeviceGetAttribute(&cus, hipDeviceAttributeMultiprocessorCount, dev);
    (void)hipOccupancyMaxActiveBlocksPerMultiprocessor(&per_cu, mega_kernel, 512, 0);
    if (per_cu > 1) per_cu = 1;
    grid_blocks = cus * per_cu;
  }
  (void)hipMemsetAsync((char*)d_ws + OFF_BAR, 0, BAR_BYTES, stream);
  void* args[] = {&p};
  hipError_t e = hipLaunchCooperativeKernel((void*)mega_kernel, dim3(grid_blocks), dim3(512), args, 0, stream);
  if (e != hipSuccess) fprintf(stderr, "cooperative launch failed: %s (grid %d)\n", hipGetErrorString(e), grid_blocks);
#endif
}
```

```cpp
#include <hip/hip_runtime.h>
#include <hip/hip_cooperative_groups.h>
#include <cstdio>
namespace cg = cooperative_groups;

#ifndef MULTI_LAUNCH
#define MULTI_LAUNCH 0
#endif

#define DI __device__ __forceinline__
typedef unsigned short bf16_t;
using bf16x8 = __attribute__((ext_vector_type(8))) short;
using f32x4 = __attribute__((ext_vector_type(4))) float;
typedef __bf16 bf16x2_t __attribute__((ext_vector_type(2)));
typedef float f32x2_t __attribute__((ext_vector_type(2)));
using u32x4 = __attribute__((ext_vector_type(4))) unsigned;
using u32x2 = __attribute__((ext_vector_type(2))) unsigned;

constexpr int DM = 1024, NB = 16, SEQ = 2048, NTOK = NB * SEQ;
constexpr int NSA_IN = 3632, NSA_NP = 3584, MOBA_IN = 2560;
constexpr float EPS = 1e-6f;
constexpr float QSCALE = 0.125f * 1.4426950408889634f;
constexpr float NEG = -1e30f;

constexpr size_t SZ_WT_NSA_IN = (size_t)2 * NSA_NP * 1024 * 2;
constexpr size_t SZ_WT_SQ = (size_t)2 * 1024 * 1024 * 2;
constexpr size_t SZ_WT_MOBA_IN = (size_t)2 * MOBA_IN * 1024 * 2;
constexpr size_t SZ_WT_CMP1 = (size_t)4 * 256 * 2048 * 2;
constexpr size_t SZ_ACT = (size_t)NTOK * 1024 * 2;
constexpr size_t SZ_KV = (size_t)NTOK * 256 * 2;
constexpr size_t OFF_WT_NSA_IN = 0;
constexpr size_t OFF_WT_NSA_OUT = OFF_WT_NSA_IN + SZ_WT_NSA_IN;
constexpr size_t OFF_WT_MOBA_IN = OFF_WT_NSA_OUT + SZ_WT_SQ;
constexpr size_t OFF_WT_MOBA_OUT = OFF_WT_MOBA_IN + SZ_WT_MOBA_IN;
constexpr size_t OFF_WT_CMP1 = OFF_WT_MOBA_OUT + SZ_WT_SQ;
constexpr size_t OFF_B1EFF = OFF_WT_CMP1 + SZ_WT_CMP1;
constexpr size_t OFF_ROPE = OFF_B1EFF + 4096;
constexpr size_t OFF_MOD = OFF_ROPE + (size_t)NTOK * 16 * 4;
constexpr size_t OFF_H = OFF_MOD + (size_t)4 * 16 * 3072 * 4;
constexpr size_t OFF_Q = OFF_H + SZ_ACT;
constexpr size_t OFF_SZ = OFF_Q + SZ_ACT;
constexpr size_t OFF_KC = OFF_SZ + SZ_ACT;
constexpr size_t OFF_VC = OFF_KC + SZ_KV;
constexpr size_t OFF_KS = OFF_VC + SZ_KV;
constexpr size_t OFF_KW = OFF_KS + SZ_KV;
constexpr size_t OFF_VST = OFF_KW + SZ_KV;
constexpr size_t OFF_VWT = OFF_VST + SZ_KV;
constexpr size_t OFF_GATES = OFF_VWT + SZ_KV;
constexpr size_t OFF_HID = OFF_GATES + (size_t)NTOK * 48 * 4;
constexpr size_t OFF_KCMP = OFF_HID + (size_t)2 * 8192 * 256 * 2;
constexpr size_t OFF_VCMPT = OFF_KCMP + (size_t)64 * 128 * 64 * 2;
constexpr size_t OFF_KMEAN = OFF_VCMPT + (size_t)64 * 128 * 64 * 2;
constexpr size_t OFF_WT_GL = OFF_KMEAN + (size_t)64 * 16 * 64 * 2;
constexpr size_t OFF_BAR = OFF_WT_GL + (size_t)2 * 128 * 1024 * 2;
constexpr size_t BAR_BYTES = 3456 * 4;
constexpr size_t WS_TOTAL = OFF_BAR + 16384;

struct Params {
  const float *x, *c;
  const int* pos;
  const float *norm_g, *ada_w, *ada_b, *nsa_w_in, *nsa_w_out, *nsa_qn, *nsa_kn, *cmp_pe, *cmp_w1, *cmp_b1, *cmp_w2, *gate_b,
      *moba_w_in, *moba_w_out, *moba_qn, *moba_kn;
  float* out;
  char* ws;
};

constexpr int SMEM_BYTES = 73728;

DI int tidx() {
  int t = __builtin_amdgcn_workitem_id_x() & 255;
  asm volatile("" : "+v"(t));
  return t;
}
DI void lds_barrier() {
  asm volatile("s_waitcnt lgkmcnt(0)" ::: "memory");
  __builtin_amdgcn_s_barrier();
  asm volatile("" ::: "memory");
}
DI float qxor1(float x) { return __builtin_bit_cast(float, __builtin_amdgcn_mov_dpp(__builtin_bit_cast(int, x), 0xB1, 0xF, 0xF, true)); }
DI float qxor2(float x) { return __builtin_bit_cast(float, __builtin_amdgcn_mov_dpp(__builtin_bit_cast(int, x), 0x4E, 0xF, 0xF, true)); }
DI int vhalf() { return __builtin_amdgcn_readfirstlane(__builtin_amdgcn_workitem_id_x() >> 8); }
DI unsigned pack_bf2(float a, float b) {
  f32x2_t v = {a, b};
  bf16x2_t r = __builtin_convertvector(v, bf16x2_t);
  return __builtin_bit_cast(unsigned, r);
}
DI float bf2f(bf16_t v) { return __uint_as_float(((unsigned)v) << 16); }
DI float bflo(unsigned u) { return __uint_as_float(u << 16); }
DI float bfhi(unsigned u) { return __uint_as_float(u & 0xffff0000u); }
DI f32x4 mfma16(bf16x8 a, bf16x8 b, f32x4 c) { return __builtin_amdgcn_mfma_f32_16x16x32_bf16(a, b, c, 0, 0, 0); }
DI float fexp2(float x) { return __builtin_amdgcn_exp2f(x); }
DI float sigmoidf_(float x) { return __builtin_amdgcn_rcpf(1.f + __builtin_amdgcn_exp2f(-1.4426950408889634f * x)); }
DI float siluf_(float x) { return x * __builtin_amdgcn_rcpf(1.f + __builtin_amdgcn_exp2f(-1.4426950408889634f * x)); }
DI float geluf_(float x) {
  float u = 0.7978845608028654f * (x + 0.044715f * x * x * x);
  float t = 1.f - 2.f / (__expf(2.f * u) + 1.f);
  return 0.5f * x * (1.f + t);
}


#define XB_TMO      128
#define XB_XCNT(j)  (256  + 64 * (j))
#define XB_XSUB(j)  (1280 + 64 * (j))
#define XB_XGEN(j)  (2304 + 64 * (j))
#define XB_TOP      3328
#define XB_TOPGEN   3392
#define XB_SPIN_CAP (1u << 22)
#define LAS __attribute__((address_space(3)))
DI unsigned xb_ld(unsigned* p) { return __hip_atomic_load(p, __ATOMIC_RELAXED, __HIP_MEMORY_SCOPE_AGENT); }
DI unsigned xb_add(unsigned* p, unsigned v) { return __hip_atomic_fetch_add(p, v, __ATOMIC_RELAXED, __HIP_MEMORY_SCOPE_AGENT); }
DI unsigned xb_xcc_id() { return (unsigned)__builtin_amdgcn_s_getreg((3 << 11) | 20) & 0xFu; }
#define XB_SPIN(cond, bar) do { unsigned _sp = 0; while (cond) { __builtin_amdgcn_s_sleep(1); \
    if ((++_sp & 255u) == 0u) { if (xb_ld(&(bar)[XB_TMO])) break; if (_sp > XB_SPIN_CAP) { atomicAdd(&(bar)[XB_TMO], 1u); break; } } } } while (0)
struct XcdBarrier { unsigned* bar; unsigned x; volatile LAS unsigned* st; };
DI XcdBarrier xcd_barrier_post(unsigned* bar, volatile LAS unsigned* st) {
  XcdBarrier b; b.bar = bar; b.x = xb_xcc_id(); b.st = st;
  if (__builtin_amdgcn_workitem_id_x() == 0) (void)xb_add(&bar[XB_XCNT(b.x)], 1u);
  return b;
}
DI void xcd_barrier_complete(unsigned* bar, unsigned x, unsigned& nloc, unsigned& nx) {
  const unsigned G = gridDim.x * gridDim.y * gridDim.z;
  unsigned sum, cnt, mine, sp = 0u;
  for (;;) {
    sum = 0u; cnt = 0u; mine = 0u;
#pragma unroll
    for (unsigned j = 0; j < 16; ++j) { const unsigned c = xb_ld(&bar[XB_XCNT(j)]); sum += c; cnt += (c > 0u) ? 1u : 0u; mine = (j == x) ? c : mine; }
    if (sum == G) break;
    __builtin_amdgcn_s_sleep(1);
    if ((++sp & 255u) == 0u) { if (xb_ld(&bar[XB_TMO])) break; if (sp > XB_SPIN_CAP) { atomicAdd(&bar[XB_TMO], 1u); break; } }
  }
  nloc = mine > 0u ? mine : 1u; nx = cnt > 0u ? cnt : 1u;
}
DI void xcd_barrier(const XcdBarrier& b) {
  asm volatile("s_waitcnt vmcnt(0)" ::: "memory");
  __syncthreads();
  if (__builtin_amdgcn_workitem_id_x() == 0) {
    unsigned* bar = b.bar;
    __builtin_amdgcn_s_waitcnt(0);
    unsigned nloc = b.st[0], nx = b.st[1];
    if (nloc == 0u) { xcd_barrier_complete(bar, b.x, nloc, nx); b.st[0] = nloc; b.st[1] = nx; }
    const unsigned old = xb_add(&bar[XB_XSUB(b.x)], 1u);
    const unsigned gen = old / nloc;
    if (old + 1u == (gen + 1u) * nloc) {
      __builtin_amdgcn_fence(__ATOMIC_RELEASE, "agent");
      asm volatile("s_waitcnt vmcnt(0)" ::: "memory");
      const unsigned og = xb_add(&bar[XB_TOP], 1u);
      const unsigned tg = og / nx;
      if (og + 1u == (tg + 1u) * nx) xb_add(&bar[XB_TOPGEN], 1u);
      else XB_SPIN(xb_ld(&bar[XB_TOPGEN]) == tg, bar);
      __builtin_amdgcn_fence(__ATOMIC_ACQUIRE, "agent");
      xb_add(&bar[XB_XGEN(b.x)], 1u);
      asm volatile("s_waitcnt vmcnt(0)" ::: "memory");
    } else {
      XB_SPIN(xb_ld(&bar[XB_XGEN(b.x)]) == gen, bar);
      __builtin_amdgcn_fence(__ATOMIC_ACQUIRE, "agent");
      asm volatile("s_waitcnt vmcnt(0)" ::: "memory");
    }
  }
  __syncthreads();
}

DI void ada_item(const Params& p, int item, char* smem) {
  const int tid = tidx();
  const int l = item / 192, n0 = (item % 192) * 16;
  float* cond = (float*)smem;
  __syncthreads();
  for (int i = tid; i < 16 * 1024; i += 256) {
    int b = i >> 10, k = i & 1023;
    float v = p.c[i];
    cond[k * 16 + b] = siluf_(v);
  }
  __syncthreads();
  const int kq = tid >> 4, col = tid & 15;
  float acc[16];
#pragma unroll
  for (int b = 0; b < 16; ++b) acc[b] = 0.f;
  const float* w = p.ada_w + (size_t)l * 1024 * 3072 + n0 + col;
#pragma unroll 16
  for (int k = kq * 64; k < kq * 64 + 64; ++k) {
    float wv = __builtin_nontemporal_load(w + (size_t)k * 3072);
    const float4* cp = (const float4*)(cond + k * 16);
    float4 c0 = cp[0], c1 = cp[1], c2 = cp[2], c3 = cp[3];
    acc[0] += wv * c0.x; acc[1] += wv * c0.y; acc[2] += wv * c0.z; acc[3] += wv * c0.w;
    acc[4] += wv * c1.x; acc[5] += wv * c1.y; acc[6] += wv * c1.z; acc[7] += wv * c1.w;
    acc[8] += wv * c2.x; acc[9] += wv * c2.y; acc[10] += wv * c2.z; acc[11] += wv * c2.w;
    acc[12] += wv * c3.x; acc[13] += wv * c3.y; acc[14] += wv * c3.z; acc[15] += wv * c3.w;
  }
  __syncthreads();
  float* red = (float*)smem;
#pragma unroll
  for (int b = 0; b < 16; ++b) red[(kq * 16 + b) * 16 + col] = acc[b];
  __syncthreads();
  float* mod = (float*)(p.ws + OFF_MOD);
  {
    const int b = tid >> 4, cc = tid & 15;
    float s = 0.f;
#pragma unroll
    for (int q = 0; q < 16; ++q) s += red[(q * 16 + b) * 16 + cc];
    mod[(size_t)(l * 16 + b) * 3072 + n0 + cc] = s + p.ada_b[l * 3072 + n0 + cc];
  }
}

DI void b1eff_item(const Params& p, int item, char* smem) {
  const int tid = tidx();
  const int li = item >> 4, h0 = (item & 15) * 16;
  const int kg = tid >> 4, hh = tid & 15;
  const float* W1 = p.cmp_w1 + (size_t)li * 2048 * 256;
  const float* pe = p.cmp_pe + li * 2048;
  float acc = 0.f;
#pragma unroll 16
  for (int k = kg * 128; k < kg * 128 + 128; ++k) acc += pe[k] * __builtin_nontemporal_load(W1 + (size_t)k * 256 + h0 + hh);
  float* red = (float*)smem;
  __syncthreads();
  red[kg * 16 + hh] = acc;
  __syncthreads();
  if (tid < 16) {
    float s = 0.f;
    for (int g = 0; g < 16; ++g) s += red[g * 16 + tid];
    ((float*)(p.ws + OFF_B1EFF))[li * 256 + h0 + tid] = s + p.cmp_b1[li * 256 + h0 + tid];
  }
}

DI void rope_item(const Params& p, int item) {
  const int idx = item * 256 + tidx();
  const int tok = idx >> 3, i = idx & 7;
  const float invf[8] = {1.0f, 0.1939227432012558f, 0.03760603070259094f, 0.007292664609849453f,
                         0.0014142135623842478f, 0.00027424818836152554f, 5.318296098266728e-05f, 1.0313386155758053e-05f};
  float f = i == 0 ? invf[0] : i == 1 ? invf[1] : i == 2 ? invf[2] : i == 3 ? invf[3] : i == 4 ? invf[4] : i == 5 ? invf[5] : i == 6 ? invf[6] : invf[7];
  float ang = (float)p.pos[tok] * f;
  double rev = (double)ang * 0.15915494309189535;
  double fr = rev - floor(rev);
  float frf = (float)fr;
  float* rope = (float*)(p.ws + OFF_ROPE);
  rope[(size_t)tok * 16 + i] = __builtin_amdgcn_cosf(frf);
  rope[(size_t)tok * 16 + 8 + i] = __builtin_amdgcn_sinf(frf);
}

DI void transpose_item(const float* __restrict__ src, int K, int Nsrc, bf16_t* __restrict__ dst, int k0, int n0, int mapmode, char* smem) {
  float* tile = (float*)smem;
  const int tid = tidx();
  __syncthreads();
  float tv[16];
#pragma unroll
  for (int i = 0; i < 16; ++i) {
    int kk = i * 4 + (tid >> 6), nn = tid & 63;
    int nd = n0 + nn, ns = nd;
    if (mapmode == 1 || mapmode == 2) {
      const int rho = nd & 255;
      ns = (nd & ~255) + 64 * ((rho >> 5) & 3) + 32 * (rho >> 7) + (rho & 31);
    }
    if (mapmode == 1) ns = ns < 2560 ? ns : ns + 48;
    if (mapmode == 3) ns = nd < 48 ? 2560 + nd : -1;
    tv[i] = ns >= 0 ? __builtin_nontemporal_load(src + (size_t)(k0 + kk) * Nsrc + ns) : 0.f;
  }
#pragma unroll
  for (int i = 0; i < 16; ++i) {
    int kk = i * 4 + (tid >> 6), nn = tid & 63;
    tile[kk * 65 + nn] = tv[i];
  }
  __syncthreads();
#pragma unroll
  for (int i = 0; i < 16; ++i) {
    int nn = i * 4 + (tid >> 6), kk = tid & 63;
    float v = tile[kk * 65 + nn];
    unsigned u = pack_bf2(v, 0.f);
    dst[(size_t)(n0 + nn) * K + k0 + kk] = (bf16_t)(u & 0xffff);
  }
}

constexpr int NW_ADA = 768, NW_B1 = 64, NW_ROPE = 1024;
constexpr int NW_T_NSA_IN = 16 * 56, NW_T_SQ = 256, NW_T_MOBA_IN = 16 * 40, NW_T_CMP = 128, NW_T_GL = 16 * 2;
constexpr int NW_TRANS = 2 * NW_T_NSA_IN + 2 * NW_T_SQ + 2 * NW_T_MOBA_IN + 2 * NW_T_SQ + 4 * NW_T_CMP + 2 * NW_T_GL;
constexpr int NW_TOTAL = NW_ADA + NW_B1 + NW_ROPE + NW_TRANS;

DI void phaseW_item(const Params& p, int it, char* smem) {
  if (it < NW_ADA) { ada_item(p, it, smem); return; }
  it -= NW_ADA;
  if (it < NW_B1) { b1eff_item(p, it, smem); return; }
  it -= NW_B1;
  if (it < NW_ROPE) { rope_item(p, it); return; }
  it -= NW_ROPE;
  if (it < 2 * NW_T_NSA_IN) {
    int l = it / NW_T_NSA_IN, t = it % NW_T_NSA_IN;
    transpose_item(p.nsa_w_in + (size_t)l * 1024 * NSA_IN, 1024, NSA_IN, (bf16_t*)(p.ws + OFF_WT_NSA_IN) + (size_t)l * NSA_NP * 1024,
                   (t % 16) * 64, (t / 16) * 64, 1, smem);
    return;
  }
  it -= 2 * NW_T_NSA_IN;
  if (it < 2 * NW_T_SQ) {
    int l = it / NW_T_SQ, t = it % NW_T_SQ;
    transpose_item(p.nsa_w_out + (size_t)l * 1024 * 1024, 1024, 1024, (bf16_t*)(p.ws + OFF_WT_NSA_OUT) + (size_t)l * 1024 * 1024,
                   (t % 16) * 64, (t / 16) * 64, 2, smem);
    return;
  }
  it -= 2 * NW_T_SQ;
  if (it < 2 * NW_T_MOBA_IN) {
    int l = it / NW_T_MOBA_IN, t = it % NW_T_MOBA_IN;
    transpose_item(p.moba_w_in + (size_t)l * 1024 * MOBA_IN, 1024, MOBA_IN, (bf16_t*)(p.ws + OFF_WT_MOBA_IN) + (size_t)l * MOBA_IN * 1024,
                   (t % 16) * 64, (t / 16) * 64, 2, smem);
    return;
  }
  it -= 2 * NW_T_MOBA_IN;
  if (it < 2 * NW_T_SQ) {
    int l = it / NW_T_SQ, t = it % NW_T_SQ;
    transpose_item(p.moba_w_out + (size_t)l * 1024 * 1024, 1024, 1024, (bf16_t*)(p.ws + OFF_WT_MOBA_OUT) + (size_t)l * 1024 * 1024,
                   (t % 16) * 64, (t / 16) * 64, 2, smem);
    return;
  }
  it -= 2 * NW_T_SQ;
  if (it < 4 * NW_T_CMP) {
    int li = it / NW_T_CMP, t = it % NW_T_CMP;
    transpose_item(p.cmp_w1 + (size_t)li * 2048 * 256, 2048, 256, (bf16_t*)(p.ws + OFF_WT_CMP1) + (size_t)li * 256 * 2048,
                   (t % 32) * 64, (t / 32) * 64, 0, smem);
    return;
  }
  it -= 4 * NW_T_CMP;
  {
    int l = it / NW_T_GL, t = it % NW_T_GL;
    transpose_item(p.nsa_w_in + (size_t)l * 1024 * NSA_IN, 1024, NSA_IN, (bf16_t*)(p.ws + OFF_WT_GL) + (size_t)l * 128 * 1024,
                   (t % 16) * 64, (t / 16) * 64, 3, smem);
  }
}

DI void prep_item(const Params& p, int layer, const float* __restrict__ xin, int item) {
  const int lane = tidx() & 63, w = tidx() >> 6;
  const int tok0 = item * 16 + w * 4;
  const int b = tok0 >> 11;
  f32x4 v[4][4];
#pragma unroll
  for (int r = 0; r < 4; ++r)
#pragma unroll
    for (int i = 0; i < 4; ++i) v[r][i] = __builtin_nontemporal_load((const f32x4*)(xin + (size_t)(tok0 + r) * 1024 + (lane + i * 64) * 4));
  const float* mod = (const float*)(p.ws + OFF_MOD) + (size_t)(layer * 16 + b) * 3072;
  f32x4 gs[4], sh[4];
#pragma unroll
  for (int i = 0; i < 4; ++i) {
    const int c = (lane + i * 64) * 4;
    const f32x4 g = *(const f32x4*)(p.norm_g + layer * 1024 + c);
    const f32x4 sc = *(const f32x4*)(mod + 1024 + c);
    sh[i] = *(const f32x4*)(mod + c);
    gs[i] = g * (sc + 1.f);
  }
#pragma unroll
  for (int r = 0; r < 4; ++r) {
    float ss = 0.f;
#pragma unroll
    for (int i = 0; i < 4; ++i) ss += v[r][i][0] * v[r][i][0] + v[r][i][1] * v[r][i][1] + v[r][i][2] * v[r][i][2] + v[r][i][3] * v[r][i][3];
#pragma unroll
    for (int o = 32; o >= 1; o >>= 1) ss += __shfl_xor(ss, o);
    const float rstd = __builtin_amdgcn_rsqf(ss * (1.f / 1024.f) + EPS);
    bf16_t* hr = (bf16_t*)(p.ws + OFF_H) + (size_t)(tok0 + r) * 1024;
#pragma unroll
    for (int i = 0; i < 4; ++i) {
      const f32x4 a = v[r][i] * rstd * gs[i] + sh[i];
      u32x2 o;
      o.x = pack_bf2(a[0], a[1]);
      o.y = pack_bf2(a[2], a[3]);
      *(u32x2*)(hr + (lane + i * 64) * 4) = o;
    }
  }
}

template <bool SWAP>
DI void gemm_mainloop(const bf16_t* __restrict__ A, const unsigned (&aoff)[4], int a_kstride, const bf16_t* __restrict__ Bt, int K, int n0,
                      char* smem, f32x4 (&acc)[4][4], int ldb = 0) {
  if (ldb == 0) ldb = K;
  bf16_t* sA = (bf16_t*)smem;
  bf16_t* sB = (bf16_t*)(smem + 36864);
  const int tid = tidx(), lane = tid & 63, w = tid >> 6;
  const int wm = w >> 1, wn = w & 1, c16 = lane & 15, lg = lane >> 4;
  const int r0 = tid >> 3, c8 = tid & 7;
  const int nk = K >> 6;
  u32x4 ra[4], rb[4];
  const bf16_t* bbase = Bt + (size_t)(n0 + r0) * ldb + c8 * 8;
#pragma unroll
  for (int i = 0; i < 4; ++i) {
    ra[i] = *(const u32x4*)(A + aoff[i] + c8 * 8);
    rb[i] = *(const u32x4*)(bbase + (size_t)i * 32 * ldb);
  }
#pragma unroll
  for (int a = 0; a < 4; ++a)
#pragma unroll
    for (int b = 0; b < 4; ++b) acc[a][b] = f32x4{0.f, 0.f, 0.f, 0.f};
  __syncthreads();
  for (int kt = 0; kt < nk; ++kt) {
    const int buf = kt & 1;
    bf16_t* cA = sA + buf * (128 * 72);
    bf16_t* cB = sB + buf * (128 * 72);
#pragma unroll
    for (int i = 0; i < 4; ++i) {
      *(u32x4*)(cA + (r0 + 32 * i) * 72 + c8 * 8) = ra[i];
      *(u32x4*)(cB + (r0 + 32 * i) * 72 + c8 * 8) = rb[i];
    }
    lds_barrier();
    if (kt + 1 < nk) {
#pragma unroll
      for (int i = 0; i < 4; ++i) {
        ra[i] = *(const u32x4*)(A + aoff[i] + (size_t)(kt + 1) * a_kstride + c8 * 8);
        rb[i] = *(const u32x4*)(bbase + (size_t)i * 32 * ldb + (kt + 1) * 64);
      }
    }
#pragma unroll
    for (int ks = 0; ks < 2; ++ks) {
      bf16x8 af[4], bfr[4];
#pragma unroll
      for (int mt = 0; mt < 4; ++mt) af[mt] = *(const bf16x8*)(cA + (wm * 64 + mt * 16 + c16) * 72 + ks * 32 + lg * 8);
#pragma unroll
      for (int nt = 0; nt < 4; ++nt) bfr[nt] = *(const bf16x8*)(cB + (wn * 64 + nt * 16 + c16) * 72 + ks * 32 + lg * 8);
#pragma unroll
      for (int mt = 0; mt < 4; ++mt)
#pragma unroll
        for (int nt = 0; nt < 4; ++nt) {
          if (SWAP) acc[nt][mt] = mfma16(bfr[nt], af[mt], acc[nt][mt]);
          else acc[mt][nt] = mfma16(af[mt], bfr[nt], acc[mt][nt]);
        }
    }
  }
}

DI void epi_normrope(f32x4 (&acc)[4][4], int m_base  , int ncol_base  ,
                     bf16_t* __restrict__ dst, int ld, const float* __restrict__ gw, const float* __restrict__ rope, float oscale) {
  const int lane = tidx() & 63, c16 = lane & 15, lg = lane >> 4;
  float gwv[4][4];
#pragma unroll
  for (int nt = 0; nt < 4; ++nt)
#pragma unroll
    for (int j = 0; j < 4; ++j) gwv[nt][j] = gw[nt * 16 + lg * 4 + j];
#pragma unroll
  for (int mt = 0; mt < 4; ++mt) {
    const int m = m_base + mt * 16 + c16;
    float ss = 0.f;
#pragma unroll
    for (int nt = 0; nt < 4; ++nt)
#pragma unroll
      for (int j = 0; j < 4; ++j) ss += acc[nt][mt][j] * acc[nt][mt][j];
    ss += __shfl_xor(ss, 16);
    ss += __shfl_xor(ss, 32);
    const float rstd = __builtin_amdgcn_rsqf(ss * (1.f / 64.f) + EPS);
    float v[4][4];
#pragma unroll
    for (int nt = 0; nt < 4; ++nt)
#pragma unroll
      for (int j = 0; j < 4; ++j) v[nt][j] = acc[nt][mt][j] * rstd * gwv[nt][j];
    const float4 cs = *(const float4*)(rope + (size_t)m * 16 + (lg & 1) * 4);
    const float4 sn = *(const float4*)(rope + (size_t)m * 16 + 8 + (lg & 1) * 4);
    const float csv[4] = {cs.x, cs.y, cs.z, cs.w};
    const float snv[4] = {sn.x, sn.y, sn.z, sn.w};
#pragma unroll
    for (int j = 0; j < 4; ++j) {
      float mine = v[0][j];
      float other = __shfl_xor(mine, 32);
      float r = (lg < 2) ? (mine * csv[j] - other * snv[j]) : (mine * csv[j] + other * snv[j]);
      v[0][j] = r;
    }
#pragma unroll
    for (int nt = 0; nt < 4; ++nt) {
      u32x2 o;
      o.x = pack_bf2(v[nt][0] * oscale, v[nt][1] * oscale);
      o.y = pack_bf2(v[nt][2] * oscale, v[nt][3] * oscale);
      *(u32x2*)(dst + (size_t)m * ld + ncol_base + nt * 16 + lg * 4) = o;
    }
  }
}

template <int MODE>
DI void epi_store_bf16(f32x4 (&acc)[4][4], int m_base, int ncol_base, bf16_t* __restrict__ dst, int ld, const float* __restrict__ bias) {
  const int lane = tidx() & 63, c16 = lane & 15, lg = lane >> 4;
#pragma unroll
  for (int mt = 0; mt < 4; ++mt) {
    const int m = m_base + mt * 16 + c16;
#pragma unroll
    for (int nt = 0; nt < 4; ++nt) {
      float v[4];
#pragma unroll
      for (int j = 0; j < 4; ++j) {
        float a = acc[nt][mt][j];
        if (MODE == 1) a = siluf_(a);
        if (MODE == 2) a = geluf_(a + bias[ncol_base + nt * 16 + lg * 4 + j]);
        v[j] = a;
      }
      u32x2 o;
      o.x = pack_bf2(v[0], v[1]);
      o.y = pack_bf2(v[2], v[3]);
      *(u32x2*)(dst + (size_t)m * ld + ncol_base + nt * 16 + lg * 4) = o;
    }
  }
}

DI void epi_store_vt(f32x4 (&acc)[4][4], int m_base, int col_base, bf16_t* __restrict__ vt) {
  const int lane = tidx() & 63, c16 = lane & 15, lg = lane >> 4;
#pragma unroll
  for (int mt = 0; mt < 4; ++mt) {
    const int m = m_base + mt * 16 + lg * 4;
    const int b = m >> 11, s = m & 2047;
#pragma unroll
    for (int nt = 0; nt < 4; ++nt) {
      const int col = col_base + nt * 16 + c16;
      const int gh = col >> 6, d = col & 63;
      u32x2 o;
      o.x = pack_bf2(acc[mt][nt][0], acc[mt][nt][1]);
      o.y = pack_bf2(acc[mt][nt][2], acc[mt][nt][3]);
      *(u32x2*)(vt + ((size_t)((b * 4 + gh) * 64 + d)) * 2048 + s) = o;
    }
  }
}

#ifndef PROBE_T
#define PROBE_T -1
#endif
namespace g8 {
constexpr int BM = 256, BK = 64, HALF = 128, HTB = HALF * BK * 2, NXCD = 8, WGM = 8;
DI int lds_byte(int r, int c) { const int st = (r >> 4) * 2 + (c >> 5), rr = r & 15, cc = c & 31, ob = rr * 64 + cc * 2; return st * 1024 + (ob ^ (((ob >> 9) & 1) << 5)); }
DI void stage_rc(int b, int& R, int& C) { const int st = b / 1024, sb = b % 1024, swz = sb ^ (((sb >> 9) & 1) << 5); R = (st >> 1) * 16 + swz / 64; C = (st & 1) * 32 + (swz % 64) / 2; }
struct Unit { int pm, pn; };
struct StaticOrder {
  int nM, nN, nwg, G, c;
  DI void init(int M, int N, int G_, int c_) { nM = M / BM; nN = N / BM; nwg = nM * nN; G = G_; c = c_; }
  DI bool next(int i, Unit& u) const {
    const long L = (long)i * G + c; if (L >= nwg) return false;
    int wgid = (int)L; { const int q = nwg / NXCD, r = nwg % NXCD, xcd = wgid % NXCD, off = wgid / NXCD; wgid = (xcd < r ? xcd * (q + 1) : r * (q + 1) + (xcd - r) * q) + off; }
    const int nig = WGM * nN, gid = wgid / nig, fm = gid * WGM, gsz = (nM - fm) < WGM ? (nM - fm) : WGM;
    u.pm = fm + ((wgid % nig) % gsz); u.pn = (wgid % nig) / gsz; return true;
  }
};
template <class Epi>
DI void gemm_phase(LAS unsigned char* lds, const bf16_t* gA, const bf16_t* gBt, int K, const StaticOrder& S, const Epi& E, unsigned long long& eticks) {
  int tid = __builtin_amdgcn_workitem_id_x();
  asm volatile("" : "+v"(tid));
  const int wid = __builtin_amdgcn_readfirstlane(tid >> 6), lane = tid & 63, wr = wid >> 2, wc = wid & 3, fr = lane & 15, fq = lane >> 4;
  const int nt = K / BK;
  unsigned voffA[2], voffB[2];
#pragma unroll
  for (int i = 0; i < 2; ++i) { int R, C; stage_rc(tid * 16 + i * 8192, R, C); voffA[i] = (unsigned)(R * K + C) * 2u; voffB[i] = voffA[i]; }
  const size_t kstep = (size_t)(BK * 2);
  const size_t hstep = (size_t)HALF * K * 2;
  const size_t tstep = 2 * hstep;
  const unsigned ldsw = (unsigned)wid * 1024u;
  const int aoff = lds_byte(wr * 64 + fr, fq * 8), boff = lds_byte(wc * 32 + fr, fq * 8);
#define G8_SA(b, h) (((b) * 2 + (h)) * HTB)
#define G8_SB(b, h) ((4 + (b) * 2 + (h)) * HTB)
#define G8_STAGE(bufoff, gbase, voff) do { _Pragma("unroll") for (int _i = 0; _i < 2; ++_i) \
    __builtin_amdgcn_global_load_lds((const unsigned*)((const char*)(gbase) + (voff)[_i]), (LAS unsigned*)(lds + (bufoff) + ldsw + _i * 8192), 16, 0, 0); } while (0)
#define G8_LDA(dst, b, h) do { _Pragma("unroll") for (int m = 0; m < 4; ++m) _Pragma("unroll") for (int k = 0; k < 2; ++k) dst[m][k] = *(const LAS bf16x8*)(lds + G8_SA(b, h) + aoff + m * 2048 + k * 1024); } while (0)
#define G8_LDB(dst, b, h) do { _Pragma("unroll") for (int n = 0; n < 2; ++n) _Pragma("unroll") for (int k = 0; k < 2; ++k) dst[n][k] = *(const LAS bf16x8*)(lds + G8_SB(b, h) + boff + n * 2048 + k * 1024); } while (0)
#define G8_MMA(ai, bj, At, Bt) do { __builtin_amdgcn_s_setprio(1); _Pragma("unroll") for (int m = 0; m < 4; ++m) _Pragma("unroll") for (int n = 0; n < 2; ++n) _Pragma("unroll") for (int k = 0; k < 2; ++k) \
    acc[ai][bj][m][n] = __builtin_amdgcn_mfma_f32_16x16x32_bf16(Bt[n][k], At[m][k], acc[ai][bj][m][n], 0, 0, 0); __builtin_amdgcn_s_setprio(0); } while (0)
#define G8_WAIT_V(n) asm volatile("s_waitcnt vmcnt(" #n ")" ::: "memory")
#define G8_WAIT_L(n) asm volatile("s_waitcnt lgkmcnt(" #n ")" ::: "memory")
#define G8_BAR __builtin_amdgcn_s_barrier()
#define G8_SCHED __builtin_amdgcn_sched_barrier(0)
  Unit cur, nxt; int ui = 0;
  if (!S.next(0, cur)) return;
  f32x4 acc[2][2][4][2];
#pragma unroll
  for (int a = 0; a < 2; ++a)
#pragma unroll
    for (int b = 0; b < 2; ++b)
#pragma unroll
      for (int m = 0; m < 4; ++m)
#pragma unroll
        for (int n = 0; n < 2; ++n) acc[a][b][m][n] = (f32x4){0.f, 0.f, 0.f, 0.f};
  bf16x8 At[4][2], B0[2][2], B1[2][2];
  const char* cA = (const char*)gA + (size_t)cur.pm * tstep; const char* cB = (const char*)gBt + (size_t)cur.pn * tstep;
  G8_STAGE(G8_SB(0, 0), cB, voffB); G8_STAGE(G8_SA(0, 0), cA, voffA); G8_STAGE(G8_SB(0, 1), cB + hstep, voffB); G8_STAGE(G8_SA(0, 1), cA + hstep, voffA);
  if (wr == 1) G8_BAR;
  G8_WAIT_V(4); G8_BAR;
  G8_STAGE(G8_SB(1, 0), cB + kstep, voffB); G8_STAGE(G8_SA(1, 0), cA + kstep, voffA); G8_STAGE(G8_SB(1, 1), cB + hstep + kstep, voffB);
  G8_WAIT_V(6); G8_BAR;
  for (;;) {
    const bool has_next = S.next(ui + 1, nxt);
    const char* nA = has_next ? (const char*)gA + (size_t)nxt.pm * tstep : cA; const char* nB = has_next ? (const char*)gBt + (size_t)nxt.pn * tstep : cB;
    for (int t = 0; t < nt; t += 2) {
      const bool last = (t == nt - 2);
      const char* a1 = cA + (size_t)(t + 1) * kstep;
      const char* a2 = last ? nA : cA + (size_t)(t + 2) * kstep; const char* b2 = last ? nB : cB + (size_t)(t + 2) * kstep;
      const char* a3 = a2 + kstep; const char* b3 = b2 + kstep;
      G8_LDB(B0, 0, 0); G8_SCHED; G8_LDA(At, 0, 0); G8_STAGE(G8_SA(1, 1), a1 + hstep, voffA);
      G8_WAIT_L(8); G8_BAR; G8_WAIT_L(0); G8_MMA(0, 0, At, B0); G8_BAR; G8_SCHED;
      G8_LDB(B1, 0, 1); G8_STAGE(G8_SB(0, 0), b2, voffB);
      G8_BAR; G8_WAIT_L(0); G8_MMA(0, 1, At, B1); G8_BAR;
      G8_LDA(At, 0, 1); G8_STAGE(G8_SA(0, 0), a2, voffA);
      G8_BAR; G8_WAIT_L(0); G8_MMA(1, 0, At, B0); G8_BAR; G8_SCHED;
      G8_STAGE(G8_SB(0, 1), b2 + hstep, voffB);
      G8_WAIT_V(6); G8_BAR; G8_MMA(1, 1, At, B1); G8_BAR;
      G8_LDB(B0, 1, 0); G8_SCHED; G8_LDA(At, 1, 0); G8_STAGE(G8_SA(0, 1), a2 + hstep, voffA);
      G8_WAIT_L(8); G8_BAR; G8_WAIT_L(0); G8_MMA(0, 0, At, B0); G8_BAR; G8_SCHED;
      G8_LDB(B1, 1, 1); G8_STAGE(G8_SB(1, 0), b3, voffB);
      G8_BAR; G8_WAIT_L(0); G8_MMA(0, 1, At, B1); G8_BAR;
      G8_LDA(At, 1, 1); G8_STAGE(G8_SA(1, 0), a3, voffA);
      G8_BAR; G8_WAIT_L(0); G8_MMA(1, 0, At, B0); G8_BAR; G8_SCHED;
      G8_STAGE(G8_SB(1, 1), b3 + hstep, voffB);
      G8_WAIT_V(6); G8_BAR; G8_MMA(1, 1, At, B1); G8_BAR;
    }
    if (PROBE_T == 8 || PROBE_T == 9) {
      const unsigned long long _t0 = wall_clock64();
      E(acc, cur, wr, wc, fr, fq);
      if (PROBE_T == 9) asm volatile("s_waitcnt vmcnt(0)" ::: "memory");
      eticks += wall_clock64() - _t0;
    } else {
      E(acc, cur, wr, wc, fr, fq);
    }
    if (!has_next) break;
#pragma unroll
    for (int a = 0; a < 2; ++a)
#pragma unroll
      for (int b = 0; b < 2; ++b)
#pragma unroll
        for (int m = 0; m < 4; ++m)
#pragma unroll
          for (int n = 0; n < 2; ++n) acc[a][b][m][n] = (f32x4){0.f, 0.f, 0.f, 0.f};
    cur = nxt; cA = nA; cB = nB; ++ui;
  }
  G8_WAIT_V(0);
  if (wr == 0) G8_BAR;
  G8_BAR;
#undef G8_SA
#undef G8_SB
#undef G8_STAGE
#undef G8_LDA
#undef G8_LDB
#undef G8_MMA
#undef G8_WAIT_V
#undef G8_WAIT_L
#undef G8_BAR
#undef G8_SCHED
}
}

typedef const f32x4 (&Acc8)[2][2][4][2];
DI void epi8_normrope(Acc8 acc, int row0, int colbase, bf16_t* __restrict__ dst, int ld, const float* __restrict__ gw, const float* __restrict__ rope,
                      float oscale, int fq) {
  float gwv[2][2][4];
#pragma unroll
  for (int bj = 0; bj < 2; ++bj)
#pragma unroll
    for (int n = 0; n < 2; ++n)
#pragma unroll
      for (int j = 0; j < 4; ++j) gwv[bj][n][j] = gw[32 * bj + 16 * n + 4 * fq + j];
#pragma unroll
  for (int am = 0; am < 4; ++am) {
    const int ai = am >> 1;
    f32x4 csv[2], snv[2];
#pragma unroll
    for (int mm = 0; mm < 2; ++mm) {
      const int r = row0 + 128 * ai + 16 * ((am & 1) * 2 + mm);
      csv[mm] = *(const f32x4*)(rope + (size_t)r * 16 + (fq & 1) * 4);
      snv[mm] = *(const f32x4*)(rope + (size_t)r * 16 + 8 + (fq & 1) * 4);
    }
#pragma unroll
    for (int mm = 0; mm < 2; ++mm) {
      const int m = (am & 1) * 2 + mm;
      const int r = row0 + 128 * ai + 16 * m;
      float ss = 0.f;
#pragma unroll
      for (int bj = 0; bj < 2; ++bj)
#pragma unroll
        for (int n = 0; n < 2; ++n)
#pragma unroll
          for (int j = 0; j < 4; ++j) ss += acc[ai][bj][m][n][j] * acc[ai][bj][m][n][j];
      ss += __shfl_xor(ss, 16);
      ss += __shfl_xor(ss, 32);
      const float rstd = __builtin_amdgcn_rsqf(ss * (1.f / 64.f) + EPS);
      float v[2][2][4];
#pragma unroll
      for (int bj = 0; bj < 2; ++bj)
#pragma unroll
        for (int n = 0; n < 2; ++n)
#pragma unroll
          for (int j = 0; j < 4; ++j) v[bj][n][j] = acc[ai][bj][m][n][j] * rstd * gwv[bj][n][j];
      const f32x4 cs = csv[mm], sn = snv[mm];
#pragma unroll
      for (int j = 0; j < 4; ++j) {
        const float mine = v[0][0][j];
        const float other = __shfl_xor(mine, 32);
        v[0][0][j] = (fq < 2) ? (mine * cs[j] - other * sn[j]) : (mine * cs[j] + other * sn[j]);
      }
#pragma unroll
      for (int bj = 0; bj < 2; ++bj)
#pragma unroll
        for (int n = 0; n < 2; ++n) {
          u32x2 o;
          o.x = pack_bf2(v[bj][n][0] * oscale, v[bj][n][1] * oscale);
          o.y = pack_bf2(v[bj][n][2] * oscale, v[bj][n][3] * oscale);
          *(u32x2*)(dst + (size_t)r * ld + colbase + 32 * bj + 16 * n + 4 * fq) = o;
        }
    }
  }
}
template <int MODE>
DI void epi8_store_bf16(Acc8 acc, int row0, int colbase, bf16_t* __restrict__ dst, int ld, int fq) {
#pragma unroll
  for (int ai = 0; ai < 2; ++ai)
#pragma unroll
    for (int m = 0; m < 4; ++m) {
      const int r = row0 + 128 * ai + 16 * m;
#pragma unroll
      for (int bj = 0; bj < 2; ++bj)
#pragma unroll
        for (int n = 0; n < 2; ++n) {
          float v[4];
#pragma unroll
          for (int j = 0; j < 4; ++j) { float a = acc[ai][bj][m][n][j]; if (MODE == 1) a = siluf_(a); v[j] = a; }
          u32x2 o;
          o.x = pack_bf2(v[0], v[1]);
          o.y = pack_bf2(v[2], v[3]);
          *(u32x2*)(dst + (size_t)r * ld + colbase + 32 * bj + 16 * n + 4 * fq) = o;
        }
    }
}
DI void epi8_store_vt(Acc8 acc, int row0, int gh, bf16_t* __restrict__ vt, int fr, int fq) {
  const int q = fr & 3;
  const bool odd = (q & 1) != 0, upper = q >= 2;
  const int dsel = 2 * (q & 1) + (q >> 1);
#pragma unroll
  for (int ai = 0; ai < 2; ++ai)
#pragma unroll
    for (int m = 0; m < 4; ++m) {
      const int r = row0 + 128 * ai + 16 * m;
      const int b = r >> 11, sb = (r & 2047) - q;
#pragma unroll
      for (int bj = 0; bj < 2; ++bj)
#pragma unroll
        for (int n = 0; n < 2; ++n) {
          const float v0 = acc[ai][bj][m][n][0], v1 = acc[ai][bj][m][n][1], v2 = acc[ai][bj][m][n][2], v3 = acc[ai][bj][m][n][3];
          const float s0 = odd ? v0 : v2, s1 = odd ? v1 : v3;
          const float r0 = qxor1(s0), r1 = qxor1(s1);
          const float w0 = odd ? r0 : v0, w1 = odd ? r1 : v1, w2 = odd ? v2 : r0, w3 = odd ? v3 : r1;
          const float t0 = upper ? w0 : w1, t1 = upper ? w2 : w3;
          const float x0 = qxor2(t0), x1 = qxor2(t1);
          const float o0 = upper ? x0 : w0, o1 = upper ? x1 : w2, o2 = upper ? w1 : x0, o3 = upper ? w3 : x1;
          const int d = 32 * bj + 16 * n + 4 * fq + dsel;
          u32x2 o;
          o.x = pack_bf2(o0, o1);
          o.y = pack_bf2(o2, o3);
          *(u32x2*)(vt + ((size_t)((b * 4 + gh) * 64 + d)) * 2048 + sb) = o;
        }
    }
}

struct InProjEpi {
  Params p; int layer;
  DI void operator()(Acc8 acc, const g8::Unit& u, int wr, int wc, int fr, int fq) const {
    const bool nsa = (layer & 1) == 0;
    const int lj = layer >> 1;
    const int pn = u.pn;
    const int row0 = u.pm * 256 + wr * 64 + fr;
    const float* rope = (const float*)(p.ws + OFF_ROPE);
    if (pn < 4) {
      epi8_normrope(acc, row0, pn * 256 + wc * 64, (bf16_t*)(p.ws + OFF_Q), 1024, (nsa ? p.nsa_qn : p.moba_qn) + lj * 64, rope, QSCALE, fq);
    } else if (nsa) {
      if (pn == 4) epi8_store_bf16<0>(acc, row0, wc * 64, (bf16_t*)(p.ws + OFF_KC), 256, fq);
      else if (pn == 5) epi8_store_bf16<0>(acc, row0, wc * 64, (bf16_t*)(p.ws + OFF_VC), 256, fq);
      else if (pn == 6) epi8_normrope(acc, row0, wc * 64, (bf16_t*)(p.ws + OFF_KS), 256, p.nsa_kn + (lj * 3 + 1) * 64, rope, 1.0f, fq);
      else if (pn == 7) epi8_store_vt(acc, row0, wc, (bf16_t*)(p.ws + OFF_VST), fr, fq);
      else if (pn == 8) epi8_normrope(acc, row0, wc * 64, (bf16_t*)(p.ws + OFF_KW), 256, p.nsa_kn + (lj * 3 + 2) * 64, rope, 1.0f, fq);
      else if (pn == 9) epi8_store_vt(acc, row0, wc, (bf16_t*)(p.ws + OFF_VWT), fr, fq);
      else epi8_store_bf16<1>(acc, row0, (pn - 10) * 256 + wc * 64, (bf16_t*)(p.ws + OFF_SZ), 1024, fq);
    } else {
      if (pn == 4) epi8_normrope(acc, row0, wc * 64, (bf16_t*)(p.ws + OFF_KS), 256, p.moba_kn + lj * 64, rope, 1.0f, fq);
      else if (pn == 5) epi8_store_vt(acc, row0, wc, (bf16_t*)(p.ws + OFF_VST), fr, fq);
      else epi8_store_bf16<1>(acc, row0, (pn - 6) * 256 + wc * 64, (bf16_t*)(p.ws + OFF_SZ), 1024, fq);
    }
  }
};
struct OutProjEpi {
  Params p; int layer; const float* xin;
  DI void operator()(Acc8 acc, const g8::Unit& u, int wr, int wc, int fr, int fq) const {
    const int row0 = u.pm * 256 + wr * 64 + fr;
    const int b = (u.pm * 256) >> 11;
    const float* gatev = (const float*)(p.ws + OFF_MOD) + (size_t)(layer * 16 + b) * 3072 + 2048;
#pragma unroll
    for (int bj = 0; bj < 2; ++bj)
#pragma unroll
      for (int n = 0; n < 2; ++n) {
        const int c = u.pn * 256 + wc * 64 + 32 * bj + 16 * n + 4 * fq;
        const f32x4 gv = *(const f32x4*)(gatev + c);
        f32x4 xv[2][4];
#pragma unroll
        for (int ai = 0; ai < 2; ++ai)
#pragma unroll
          for (int m = 0; m < 4; ++m) xv[ai][m] = __builtin_nontemporal_load((const f32x4*)(xin + (size_t)(row0 + 128 * ai + 16 * m) * 1024 + c));
#pragma unroll
        for (int ai = 0; ai < 2; ++ai)
#pragma unroll
          for (int m = 0; m < 4; ++m) *(f32x4*)(p.out + (size_t)(row0 + 128 * ai + 16 * m) * 1024 + c) = xv[ai][m] + gv * acc[ai][bj][m][n];
      }
  }
};

DI void gates_tile(const Params& p, int lj, int item, char* smem) {
  const int tile = item >> 1, kh = item & 1;
  const int m0 = tile * 128;
  const int tid = tidx(), lane = tid & 63, w = tid >> 6, wm = w >> 1, wn = w & 1, c16 = lane & 15, lg = lane >> 4;
  const bf16_t* A = (const bf16_t*)(p.ws + OFF_H);
  const bf16_t* Bt = (const bf16_t*)(p.ws + OFF_WT_GL) + (size_t)lj * 128 * 1024 + kh * 512;
  unsigned aoff[4];
#pragma unroll
  for (int i = 0; i < 4; ++i) aoff[i] = (unsigned)(m0 + (tid >> 3) + 32 * i) * 1024u + kh * 512u;
  f32x4 acc[4][4];
  gemm_mainloop<true>(A, aoff, 64, Bt, 512, 0, smem, acc, 1024);
  __syncthreads();
  f32x4* red = (f32x4*)(kh ? smem : smem + SMEM_BYTES) + tid;
  if (kh == 1) {
#pragma unroll
    for (int a = 0; a < 3; ++a)
#pragma unroll
      for (int b = 0; b < 4; ++b) red[(a * 4 + b) * 256] = acc[a][b];
  }
  __syncthreads();
  if (kh == 1) return;
#pragma unroll
  for (int a = 0; a < 3; ++a)
#pragma unroll
    for (int b = 0; b < 4; ++b) acc[a][b] += red[(a * 4 + b) * 256];
  float* gates = (float*)(p.ws + OFF_GATES);
  const float* gb = p.gate_b + lj * 48;
  f32x4 gbv[3];
#pragma unroll
  for (int nt = 0; nt < 3; ++nt) gbv[nt] = *(const f32x4*)(gb + nt * 16 + lg * 4);
  if (wn == 0) {
#pragma unroll
    for (int mt = 0; mt < 4; ++mt) {
      const int m = m0 + wm * 64 + mt * 16 + c16;
#pragma unroll
      for (int nt = 0; nt < 3; ++nt) {
        const int nl = nt * 16 + lg * 4;
        f32x4 o;
        o[0] = sigmoidf_(acc[nt][mt][0] + gbv[nt][0]);
        o[1] = sigmoidf_(acc[nt][mt][1] + gbv[nt][1]);
        o[2] = sigmoidf_(acc[nt][mt][2] + gbv[nt][2]);
        o[3] = sigmoidf_(acc[nt][mt][3] + gbv[nt][3]);
        *(f32x4*)(gates + (size_t)m * 48 + nl) = o;
      }
    }
  }
}

DI void cmp1_tile(const Params& p, int lj, int item, char* smem) {
  const int tile = item >> 1, kh = item & 1;
  const int i = tile >> 7, t = tile & 127;
  const int mtile = t >> 1, ntile = t & 1;
  const int m0 = mtile * 128, n0 = ntile * 128;
  const int tid = tidx(), w = tid >> 6, wm = w >> 1, wn = w & 1;
  const bf16_t* A = (const bf16_t*)(p.ws + (i == 0 ? OFF_KC : OFF_VC));
  const bf16_t* Bt = (const bf16_t*)(p.ws + OFF_WT_CMP1) + (size_t)(lj * 2 + i) * 256 * 2048 + kh * 1024;
  unsigned aoff[4];
#pragma unroll
  for (int q = 0; q < 4; ++q) {
    int m = m0 + (tid >> 3) + 32 * q;
    int g = m & 3, n = (m >> 2) & 127, b = m >> 9;
    if (n > 126) n = 126;
    aoff[q] = (unsigned)((b * 2048 + 16 * n + 16 * kh) * 256 + g * 64);
  }
  f32x4 acc[4][4];
  gemm_mainloop<true>(A, aoff, 256, Bt, 1024, n0, smem, acc, 2048);
  __syncthreads();
  f32x4* red = (f32x4*)(kh ? smem : smem + SMEM_BYTES) + tid;
  if (kh == 1) {
#pragma unroll
    for (int a = 0; a < 4; ++a)
#pragma unroll
      for (int b = 0; b < 4; ++b) red[(a * 4 + b) * 256] = acc[a][b];
  }
  __syncthreads();
  if (kh == 0) {
#pragma unroll
    for (int a = 0; a < 4; ++a)
#pragma unroll
      for (int b = 0; b < 4; ++b) acc[a][b] += red[(a * 4 + b) * 256];
    bf16_t* hid = (bf16_t*)(p.ws + OFF_HID) + (size_t)i * 8192 * 256;
    const float* b1 = (const float*)(p.ws + OFF_B1EFF) + (lj * 2 + i) * 256;
    epi_store_bf16<2>(acc, m0 + wm * 64, n0 + wn * 64, hid, 256, b1);
  }
}

DI void cmp2_item(const Params& p, int lj, int item, char* smem) {
  const int tid = tidx();
  const int tile = item >> 1, kh = item & 1;
  const int i = tile >> 7, rt = tile & 127;
  float* w2s = (float*)smem;
  const float* W2 = p.cmp_w2 + (size_t)(lj * 2 + i) * 256 * 64 + (size_t)kh * 128 * 64;
  const int row = tid >> 2, cq = tid & 3;
  const int m = rt * 64 + row;
  const bf16_t* hid = (const bf16_t*)(p.ws + OFF_HID) + ((size_t)i * 8192 + m) * 256 + kh * 128;
  u32x4 hvv[16];
#pragma unroll
  for (int k8 = 0; k8 < 16; ++k8) hvv[k8] = *(const u32x4*)(hid + k8 * 8);
  __syncthreads();
  for (int q = tid; q < 128 * 64 / 4; q += 256) ((float4*)w2s)[q] = ((const float4*)W2)[q];
  __syncthreads();
  float acc[16];
#pragma unroll
  for (int d = 0; d < 16; ++d) acc[d] = 0.f;
#pragma unroll
  for (int k8 = 0; k8 < 16; ++k8) {
    const u32x4 hv = hvv[k8];
    float hf[8] = {bflo(hv.x), bfhi(hv.x), bflo(hv.y), bfhi(hv.y), bflo(hv.z), bfhi(hv.z), bflo(hv.w), bfhi(hv.w)};
#pragma unroll
    for (int kk = 0; kk < 8; ++kk) {
      const float4* wr = (const float4*)(w2s + (k8 * 8 + kk) * 64 + cq * 16);
      float4 w0 = wr[0], w1 = wr[1], w2 = wr[2], w3 = wr[3];
      float h = hf[kk];
      acc[0] += h * w0.x; acc[1] += h * w0.y; acc[2] += h * w0.z; acc[3] += h * w0.w;
      acc[4] += h * w1.x; acc[5] += h * w1.y; acc[6] += h * w1.z; acc[7] += h * w1.w;
      acc[8] += h * w2.x; acc[9] += h * w2.y; acc[10] += h * w2.z; acc[11] += h * w2.w;
      acc[12] += h * w3.x; acc[13] += h * w3.y; acc[14] += h * w3.z; acc[15] += h * w3.w;
    }
  }
  {
    f32x4* red = (f32x4*)((kh ? smem : smem + SMEM_BYTES) + 32768) + tid;
    if (kh == 1) {
#pragma unroll
      for (int q = 0; q < 4; ++q) red[q * 256] = f32x4{acc[4 * q], acc[4 * q + 1], acc[4 * q + 2], acc[4 * q + 3]};
    }
    __syncthreads();
    if (kh == 1) return;
#pragma unroll
    for (int q = 0; q < 4; ++q) {
      const f32x4 r = red[q * 256];
      acc[4 * q] += r[0]; acc[4 * q + 1] += r[1]; acc[4 * q + 2] += r[2]; acc[4 * q + 3] += r[3];
    }
  }
  const int g = m & 3, n = (m >> 2) & 127, b = m >> 9;
  const bool valid = n < 127;
  if (i == 0) {
    float ss = 0.f;
#pragma unroll
    for (int d = 0; d < 16; ++d) ss += acc[d] * acc[d];
    ss += __shfl_xor(ss, 1);
    ss += __shfl_xor(ss, 2);
    const float rstd = __builtin_amdgcn_rsqf(ss * (1.f / 64.f) + EPS);
    const float* gw = p.nsa_kn + (lj * 3 + 0) * 64 + cq * 16;
#pragma unroll
    for (int d = 0; d < 16; ++d) acc[d] = acc[d] * rstd * gw[d];
    if (cq == 0) {
      const int tokc = b * 2048 + (valid ? 16 * n + 31 : 2047);
      const float* rp = (const float*)(p.ws + OFF_ROPE) + (size_t)tokc * 16;
#pragma unroll
      for (int d = 0; d < 8; ++d) {
        float c = rp[d], s = rp[8 + d];
        float x1 = acc[d], x2 = acc[d + 8];
        acc[d] = x1 * c - x2 * s;
        acc[d + 8] = x2 * c + x1 * s;
      }
    }
    bf16_t* dst = (bf16_t*)(p.ws + OFF_KCMP) + ((size_t)((b * 4 + g) * 128 + n)) * 64 + cq * 16;
    u32x4 o0, o1;
    if (valid) {
      o0.x = pack_bf2(acc[0], acc[1]); o0.y = pack_bf2(acc[2], acc[3]); o0.z = pack_bf2(acc[4], acc[5]); o0.w = pack_bf2(acc[6], acc[7]);
      o1.x = pack_bf2(acc[8], acc[9]); o1.y = pack_bf2(acc[10], acc[11]); o1.z = pack_bf2(acc[12], acc[13]); o1.w = pack_bf2(acc[14], acc[15]);
    } else {
      o0 = u32x4{0u, 0u, 0u, 0u}; o1 = o0;
    }
    *(u32x4*)(dst) = o0;
    *(u32x4*)(dst + 8) = o1;
  } else {
    bf16_t* dst = (bf16_t*)(p.ws + OFF_VCMPT) + ((size_t)((b * 4 + g) * 64 + cq * 16)) * 128 + n;
#pragma unroll
    for (int d = 0; d < 16; ++d) {
      unsigned u = pack_bf2(valid ? acc[d] : 0.f, 0.f);
      dst[(size_t)d * 128] = (bf16_t)(u & 0xffff);
    }
  }
}

DI void kmean_item(const Params& p, int item, char* smem) {
  const int tid = tidx();
  const int blk = item & 7, g = (item >> 3) & 3, b = item >> 5;
  const int d8 = tid & 7, rg = tid >> 3;
  const bf16_t* K = (const bf16_t*)(p.ws + OFF_KS) + ((size_t)(b * 2048 + blk * 256)) * 256 + g * 64 + d8 * 8;
  float s[8];
#pragma unroll
  for (int q = 0; q < 8; ++q) s[q] = 0.f;
#pragma unroll
  for (int r = 0; r < 8; ++r) {
    u32x4 v = *(const u32x4*)(K + (size_t)(rg + 32 * r) * 256);
    s[0] += bflo(v.x); s[1] += bfhi(v.x); s[2] += bflo(v.y); s[3] += bfhi(v.y);
    s[4] += bflo(v.z); s[5] += bfhi(v.z); s[6] += bflo(v.w); s[7] += bfhi(v.w);
  }
  float* red = (float*)smem;
  __syncthreads();
#pragma unroll
  for (int q = 0; q < 8; ++q) red[rg * 64 + d8 * 8 + q] = s[q];
  __syncthreads();
  if (tid < 64) {
    float t = 0.f;
    for (int r = 0; r < 32; ++r) t += red[r * 64 + tid];
    bf16_t* km = (bf16_t*)(p.ws + OFF_KMEAN) + (size_t)((b * 4 + g) * 16) * 64;
    km[blk * 64 + tid] = (bf16_t)(pack_bf2(t * (1.f / 256.f), 0.f) & 0xffff);
    km[(8 + blk) * 64 + tid] = 0;
  }
}

template <int MASKMODE, bool FIXED>
DI void softmax_ct(f32x4 (&Sc)[4], int lo, int hi, float& mrun, float& lrun, f32x4 (&Oc)[4], bf16x8 (&Pc)[2]) {
  const bool colok = (MASKMODE == 1) ? (hi >= 0) : true;
  if (FIXED) {
    float rs = 0.f;
#pragma unroll
    for (int kt = 0; kt < 4; ++kt)
#pragma unroll
      for (int j = 0; j < 4; ++j) {
        float s = Sc[kt][j];
        if (MASKMODE == 2) {
          const int idx = kt * 16 + j;
          s = (idx > lo && idx <= hi) ? s : NEG;
        }
        const float pv = fexp2(s);
        Sc[kt][j] = pv;
        rs += pv;
      }
    if (MASKMODE == 1) rs = colok ? rs : 0.f;
    lrun += rs;
  } else {
    float mx = NEG;
#pragma unroll
    for (int kt = 0; kt < 4; ++kt)
#pragma unroll
      for (int j = 0; j < 4; ++j) {
        float s = Sc[kt][j];
        if (MASKMODE == 2) {
          const int idx = kt * 16 + j;
          s = (idx > lo && idx <= hi) ? s : NEG;
          Sc[kt][j] = s;
        }
        if (MASKMODE == 1) { s = colok ? s : NEG; Sc[kt][j] = s; }
        mx = fmaxf(mx, s);
      }
    mx = fmaxf(mx, __shfl_xor(mx, 16));
    mx = fmaxf(mx, __shfl_xor(mx, 32));
    const float mn = fmaxf(mrun, mx);
    const float alpha = fexp2(mrun - mn);
    mrun = mn;
    const float msafe = mn < -1e29f ? 0.f : mn;
    float rs = 0.f;
#pragma unroll
    for (int kt = 0; kt < 4; ++kt)
#pragma unroll
      for (int j = 0; j < 4; ++j) {
        float pv = fexp2(Sc[kt][j] - msafe);
        Sc[kt][j] = pv;
        rs += pv;
      }
    lrun = lrun * alpha + rs;
#pragma unroll
    for (int dt = 0; dt < 4; ++dt) Oc[dt] *= alpha;
  }
#pragma unroll
  for (int kp = 0; kp < 2; ++kp) {
    u32x4 u;
    u.x = pack_bf2(Sc[2 * kp][0], Sc[2 * kp][1]);
    u.y = pack_bf2(Sc[2 * kp][2], Sc[2 * kp][3]);
    u.z = pack_bf2(Sc[2 * kp + 1][0], Sc[2 * kp + 1][1]);
    u.w = pack_bf2(Sc[2 * kp + 1][2], Sc[2 * kp + 1][3]);
    if (MASKMODE == 1 && FIXED) { u.x = colok ? u.x : 0u; u.y = colok ? u.y : 0u; u.z = colok ? u.z : 0u; u.w = colok ? u.w : 0u; }
    Pc[kp] = __builtin_bit_cast(bf16x8, u);
  }
}
template <int MASKMODE, bool FIXED>
DI void attn_h1(const bf16_t* __restrict__ Ks, const bf16x8 (&Qb)[2][2], f32x4 (&O0)[4], f32x4 (&O1)[4], float (&mrun)[2], float (&lrun)[2],
                const int (&lo)[2], const int (&hi)[2], bf16x8 (&P0)[2], f32x4 (&S1)[4]) {
  const int lane = tidx() & 63, c16 = lane & 15, lg = lane >> 4;
  f32x4 S0[4];
  {
    bf16x8 ka[4][2];
#pragma unroll
    for (int kt = 0; kt < 4; ++kt)
#pragma unroll
      for (int ks = 0; ks < 2; ++ks) ka[kt][ks] = *(const bf16x8*)(Ks + (kt * 16 + c16) * 72 + ks * 32 + lg * 8);
#pragma unroll
    for (int kt = 0; kt < 4; ++kt) {
      S0[kt] = f32x4{0.f, 0.f, 0.f, 0.f};
      S1[kt] = f32x4{0.f, 0.f, 0.f, 0.f};
#pragma unroll
      for (int ks = 0; ks < 2; ++ks) {
        S0[kt] = mfma16(ka[kt][ks], Qb[0][ks], S0[kt]);
        S1[kt] = mfma16(ka[kt][ks], Qb[1][ks], S1[kt]);
      }
    }
  }
  softmax_ct<MASKMODE, FIXED>(S0, lo[0], hi[0], mrun[0], lrun[0], O0, P0);
}
template <int MASKMODE, bool FIXED>
DI void attn_h2(const bf16_t* __restrict__ Vs, f32x4 (&O0)[4], f32x4 (&O1)[4], float (&mrun)[2], float (&lrun)[2], const int (&lo)[2],
                const int (&hi)[2], const bf16x8 (&P0)[2], f32x4 (&S1)[4]) {
  const int lane = tidx() & 63, c16 = lane & 15, lg = lane >> 4;
  bf16x8 va[2][4];
#pragma unroll
  for (int kp = 0; kp < 2; ++kp)
#pragma unroll
    for (int dt = 0; dt < 4; ++dt) {
      const u32x2 v0 = *(const u32x2*)(Vs + (dt * 16 + c16) * 72 + kp * 32 + lg * 4);
      const u32x2 v1 = *(const u32x2*)(Vs + (dt * 16 + c16) * 72 + kp * 32 + 16 + lg * 4);
      va[kp][dt] = __builtin_bit_cast(bf16x8, (u32x4{v0.x, v0.y, v1.x, v1.y}));
    }
#pragma unroll
  for (int kp = 0; kp < 2; ++kp)
#pragma unroll
    for (int dt = 0; dt < 4; ++dt) O0[dt] = mfma16(va[kp][dt], P0[kp], O0[dt]);
  bf16x8 P1[2];
  softmax_ct<MASKMODE, FIXED>(S1, lo[1], hi[1], mrun[1], lrun[1], O1, P1);
#pragma unroll
  for (int kp = 0; kp < 2; ++kp)
#pragma unroll
    for (int dt = 0; dt < 4; ++dt) O1[dt] = mfma16(va[kp][dt], P1[kp], O1[dt]);
}

template <int MODE, bool FIXED>
DI void attn_range(const bf16_t* __restrict__ Kg, const bf16_t* __restrict__ VTg, int j0, int j1, char* smem, int& buf, const bf16x8 (&Qb)[2][2],
                   f32x4 (&O)[4][2], float (&mrun)[2], float (&lrun)[2], const int (&tq)[2], const unsigned (&selbits)[2], int own,
                   u32x4 (&rk)[2], u32x4 (&rv)[2]) {
  const int tid = tidx(), lane = tid & 63, lg = lane >> 4;
  const int half = vhalf();
  const int t512 = half * 256 + tid;
  const int r0 = t512 >> 3, c8 = t512 & 7;
  char* smsh = smem - half * SMEM_BYTES;
  const int soff = r0 * 72 + c8 * 8;
  f32x4 O0[4], O1[4];
#pragma unroll
  for (int dt = 0; dt < 4; ++dt) { O0[dt] = O[dt][0]; O1[dt] = O[dt][1]; }
  {
    bf16_t* base = (bf16_t*)(smsh + buf * SMEM_BYTES);
#pragma unroll
    for (int i = 0; i < 2; ++i) {
      *(u32x4*)(base + i * (64 * 72) + soff) = rk[i];
      *(u32x4*)(base + 9216 + i * (64 * 72) + soff) = rv[i];
    }
  }
#pragma unroll
  for (int i = 0; i < 2; ++i) {
    const int jj = j0 + 2 + i <= j1 ? j0 + 2 + i : j1;
    rk[i] = *(const u32x4*)(Kg + (size_t)(jj * 64 + r0) * 256 + c8 * 8);
    rv[i] = *(const u32x4*)(VTg + (size_t)r0 * 2048 + jj * 64 + c8 * 8);
  }
  lds_barrier();
  for (int jp = j0; jp <= j1; jp += 2) {
    const bf16_t* base = (const bf16_t*)(smsh + buf * SMEM_BYTES);
#pragma unroll 1
    for (int sub = 0; sub < 2; ++sub) {
      const int j = jp + sub;
      if (j > j1) break;
      const bf16_t* cK = base + sub * (64 * 72);
      const bf16_t* cV = base + 9216 + sub * (64 * 72);
      int lo[2], hi[2];
      const int kb = j * 64;
#pragma unroll
      for (int ct = 0; ct < 2; ++ct) {
        const int rel = tq[ct] - kb - lg * 4;
        if (MODE == 0) {
          hi[ct] = ((selbits[ct] >> j) & 1u) ? (j < j1 ? 1000 : rel) : -1;
          lo[ct] = -1000;
        } else if (MODE == 1) {
          hi[ct] = rel;
          lo[ct] = rel - 256;
        } else {
          const int jb = j >> 2;
          if (jb < own) hi[ct] = ((selbits[ct] >> jb) & 1u) ? 1000 : -1;
          else hi[ct] = (j < j1 ? 1000 : rel);
          lo[ct] = -1000;
        }
      }
      const bool act = (hi[0] >= 0 && lo[0] < 63) || (hi[1] >= 0 && lo[1] < 63);
      const bool wact = __any(act);
      bf16x8 P0[2];
      f32x4 S1[4];
      const bool f0 = hi[0] >= 63 && lo[0] < 0, f1 = hi[1] >= 63 && lo[1] < 0;
      const bool cu = (f0 || hi[0] < 0) && (f1 || hi[1] < 0);
      const int mm = !wact ? 3 : (__all(f0 && f1) ? 0 : (__all(cu) ? 1 : 2));
      if (mm == 0) attn_h1<0, FIXED>(cK, Qb, O0, O1, mrun, lrun, lo, hi, P0, S1);
      else if (mm == 1) attn_h1<1, FIXED>(cK, Qb, O0, O1, mrun, lrun, lo, hi, P0, S1);
      else if (mm == 2) attn_h1<2, FIXED>(cK, Qb, O0, O1, mrun, lrun, lo, hi, P0, S1);
      if (mm == 0) attn_h2<0, FIXED>(cV, O0, O1, mrun, lrun, lo, hi, P0, S1);
      else if (mm == 1) attn_h2<1, FIXED>(cV, O0, O1, mrun, lrun, lo, hi, P0, S1);
      else if (mm == 2) attn_h2<2, FIXED>(cV, O0, O1, mrun, lrun, lo, hi, P0, S1);
    }
    if (jp + 2 <= j1) {
      bf16_t* nb = (bf16_t*)(smsh + (buf ^ 1) * SMEM_BYTES);
#pragma unroll
      for (int i = 0; i < 2; ++i) {
        *(u32x4*)(nb + i * (64 * 72) + soff) = rk[i];
        *(u32x4*)(nb + 9216 + i * (64 * 72) + soff) = rv[i];
      }
#pragma unroll
      for (int i = 0; i < 2; ++i) {
        const int jj = jp + 4 + i <= j1 ? jp + 4 + i : j1;
        rk[i] = *(const u32x4*)(Kg + (size_t)(jj * 64 + r0) * 256 + c8 * 8);
        rv[i] = *(const u32x4*)(VTg + (size_t)r0 * 2048 + jj * 64 + c8 * 8);
      }
    }
    lds_barrier();
    buf ^= 1;
  }
#pragma unroll
  for (int dt = 0; dt < 4; ++dt) { O[dt][0] = O0[dt]; O[dt][1] = O1[dt]; }
}

DI void attn_first_pair(const bf16_t* __restrict__ Kg, const bf16_t* __restrict__ VTg, int j0, int j1, u32x4 (&rk)[2], u32x4 (&rv)[2]) {
  const int t512 = vhalf() * 256 + tidx();
  const int r0 = t512 >> 3, c8 = t512 & 7;
#pragma unroll
  for (int i = 0; i < 2; ++i) {
    const int jj = j0 + i <= j1 ? j0 + i : j1;
    rk[i] = *(const u32x4*)(Kg + (size_t)(jj * 64 + r0) * 256 + c8 * 8);
    rv[i] = *(const u32x4*)(VTg + (size_t)r0 * 2048 + jj * 64 + c8 * 8);
  }
}
DI void load_q(const Params& p, int b, int g, int tw  , bf16x8 (&Qb)[2][2]) {
  const int lane = tidx() & 63, c16 = lane & 15, lg = lane >> 4;
  const bf16_t* q = (const bf16_t*)(p.ws + OFF_Q);
#pragma unroll
  for (int ct = 0; ct < 2; ++ct) {
    const int t = tw + ct * 4 + (c16 >> 2), head = g * 4 + (c16 & 3);
    const bf16_t* qp = q + ((size_t)(b * 2048 + t)) * 1024 + head * 64 + lg * 8;
    Qb[ct][0] = __builtin_nontemporal_load((const bf16x8*)(qp));
    Qb[ct][1] = __builtin_nontemporal_load((const bf16x8*)(qp + 32));
  }
}

DI void store_y(const Params& p, int b, int g, int tw, const f32x4 (&Ot)[4][2]) {
  const int lane = tidx() & 63, c16 = lane & 15, lg = lane >> 4;
  const bf16_t* sz = (const bf16_t*)(p.ws + OFF_SZ);
  bf16_t* y = (bf16_t*)(p.ws + OFF_H);
#pragma unroll
  for (int ct = 0; ct < 2; ++ct) {
    const int t = tw + ct * 4 + (c16 >> 2), head = g * 4 + (c16 & 3);
    const size_t base = ((size_t)(b * 2048 + t)) * 1024 + head * 64 + lg * 4;
#pragma unroll
    for (int dt = 0; dt < 4; ++dt) {
      u32x2 zz = __builtin_nontemporal_load((const u32x2*)(sz + base + dt * 16));
      u32x2 o;
      o.x = pack_bf2(Ot[dt][ct][0] * bflo(zz.x), Ot[dt][ct][1] * bfhi(zz.x));
      o.y = pack_bf2(Ot[dt][ct][2] * bflo(zz.y), Ot[dt][ct][3] * bfhi(zz.y));
      *(u32x2*)(y + base + dt * 16) = o;
    }
  }
}

template <bool FIXED>
DI void nsa_attn_item(const Params& p, int item, char* smem) {
  const int tid = tidx(), lane = tid & 63, w = tid >> 6, c16 = lane & 15, lg = lane >> 4;
  const int pi = item >> 1;
  const int rr = pi >> 6, kr = rr >> 2, bq = rr & 3;
  const int bg = pi & 63, qb = 2 * (31 - 4 * kr - ((kr & 1) ? 3 - bq : bq)) + (item & 1);
  const int b = bg >> 2, g = bg & 3;
  const int t0 = qb * 32, tw = t0 + w * 8;
  const int cur = t0 >> 6;
  unsigned* selm = (unsigned*)(smem + 36864);
  float* imp_main = (float*)(smem + 36992);
  float* imp_carry = (float*)(smem + 36992 + 4224);
  f32x4* Otl = (f32x4*)(smem + 36992) + tid;
  bf16x8 Qb[2][2];
  load_q(p, b, g, tw, Qb);
  const bf16_t* KgS = (const bf16_t*)(p.ws + OFF_KS) + (size_t)b * 2048 * 256 + g * 64;
  const bf16_t* VTgS = (const bf16_t*)(p.ws + OFF_VST) + (size_t)bg * 64 * 2048;
  const bf16_t* KgW = (const bf16_t*)(p.ws + OFF_KW) + (size_t)b * 2048 * 256 + g * 64;
  const bf16_t* VTgW = (const bf16_t*)(p.ws + OFF_VWT) + (size_t)bg * 64 * 2048;
  int jlo = t0 - 255;
  jlo = jlo < 0 ? 0 : (jlo >> 6);
  u32x4 rk[2], rv[2];
  attn_first_pair(KgS, VTgS, 0, cur, rk, rv);
  int tq[2];
  float gate[2][3];
  const float* gates = (const float*)(p.ws + OFF_GATES);
#pragma unroll
  for (int ct = 0; ct < 2; ++ct) {
    tq[ct] = tw + ct * 4 + (c16 >> 2);
    const float* gp = gates + ((size_t)(b * 2048 + tq[ct])) * 48 + (g * 4 + (c16 & 3)) * 3;
    gate[ct][0] = gp[0]; gate[ct][1] = gp[1]; gate[ct][2] = gp[2];
  }
  __syncthreads();
  char* smsh = smem - vhalf() * SMEM_BYTES;
  bf16_t* Kc = (bf16_t*)smsh;
  bf16_t* VcT = (bf16_t*)(smsh + 18432);
  {
    const bf16_t* kc = (const bf16_t*)(p.ws + OFF_KCMP) + (size_t)bg * 128 * 64;
    const bf16_t* vc = (const bf16_t*)(p.ws + OFF_VCMPT) + (size_t)bg * 64 * 128;
    const int t512 = vhalf() * 256 + tid;
    u32x4 tk[2], tv[2];
#pragma unroll
    for (int i = 0; i < 2; ++i) {
      const int ch = t512 + i * 512;
      tk[i] = *(const u32x4*)(kc + (ch >> 3) * 64 + (ch & 7) * 8);
      tv[i] = *(const u32x4*)(vc + (ch >> 4) * 128 + (ch & 15) * 8);
    }
#pragma unroll
    for (int i = 0; i < 2; ++i) {
      const int ch = t512 + i * 512;
      *(u32x4*)(Kc + (ch >> 3) * 72 + (ch & 7) * 8) = tk[i];
      *(u32x4*)(VcT + (ch >> 4) * 136 + (ch & 15) * 8) = tv[i];
    }
  }
  __syncthreads();
  f32x4 Ot[4][2];
#pragma unroll
  for (int ct = 0; ct < 2; ++ct) {
    f32x4 Sx[8];
#pragma unroll
    for (int kt = 0; kt < 8; ++kt) {
      Sx[kt] = f32x4{0.f, 0.f, 0.f, 0.f};
#pragma unroll
      for (int ks = 0; ks < 2; ++ks) {
        bf16x8 a = *(const bf16x8*)(Kc + (kt * 16 + c16) * 72 + ks * 32 + lg * 8);
        Sx[kt] = mfma16(a, Qb[ct][ks], Sx[kt]);
      }
    }
    {
      const int hi = ((tq[ct] - 31) >> 4) - lg * 4;
      float mx = NEG;
#pragma unroll
      for (int kt = 0; kt < 8; ++kt)
#pragma unroll
        for (int j = 0; j < 4; ++j) {
          float s = (kt * 16 + j <= hi) ? Sx[kt][j] : NEG;
          Sx[kt][j] = s;
          mx = fmaxf(mx, s);
        }
      mx = fmaxf(mx, __shfl_xor(mx, 16));
      mx = fmaxf(mx, __shfl_xor(mx, 32));
      const float msafe = mx < -1e29f ? 0.f : mx;
      float rs = 0.f;
#pragma unroll
      for (int kt = 0; kt < 8; ++kt)
#pragma unroll
        for (int j = 0; j < 4; ++j) {
          float pv = fexp2(Sx[kt][j] - msafe);
          Sx[kt][j] = pv;
          rs += pv;
        }
      rs += __shfl_xor(rs, 16);
      rs += __shfl_xor(rs, 32);
      const float inv = 1.f / fmaxf(rs, 1e-30f);
      const int qloc = w * 8 + ct * 4 + (c16 >> 2);
#pragma unroll
      for (int kt = 0; kt < 8; ++kt) {
#pragma unroll
        for (int j = 0; j < 4; ++j) Sx[kt][j] *= inv;
        float a = Sx[kt][0] + Sx[kt][1] + Sx[kt][2] + 0.5f * Sx[kt][3];
        float c = 0.5f * Sx[kt][3];
        a += qxor1(a);
        a += qxor2(a);
        c += qxor1(c);
        c += qxor2(c);
        if ((c16 & 3) == 0) {
          const int mi = kt * 4 + lg;
          imp_main[qloc * 33 + mi] = a;
          imp_carry[qloc * 34 + mi + 1] = c;
        }
      }
    }
    f32x4 O[4];
#pragma unroll
    for (int dt = 0; dt < 4; ++dt) O[dt] = f32x4{0.f, 0.f, 0.f, 0.f};
#pragma unroll
    for (int kp = 0; kp < 4; ++kp) {
      u32x4 u;
      u.x = pack_bf2(Sx[2 * kp][0], Sx[2 * kp][1]);
      u.y = pack_bf2(Sx[2 * kp][2], Sx[2 * kp][3]);
      u.z = pack_bf2(Sx[2 * kp + 1][0], Sx[2 * kp + 1][1]);
      u.w = pack_bf2(Sx[2 * kp + 1][2], Sx[2 * kp + 1][3]);
      bf16x8 Pb = __builtin_bit_cast(bf16x8, u);
#pragma unroll
      for (int dt = 0; dt < 4; ++dt) {
        u32x2 v0 = *(const u32x2*)(VcT + (dt * 16 + c16) * 136 + kp * 32 + lg * 4);
        u32x2 v1 = *(const u32x2*)(VcT + (dt * 16 + c16) * 136 + kp * 32 + 16 + lg * 4);
        u32x4 uu = u32x4{v0.x, v0.y, v1.x, v1.y};
        bf16x8 va = __builtin_bit_cast(bf16x8, uu);
        O[dt] = mfma16(va, Pb, O[dt]);
      }
    }
#pragma unroll
    for (int dt = 0; dt < 4; ++dt) Ot[dt][ct] = O[dt] * gate[ct][0];
  }
  __syncthreads();
  {
    const int q = tid >> 3, jj = tid & 7;
    const int jmax = cur - 2;
    unsigned forced = 1u | (1u << cur);
    if (cur >= 1) forced |= 1u << (cur - 1);
    const int need = 8 - __popc(forced);
    float vj[4];
    int cnt[4];
#pragma unroll
    for (int c = 0; c < 4; ++c) {
      const int j = jj + 8 * c;
      vj[c] = (j >= 1 && j <= jmax) ? imp_main[q * 33 + j] + imp_carry[q * 34 + j] : 0.f;
      cnt[c] = 0;
    }
    for (int i = 1; i <= jmax; ++i) {
      const float vi = imp_main[q * 33 + i] + imp_carry[q * 34 + i];
#pragma unroll
      for (int c = 0; c < 4; ++c) {
        const int j = jj + 8 * c;
        cnt[c] += (vi > vj[c] || (vi == vj[c] && i < j)) ? 1 : 0;
      }
    }
    unsigned bits = 0;
#pragma unroll
    for (int c = 0; c < 4; ++c) {
      const int j = jj + 8 * c;
      if (j >= 1 && j <= jmax && cnt[c] < need) bits |= 1u << j;
    }
    bits |= (unsigned)__shfl_xor((int)bits, 1);
    bits |= (unsigned)__shfl_xor((int)bits, 2);
    bits |= (unsigned)__shfl_xor((int)bits, 4);
    if (jj == 0) selm[q] = forced | bits;
  }
  __syncthreads();
  unsigned selbits[2];
#pragma unroll
  for (int ct = 0; ct < 2; ++ct) selbits[ct] = selm[w * 8 + ct * 4 + (c16 >> 2)];
#pragma unroll
  for (int dt = 0; dt < 4; ++dt)
#pragma unroll
    for (int ct = 0; ct < 2; ++ct) Otl[(dt * 2 + ct) * 256] = Ot[dt][ct];
  int buf = 0;
  {
    f32x4 O[4][2];
    float mrun[2] = {NEG, NEG}, lrun[2] = {0.f, 0.f};
#pragma unroll
    for (int dt = 0; dt < 4; ++dt) { O[dt][0] = f32x4{0.f, 0.f, 0.f, 0.f}; O[dt][1] = f32x4{0.f, 0.f, 0.f, 0.f}; }
    attn_range<0, FIXED>(KgS, VTgS, 0, cur, smem, buf, Qb, O, mrun, lrun, tq, selbits, 0, rk, rv);
    attn_first_pair(KgW, VTgW, jlo, cur, rk, rv);
#pragma unroll
    for (int ct = 0; ct < 2; ++ct) {
      float l = lrun[ct];
      l += __shfl_xor(l, 16);
      l += __shfl_xor(l, 32);
      const float sc = gate[ct][1] / fmaxf(l, 1e-30f);
#pragma unroll
      for (int dt = 0; dt < 4; ++dt) Otl[(dt * 2 + ct) * 256] = Otl[(dt * 2 + ct) * 256] + O[dt][ct] * sc;
    }
  }
  {
    f32x4 O[4][2];
    float mrun[2] = {NEG, NEG}, lrun[2] = {0.f, 0.f};
#pragma unroll
    for (int dt = 0; dt < 4; ++dt) { O[dt][0] = f32x4{0.f, 0.f, 0.f, 0.f}; O[dt][1] = f32x4{0.f, 0.f, 0.f, 0.f}; }
    attn_range<1, FIXED>(KgW, VTgW, jlo, cur, smem, buf, Qb, O, mrun, lrun, tq, selbits, 0, rk, rv);
#pragma unroll
    for (int ct = 0; ct < 2; ++ct) {
      float l = lrun[ct];
      l += __shfl_xor(l, 16);
      l += __shfl_xor(l, 32);
      const float sc = gate[ct][2] / fmaxf(l, 1e-30f);
#pragma unroll
      for (int dt = 0; dt < 4; ++dt) Ot[dt][ct] = Otl[(dt * 2 + ct) * 256] + O[dt][ct] * sc;
    }
  }
  store_y(p, b, g, tw, Ot);
}

template <bool FIXED>
DI void moba_attn_item(const Params& p, int item, char* smem) {
  const int tid = tidx(), lane = tid & 63, w = tid >> 6, c16 = lane & 15, lg = lane >> 4;
  const int pi = item >> 1;
  const int rr = pi >> 6, kr = rr >> 2, bq = rr & 3;
  const int bg = pi & 63, qb = 2 * (31 - 4 * kr - ((kr & 1) ? 3 - bq : bq)) + (item & 1);
  const int b = bg >> 2, g = bg & 3;
  const int t0 = qb * 32, tw = t0 + w * 8;
  const int own = t0 >> 8;
  bf16x8 Qb[2][2];
  load_q(p, b, g, tw, Qb);
  const bf16_t* Kg = (const bf16_t*)(p.ws + OFF_KS) + (size_t)b * 2048 * 256 + g * 64;
  const bf16_t* VTg = (const bf16_t*)(p.ws + OFF_VST) + (size_t)bg * 64 * 2048;
  u32x4 rk[2], rv[2];
  attn_first_pair(Kg, VTg, 0, t0 >> 6, rk, rv);
  int tq[2];
#pragma unroll
  for (int ct = 0; ct < 2; ++ct) tq[ct] = tw + ct * 4 + (c16 >> 2);
  __syncthreads();
  bf16_t* Km = (bf16_t*)(smem + 36864);
  if (tid < 128) {
    int row = tid >> 3, cc = tid & 7;
    *(u32x4*)(Km + row * 72 + cc * 8) = *(const u32x4*)((const bf16_t*)(p.ws + OFF_KMEAN) + (size_t)bg * 16 * 64 + row * 64 + cc * 8);
  }
  __syncthreads();
  unsigned selbits[2];
#pragma unroll
  for (int ct = 0; ct < 2; ++ct) {
    f32x4 sg = f32x4{0.f, 0.f, 0.f, 0.f};
#pragma unroll
    for (int ks = 0; ks < 2; ++ks) {
      bf16x8 a = *(const bf16x8*)(Km + c16 * 72 + ks * 32 + lg * 8);
      sg = mfma16(a, Qb[ct][ks], sg);
    }
    f32x4 ot;
#pragma unroll
    for (int j = 0; j < 4; ++j) ot[j] = __shfl_xor(sg[j], 16);
    const bool odd = (lg & 1) != 0;
    float v0 = odd ? ot[0] : sg[0], v1 = odd ? ot[1] : sg[1], v2 = odd ? ot[2] : sg[2], v3 = odd ? ot[3] : sg[3];
    float v4 = odd ? sg[0] : ot[0], v5 = odd ? sg[1] : ot[1], v6 = odd ? sg[2] : ot[2], v7 = odd ? sg[3] : ot[3];
    unsigned sel = 0;
#pragma unroll
    for (int it = 0; it < 3; ++it) {
      float bv = -3.0e38f;
      int best = -1;
#define CAND(J, V) if ((J) < own && !((sel >> (J)) & 1u) && (V) > bv) { bv = (V); best = (J); }
      CAND(0, v0) CAND(1, v1) CAND(2, v2) CAND(3, v3) CAND(4, v4) CAND(5, v5) CAND(6, v6) CAND(7, v7)
#undef CAND
      if (best >= 0) sel |= 1u << best;
    }
    selbits[ct] = (unsigned)__shfl((int)sel, c16);
  }
  int buf = 0;
  f32x4 O[4][2];
  float mrun[2] = {NEG, NEG}, lrun[2] = {0.f, 0.f};
#pragma unroll
  for (int dt = 0; dt < 4; ++dt) { O[dt][0] = f32x4{0.f, 0.f, 0.f, 0.f}; O[dt][1] = f32x4{0.f, 0.f, 0.f, 0.f}; }
  attn_range<2, FIXED>(Kg, VTg, 0, t0 >> 6, smem, buf, Qb, O, mrun, lrun, tq, selbits, own, rk, rv);
#pragma unroll
  for (int ct = 0; ct < 2; ++ct) {
    float l = lrun[ct];
    l += __shfl_xor(l, 16);
    l += __shfl_xor(l, 32);
    const float sc = 1.f / fmaxf(l, 1e-30f);
#pragma unroll
    for (int dt = 0; dt < 4; ++dt) O[dt][ct] *= sc;
  }
  store_y(p, b, g, tw, O);
}

#ifndef PROBE_DUP
#define PROBE_DUP -1
#endif
DI void run_phase1(const Params& pin, int layer, int ph, char* smem, unsigned long long& eticks);
DI void run_phase(const Params& pin, int layer, int ph, char* smem, unsigned long long& eticks) {
  run_phase1(pin, layer, ph, smem, eticks);
}
DI void run_phase1(const Params& pin, int layer, int ph, char* smem_all, unsigned long long& eticks) {
  Params p = pin;
  {
    size_t z = 0;
    asm volatile("" : "+s"(z));
    p.ws = pin.ws + z;
    p.out = pin.out + z;
  }
  const int half = vhalf();
  char* smem = smem_all + half * SMEM_BYTES;
  const int G = 2 * gridDim.x, bid = 2 * blockIdx.x + half;
  const bool nsa = (layer & 1) == 0;
  const int lj = layer >> 1;
  const float* xin = layer == 0 ? p.x : p.out;
  if (ph == 0) {
    for (int it = bid; it < NW_TOTAL; it += G) phaseW_item(p, it, smem);
  } else if (ph == 1) {
    for (int it = bid; it < NTOK / 16; it += G) prep_item(p, layer, xin, it);
  } else if (ph == 2) {
    g8::StaticOrder S;
    S.init(NTOK, nsa ? NSA_NP : MOBA_IN, gridDim.x, blockIdx.x);
    InProjEpi E{p, layer};
    const bf16_t* Bt = nsa ? (const bf16_t*)(p.ws + OFF_WT_NSA_IN) + (size_t)lj * NSA_NP * 1024
                           : (const bf16_t*)(p.ws + OFF_WT_MOBA_IN) + (size_t)lj * MOBA_IN * 1024;
    g8::gemm_phase(( LAS unsigned char*)smem_all, (const bf16_t*)(p.ws + OFF_H), Bt, 1024, S, E, eticks);
    if (nsa) {
      __syncthreads();
      for (int it = bid; it < 512; it += G) gates_tile(p, lj, it, smem);
    }
  } else if (ph == 3) {
    if (nsa) { for (int it = bid; it < 512; it += G) cmp1_tile(p, lj, it, smem); }
    else { for (int it = bid; it < 512; it += G) kmean_item(p, it, smem); }
  } else if (ph == 4) {
    if (nsa) for (int it = bid; it < 512; it += G) cmp2_item(p, lj, it, smem);
  } else if (ph == 5) {
    float gq, gk;
    {
      const int l64 = tidx() & 63;
      if (nsa) {
        gq = fabsf(p.nsa_qn[lj * 64 + l64]);
        gk = fmaxf(fabsf(p.nsa_kn[(lj * 3 + 1) * 64 + l64]), fabsf(p.nsa_kn[(lj * 3 + 2) * 64 + l64]));
      } else {
        gq = fabsf(p.moba_qn[lj * 64 + l64]);
        gk = fabsf(p.moba_kn[lj * 64 + l64]);
      }
#pragma unroll
      for (int o = 32; o >= 1; o >>= 1) { gq = fmaxf(gq, __shfl_xor(gq, o)); gk = fmaxf(gk, __shfl_xor(gk, o)); }
    }
    const bool fixed_ok = (11.8f * gq * gk) <= 100.f;
    if (nsa) {
      if (fixed_ok) { for (int it = bid; it < 4096; it += G) nsa_attn_item<true>(p, it, smem); }
      else { for (int it = bid; it < 4096; it += G) nsa_attn_item<false>(p, it, smem); }
    } else {
      if (fixed_ok) { for (int it = bid; it < 4096; it += G) moba_attn_item<true>(p, it, smem); }
      else { for (int it = bid; it < 4096; it += G) moba_attn_item<false>(p, it, smem); }
    }
  } else if (ph == 6) {
    g8::StaticOrder S;
    S.init(NTOK, 1024, gridDim.x, blockIdx.x);
    OutProjEpi E{p, layer, xin};
    const bf16_t* Bt = (const bf16_t*)(p.ws + (nsa ? OFF_WT_NSA_OUT : OFF_WT_MOBA_OUT)) + (size_t)lj * 1024 * 1024;
    { unsigned long long dummy = 0; g8::gemm_phase((LAS unsigned char*)smem_all, (const bf16_t*)(p.ws + OFF_H), Bt, 1024, S, E, dummy); }
  }
}

#if MULTI_LAUNCH
template <int PH>
__global__ void __launch_bounds__(512, 2) phase_kernel(Params p, int layer) {
  __shared__ __attribute__((aligned(16))) char smem[2 * SMEM_BYTES];
  unsigned long long eticks = 0;
  run_phase(p, layer, PH, smem, eticks);
}
#else
#ifndef PROBE_T
#define PROBE_T -1
#endif
#define TSTAMP(type) do { if (PROBE_T >= 0) { unsigned long long _t = wall_clock64(); if (PROBE_T == (type)) tacc += _t - tprev; tprev = _t; } } while (0)
__global__ void __launch_bounds__(512, 2) mega_kernel(Params p) {
  __shared__ __attribute__((aligned(16))) char smem[2 * SMEM_BYTES];
  __shared__ u32x4 xb_words;
  cg::grid_group grid = cg::this_grid();
  if (__builtin_amdgcn_workitem_id_x() == 0) xb_words = u32x4{0u, 0u, 0u, 0u};
  __syncthreads();
  XcdBarrier xb = xcd_barrier_post((unsigned*)(p.ws + OFF_BAR), (volatile LAS unsigned*)&xb_words);
  unsigned long long tprev = 0, tacc = 0, eticks = 0;
  if (PROBE_T >= 0) tprev = wall_clock64();
  run_phase(p, 0, 0, smem, eticks);
  grid.sync();
  TSTAMP(0);
  for (int layer = 0; layer < 4; ++layer) {
    const bool nsa = (layer & 1) == 0;
    run_phase(p, layer, 1, smem, eticks);
    xcd_barrier(xb);
    TSTAMP(1);
    run_phase(p, layer, 2, smem, eticks);
    xcd_barrier(xb);
    TSTAMP(2);
    run_phase(p, layer, 3, smem, eticks);
    xcd_barrier(xb);
    TSTAMP(3);
    if (nsa) {
      run_phase(p, layer, 4, smem, eticks);
      xcd_barrier(xb);
      TSTAMP(4);
    }
    run_phase(p, layer, 5, smem, eticks);
    xcd_barrier(xb);
    TSTAMP(nsa ? 5 : 7);
    run_phase(p, layer, 6, smem, eticks);
    if (layer < 3 || PROBE_T >= 0) xcd_barrier(xb);
    TSTAMP(6);
  }
  if (PROBE_T >= 0 && blockIdx.x == 0 && __builtin_amdgcn_workitem_id_x() == 0) p.out[0] = (float)((PROBE_T >= 8) ? eticks : tacc) * 0.01f * 0.03f;
}
#endif

extern "C" void kernel_launch(void* const* d_in, const int* in_sizes, int n_in, void* d_out, int out_size, void* d_ws, size_t ws_size,
                              hipStream_t stream) {
  Params p{};
  p.x = (const float*)d_in[0];
  p.c = (const float*)d_in[1];
  p.pos = (const int*)d_in[2];
  p.norm_g = (const float*)d_in[3];
  p.ada_w = (const float*)d_in[4];
  p.ada_b = (const float*)d_in[5];
  p.nsa_w_in = (const float*)d_in[6];
  p.nsa_w_out = (const float*)d_in[7];
  p.nsa_qn = (const float*)d_in[8];
  p.nsa_kn = (const float*)d_in[9];
  p.cmp_pe = (const float*)d_in[10];
  p.cmp_w1 = (const float*)d_in[11];
  p.cmp_b1 = (const float*)d_in[12];
  p.cmp_w2 = (const float*)d_in[13];
  p.gate_b = (const float*)d_in[14];
  p.moba_w_in = (const float*)d_in[15];
  p.moba_w_out = (const float*)d_in[16];
  p.moba_qn = (const float*)d_in[17];
  p.moba_kn = (const float*)d_in[18];
  p.out = (float*)d_out;
  p.ws = (char*)d_ws;
  if (ws_size < WS_TOTAL) { fprintf(stderr, "workspace too small: %zu < %zu\n", ws_size, (size_t)WS_TOTAL); return; }
#if MULTI_LAUNCH
  const int G = 256;
  phase_kernel<0><<<G, 512, 0, stream>>>(p, 0);
  for (int layer = 0; layer < 4; ++layer) {
    phase_kernel<1><<<G, 512, 0, stream>>>(p, layer);
    phase_kernel<2><<<G, 512, 0, stream>>>(p, layer);
    phase_kernel<3><<<G, 512, 0, stream>>>(p, layer);
    if (!(layer & 1)) phase_kernel<4><<<G, 512, 0, stream>>>(p, layer);
    phase_kernel<5><<<G, 512, 0, stream>>>(p, layer);
    phase_kernel<6><<<G, 512, 0, stream>>>(p, layer);
  }
#else
  static int grid_blocks = 0;
  if (!grid_blocks) {
    int dev = 0, cus = 0, per_cu = 0;
    (void)hipGetDevice(&dev);
    (void)hipDeviceGetAttribute(&cus, hipDeviceAttributeMultiprocessorCount, dev);
    (void)hipOccupancyMaxActiveBlocksPerMultiprocessor(&per_cu, mega_kernel, 512, 0);
    if (per_cu > 1) per_cu = 1;
    grid_blocks = cus * per_cu;
  }
  (void)hipMemsetAsync((char*)d_ws + OFF_BAR, 0, BAR_BYTES, stream);
  void* args[] = {&p};
  hipError_t e = hipLaunchCooperativeKernel((void*)mega_kernel, dim3(grid_blocks), dim3(512), args, 0, stream);
  if (e != hipSuccess) fprintf(stderr, "cooperative launch failed: %s (grid %d)\n", hipGetErrorString(e), grid_blocks);
#endif
}
```

```cpp
#include <hip/hip_runtime.h>
#include <hip/hip_cooperative_groups.h>
#include <cstdio>
namespace cg = cooperative_groups;

#ifndef MULTI_LAUNCH
#define MULTI_LAUNCH 0
#endif

#define DI __device__ __forceinline__
typedef unsigned short bf16_t;
using bf16x8 = __attribute__((ext_vector_type(8))) short;
using f32x4 = __attribute__((ext_vector_type(4))) float;
typedef __bf16 bf16x2_t __attribute__((ext_vector_type(2)));
typedef float f32x2_t __attribute__((ext_vector_type(2)));
using u32x4 = __attribute__((ext_vector_type(4))) unsigned;
using u32x2 = __attribute__((ext_vector_type(2))) unsigned;

constexpr int DM = 1024, NB = 16, SEQ = 2048, NTOK = NB * SEQ;
constexpr int NSA_IN = 3632, NSA_NP = 3584, MOBA_IN = 2560;
constexpr float EPS = 1e-6f;
constexpr float QSCALE = 0.125f * 1.4426950408889634f;
constexpr float NEG = -1e30f;

constexpr size_t SZ_WT_NSA_IN = (size_t)2 * NSA_NP * 1024 * 2;
constexpr size_t SZ_WT_SQ = (size_t)2 * 1024 * 1024 * 2;
constexpr size_t SZ_WT_MOBA_IN = (size_t)2 * MOBA_IN * 1024 * 2;
constexpr size_t SZ_WT_CMP1 = (size_t)4 * 256 * 2048 * 2;
constexpr size_t SZ_ACT = (size_t)NTOK * 1024 * 2;
constexpr size_t SZ_KV = (size_t)NTOK * 256 * 2;
constexpr size_t OFF_WT_NSA_IN = 0;
constexpr size_t OFF_WT_NSA_OUT = OFF_WT_NSA_IN + SZ_WT_NSA_IN;
constexpr size_t OFF_WT_MOBA_IN = OFF_WT_NSA_OUT + SZ_WT_SQ;
constexpr size_t OFF_WT_MOBA_OUT = OFF_WT_MOBA_IN + SZ_WT_MOBA_IN;
constexpr size_t OFF_WT_CMP1 = OFF_WT_MOBA_OUT + SZ_WT_SQ;
constexpr size_t OFF_B1EFF = OFF_WT_CMP1 + SZ_WT_CMP1;
constexpr size_t OFF_ROPE = OFF_B1EFF + 4096;
constexpr size_t OFF_MOD = OFF_ROPE + (size_t)NTOK * 16 * 4;
constexpr size_t OFF_H = OFF_MOD + (size_t)4 * 16 * 3072 * 4;
constexpr size_t OFF_Q = OFF_H + SZ_ACT;
constexpr size_t OFF_SZ = OFF_Q + SZ_ACT;
constexpr size_t OFF_KC = OFF_SZ + SZ_ACT;
constexpr size_t OFF_VC = OFF_KC + SZ_KV;
constexpr size_t OFF_KS = OFF_VC + SZ_KV;
constexpr size_t OFF_KW = OFF_KS + SZ_KV;
constexpr size_t OFF_VST = OFF_KW + SZ_KV;
constexpr size_t OFF_VWT = OFF_VST + SZ_KV;
constexpr size_t OFF_GATES = OFF_VWT + SZ_KV;
constexpr size_t OFF_HID = OFF_GATES + (size_t)NTOK * 48 * 4;
constexpr size_t OFF_KCMP = OFF_HID + (size_t)2 * 8192 * 256 * 2;
constexpr size_t OFF_VCMPT = OFF_KCMP + (size_t)64 * 128 * 64 * 2;
constexpr size_t OFF_KMEAN = OFF_VCMPT + (size_t)64 * 128 * 64 * 2;
constexpr size_t OFF_WT_GL = OFF_KMEAN + (size_t)64 * 16 * 64 * 2;
constexpr size_t OFF_BAR = OFF_WT_GL + (size_t)2 * 128 * 1024 * 2;
constexpr size_t BAR_BYTES = 3456 * 4;
constexpr size_t WS_TOTAL = OFF_BAR + 16384;

struct Params {
  const float *x, *c;
  const int* pos;
  const float *norm_g, *ada_w, *ada_b, *nsa_w_in, *nsa_w_out, *nsa_qn, *nsa_kn, *cmp_pe, *cmp_w1, *cmp_b1, *cmp_w2, *gate_b,
      *moba_w_in, *moba_w_out, *moba_qn, *moba_kn;
  float* out;
  char* ws;
};

constexpr int SMEM_BYTES = 73728;

DI int tidx() {
  int t = __builtin_amdgcn_workitem_id_x() & 255;
  asm volatile("" : "+v"(t));
  return t;
}
DI void lds_barrier() {
  asm volatile("s_waitcnt lgkmcnt(0)" ::: "memory");
  __builtin_amdgcn_s_barrier();
  asm volatile("" ::: "memory");
}
DI float qxor1(float x) { return __builtin_bit_cast(float, __builtin_amdgcn_mov_dpp(__builtin_bit_cast(int, x), 0xB1, 0xF, 0xF, true)); }
DI float qxor2(float x) { return __builtin_bit_cast(float, __builtin_amdgcn_mov_dpp(__builtin_bit_cast(int, x), 0x4E, 0xF, 0xF, true)); }
DI int vhalf() { return __builtin_amdgcn_readfirstlane(__builtin_amdgcn_workitem_id_x() >> 8); }
DI unsigned pack_bf2(float a, float b) {
  f32x2_t v = {a, b};
  bf16x2_t r = __builtin_convertvector(v, bf16x2_t);
  return __builtin_bit_cast(unsigned, r);
}
DI float bf2f(bf16_t v) { return __uint_as_float(((unsigned)v) << 16); }
DI float bflo(unsigned u) { return __uint_as_float(u << 16); }
DI float bfhi(unsigned u) { return __uint_as_float(u & 0xffff0000u); }
DI f32x4 mfma16(bf16x8 a, bf16x8 b, f32x4 c) { return __builtin_amdgcn_mfma_f32_16x16x32_bf16(a, b, c, 0, 0, 0); }
DI float fexp2(float x) { return __builtin_amdgcn_exp2f(x); }
DI float sigmoidf_(float x) { return __builtin_amdgcn_rcpf(1.f + __builtin_amdgcn_exp2f(-1.4426950408889634f * x)); }
DI float siluf_(float x) { return x * __builtin_amdgcn_rcpf(1.f + __builtin_amdgcn_exp2f(-1.4426950408889634f * x)); }
DI float geluf_(float x) {
  float u = 0.7978845608028654f * (x + 0.044715f * x * x * x);
  float t = 1.f - 2.f / (__expf(2.f * u) + 1.f);
  return 0.5f * x * (1.f + t);
}


#define XB_TMO      128
#define XB_XCNT(j)  (256  + 64 * (j))
#define XB_XSUB(j)  (1280 + 64 * (j))
#define XB_XGEN(j)  (2304 + 64 * (j))
#define XB_TOP      3328
#define XB_TOPGEN   3392
#define XB_SPIN_CAP (1u << 22)
#define LAS __attribute__((address_space(3)))
DI unsigned xb_ld(unsigned* p) { return __hip_atomic_load(p, __ATOMIC_RELAXED, __HIP_MEMORY_SCOPE_AGENT); }
DI unsigned xb_add(unsigned* p, unsigned v) { return __hip_atomic_fetch_add(p, v, __ATOMIC_RELAXED, __HIP_MEMORY_SCOPE_AGENT); }
DI unsigned xb_xcc_id() { return (unsigned)__builtin_amdgcn_s_getreg((3 << 11) | 20) & 0xFu; }
#define XB_SPIN(cond, bar) do { unsigned _sp = 0; while (cond) { __builtin_amdgcn_s_sleep(1); \
    if ((++_sp & 255u) == 0u) { if (xb_ld(&(bar)[XB_TMO])) break; if (_sp > XB_SPIN_CAP) { atomicAdd(&(bar)[XB_TMO], 1u); break; } } } } while (0)
struct XcdBarrier { unsigned* bar; unsigned x; volatile LAS unsigned* st; };
DI XcdBarrier xcd_barrier_post(unsigned* bar, volatile LAS unsigned* st) {
  XcdBarrier b; b.bar = bar; b.x = xb_xcc_id(); b.st = st;
  if (__builtin_amdgcn_workitem_id_x() == 0) (void)xb_add(&bar[XB_XCNT(b.x)], 1u);
  return b;
}
DI void xcd_barrier_complete(unsigned* bar, unsigned x, unsigned& nloc, unsigned& nx) {
  const unsigned G = gridDim.x * gridDim.y * gridDim.z;
  unsigned sum, cnt, mine, sp = 0u;
  for (;;) {
    sum = 0u; cnt = 0u; mine = 0u;
#pragma unroll
    for (unsigned j = 0; j < 16; ++j) { const unsigned c = xb_ld(&bar[XB_XCNT(j)]); sum += c; cnt += (c > 0u) ? 1u : 0u; mine = (j == x) ? c : mine; }
    if (sum == G) break;
    __builtin_amdgcn_s_sleep(1);
    if ((++sp & 255u) == 0u) { if (xb_ld(&bar[XB_TMO])) break; if (sp > XB_SPIN_CAP) { atomicAdd(&bar[XB_TMO], 1u); break; } }
  }
  nloc = mine > 0u ? mine : 1u; nx = cnt > 0u ? cnt : 1u;
}
DI void xcd_barrier(const XcdBarrier& b) {
  asm volatile("s_waitcnt vmcnt(0)" ::: "memory");
  __syncthreads();
  if (__builtin_amdgcn_workitem_id_x() == 0) {
    unsigned* bar = b.bar;
    __builtin_amdgcn_s_waitcnt(0);
    unsigned nloc = b.st[0], nx = b.st[1];
    if (nloc == 0u) { xcd_barrier_complete(bar, b.x, nloc, nx); b.st[0] = nloc; b.st[1] = nx; }
    const unsigned old = xb_add(&bar[XB_XSUB(b.x)], 1u);
    const unsigned gen = old / nloc;
    if (old + 1u == (gen + 1u) * nloc) {
      __builtin_amdgcn_fence(__ATOMIC_RELEASE, "agent");
      asm volatile("s_waitcnt vmcnt(0)" ::: "memory");
      const unsigned og = xb_add(&bar[XB_TOP], 1u);
      const unsigned tg = og / nx;
      if (og + 1u == (tg + 1u) * nx) xb_add(&bar[XB_TOPGEN], 1u);
      else XB_SPIN(xb_ld(&bar[XB_TOPGEN]) == tg, bar);
      __builtin_amdgcn_fence(__ATOMIC_ACQUIRE, "agent");
      xb_add(&bar[XB_XGEN(b.x)], 1u);
      asm volatile("s_waitcnt vmcnt(0)" ::: "memory");
    } else {
      XB_SPIN(xb_ld(&bar[XB_XGEN(b.x)]) == gen, bar);
      __builtin_amdgcn_fence(__ATOMIC_ACQUIRE, "agent");
      asm volatile("s_waitcnt vmcnt(0)" ::: "memory");
    }
  }
  __syncthreads();
}

DI void ada_item(const Params& p, int item, char* smem) {
  const int tid = tidx();
  const int l = item / 192, n0 = (item % 192) * 16;
  float* cond = (float*)smem;
  __syncthreads();
  for (int i = tid; i < 16 * 1024; i += 256) {
    int b = i >> 10, k = i & 1023;
    float v = p.c[i];
    cond[k * 16 + b] = siluf_(v);
  }
  __syncthreads();
  const int kq = tid >> 4, col = tid & 15;
  float acc[16];
#pragma unroll
  for (int b = 0; b < 16; ++b) acc[b] = 0.f;
  const float* w = p.ada_w + (size_t)l * 1024 * 3072 + n0 + col;
#pragma unroll 16
  for (int k = kq * 64; k < kq * 64 + 64; ++k) {
    float wv = __builtin_nontemporal_load(w + (size_t)k * 3072);
    const float4* cp = (const float4*)(cond + k * 16);
    float4 c0 = cp[0], c1 = cp[1], c2 = cp[2], c3 = cp[3];
    acc[0] += wv * c0.x; acc[1] += wv * c0.y; acc[2] += wv * c0.z; acc[3] += wv * c0.w;
    acc[4] += wv * c1.x; acc[5] += wv * c1.y; acc[6] += wv * c1.z; acc[7] += wv * c1.w;
    acc[8] += wv * c2.x; acc[9] += wv * c2.y; acc[10] += wv * c2.z; acc[11] += wv * c2.w;
    acc[12] += wv * c3.x; acc[13] += wv * c3.y; acc[14] += wv * c3.z; acc[15] += wv * c3.w;
  }
  __syncthreads();
  float* red = (float*)smem;
#pragma unroll
  for (int b = 0; b < 16; ++b) red[(kq * 16 + b) * 16 + col] = acc[b];
  __syncthreads();
  float* mod = (float*)(p.ws + OFF_MOD);
  {
    const int b = tid >> 4, cc = tid & 15;
    float s = 0.f;
#pragma unroll
    for (int q = 0; q < 16; ++q) s += red[(q * 16 + b) * 16 + cc];
    mod[(size_t)(l * 16 + b) * 3072 + n0 + cc] = s + p.ada_b[l * 3072 + n0 + cc];
  }
}

DI void b1eff_item(const Params& p, int item, char* smem) {
  const int tid = tidx();
  const int li = item >> 4, h0 = (item & 15) * 16;
  const int kg = tid >> 4, hh = tid & 15;
  const float* W1 = p.cmp_w1 + (size_t)li * 2048 * 256;
  const float* pe = p.cmp_pe + li * 2048;
  float acc = 0.f;
#pragma unroll 16
  for (int k = kg * 128; k < kg * 128 + 128; ++k) acc += pe[k] * __builtin_nontemporal_load(W1 + (size_t)k * 256 + h0 + hh);
  float* red = (float*)smem;
  __syncthreads();
  red[kg * 16 + hh] = acc;
  __syncthreads();
  if (tid < 16) {
    float s = 0.f;
    for (int g = 0; g < 16; ++g) s += red[g * 16 + tid];
    ((float*)(p.ws + OFF_B1EFF))[li * 256 + h0 + tid] = s + p.cmp_b1[li * 256 + h0 + tid];
  }
}

DI void rope_item(const Params& p, int item) {
  const int idx = item * 256 + tidx();
  const int tok = idx >> 3, i = idx & 7;
  const float invf[8] = {1.0f, 0.1939227432012558f, 0.03760603070259094f, 0.007292664609849453f,
                         0.0014142135623842478f, 0.00027424818836152554f, 5.318296098266728e-05f, 1.0313386155758053e-05f};
  float f = i == 0 ? invf[0] : i == 1 ? invf[1] : i == 2 ? invf[2] : i == 3 ? invf[3] : i == 4 ? invf[4] : i == 5 ? invf[5] : i == 6 ? invf[6] : invf[7];
  float ang = (float)p.pos[tok] * f;
  double rev = (double)ang * 0.15915494309189535;
  double fr = rev - floor(rev);
  float frf = (float)fr;
  float* rope = (float*)(p.ws + OFF_ROPE);
  rope[(size_t)tok * 16 + i] = __builtin_amdgcn_cosf(frf);
  rope[(size_t)tok * 16 + 8 + i] = __builtin_amdgcn_sinf(frf);
}

DI void transpose_item(const float* __restrict__ src, int K, int Nsrc, bf16_t* __restrict__ dst, int k0, int n0, int mapmode, char* smem) {
  float* tile = (float*)smem;
  const int tid = tidx();
  __syncthreads();
  float tv[16];
#pragma unroll
  for (int i = 0; i < 16; ++i) {
    int kk = i * 4 + (tid >> 6), nn = tid & 63;
    int nd = n0 + nn, ns = nd;
    if (mapmode == 1 || mapmode == 2) {
      const int rho = nd & 255;
      ns = (nd & ~255) + 64 * ((rho >> 5) & 3) + 32 * (rho >> 7) + (rho & 31);
    }
    if (mapmode == 1) ns = ns < 2560 ? ns : ns + 48;
    if (mapmode == 3) ns = nd < 48 ? 2560 + nd : -1;
    tv[i] = ns >= 0 ? __builtin_nontemporal_load(src + (size_t)(k0 + kk) * Nsrc + ns) : 0.f;
  }
#pragma unroll
  for (int i = 0; i < 16; ++i) {
    int kk = i * 4 + (tid >> 6), nn = tid & 63;
    tile[kk * 65 + nn] = tv[i];
  }
  __syncthreads();
#pragma unroll
  for (int i = 0; i < 16; ++i) {
    int nn = i * 4 + (tid >> 6), kk = tid & 63;
    float v = tile[kk * 65 + nn];
    unsigned u = pack_bf2(v, 0.f);
    dst[(size_t)(n0 + nn) * K + k0 + kk] = (bf16_t)(u & 0xffff);
  }
}

constexpr int NW_ADA = 768, NW_B1 = 64, NW_ROPE = 1024;
constexpr int NW_T_NSA_IN = 16 * 56, NW_T_SQ = 256, NW_T_MOBA_IN = 16 * 40, NW_T_CMP = 128, NW_T_GL = 16 * 2;
constexpr int NW_TRANS = 2 * NW_T_NSA_IN + 2 * NW_T_SQ + 2 * NW_T_MOBA_IN + 2 * NW_T_SQ + 4 * NW_T_CMP + 2 * NW_T_GL;
constexpr int NW_TOTAL = NW_ADA + NW_B1 + NW_ROPE + NW_TRANS;

DI void phaseW_item(const Params& p, int it, char* smem) {
  if (it < NW_ADA) { ada_item(p, it, smem); return; }
  it -= NW_ADA;
  if (it < NW_B1) { b1eff_item(p, it, smem); return; }
  it -= NW_B1;
  if (it < NW_ROPE) { rope_item(p, it); return; }
  it -= NW_ROPE;
  if (it < 2 * NW_T_NSA_IN) {
    int l = it / NW_T_NSA_IN, t = it % NW_T_NSA_IN;
    transpose_item(p.nsa_w_in + (size_t)l * 1024 * NSA_IN, 1024, NSA_IN, (bf16_t*)(p.ws + OFF_WT_NSA_IN) + (size_t)l * NSA_NP * 1024,
                   (t % 16) * 64, (t / 16) * 64, 1, smem);
    return;
  }
  it -= 2 * NW_T_NSA_IN;
  if (it < 2 * NW_T_SQ) {
    int l = it / NW_T_SQ, t = it % NW_T_SQ;
    transpose_item(p.nsa_w_out + (size_t)l * 1024 * 1024, 1024, 1024, (bf16_t*)(p.ws + OFF_WT_NSA_OUT) + (size_t)l * 1024 * 1024,
                   (t % 16) * 64, (t / 16) * 64, 2, smem);
    return;
  }
  it -= 2 * NW_T_SQ;
  if (it < 2 * NW_T_MOBA_IN) {
    int l = it / NW_T_MOBA_IN, t = it % NW_T_MOBA_IN;
    transpose_item(p.moba_w_in + (size_t)l * 1024 * MOBA_IN, 1024, MOBA_IN, (bf16_t*)(p.ws + OFF_WT_MOBA_IN) + (size_t)l * MOBA_IN * 1024,
                   (t % 16) * 64, (t / 16) * 64, 2, smem);
    return;
  }
  it -= 2 * NW_T_MOBA_IN;
  if (it < 2 * NW_T_SQ) {
    int l = it / NW_T_SQ, t = it % NW_T_SQ;
    transpose_item(p.moba_w_out + (size_t)l * 1024 * 1024, 1024, 1024, (bf16_t*)(p.ws + OFF_WT_MOBA_OUT) + (size_t)l * 1024 * 1024,
                   (t % 16) * 64, (t / 16) * 64, 2, smem);
    return;
  }
  it -= 2 * NW_T_SQ;
  if (it < 4 * NW_T_CMP) {
    int li = it / NW_T_CMP, t = it % NW_T_CMP;
    transpose_item(p.cmp_w1 + (size_t)li * 2048 * 256, 2048, 256, (bf16_t*)(p.ws + OFF_WT_CMP1) + (size_t)li * 256 * 2048,
                   (t % 32) * 64, (t / 32) * 64, 0, smem);
    return;
  }
  it -= 4 * NW_T_CMP;
  {
    int l = it / NW_T_GL, t = it % NW_T_GL;
    transpose_item(p.nsa_w_in + (size_t)l * 1024 * NSA_IN, 1024, NSA_IN, (bf16_t*)(p.ws + OFF_WT_GL) + (size_t)l * 128 * 1024,
                   (t % 16) * 64, (t / 16) * 64, 3, smem);
  }
}

DI void prep_item(const Params& p, int layer, const float* __restrict__ xin, int item) {
  const int lane = tidx() & 63, w = tidx() >> 6;
  const int tok0 = item * 16 + w * 4;
  const int b = tok0 >> 11;
  f32x4 v[4][4];
#pragma unroll
  for (int r = 0; r < 4; ++r)
#pragma unroll
    for (int i = 0; i < 4; ++i) v[r][i] = *(const f32x4*)(xin + (size_t)(tok0 + r) * 1024 + (lane + i * 64) * 4);
  const float* mod = (const float*)(p.ws + OFF_MOD) + (size_t)(layer * 16 + b) * 3072;
  f32x4 gs[4], sh[4];
#pragma unroll
  for (int i = 0; i < 4; ++i) {
    const int c = (lane + i * 64) * 4;
    const f32x4 g = *(const f32x4*)(p.norm_g + layer * 1024 + c);
    const f32x4 sc = *(const f32x4*)(mod + 1024 + c);
    sh[i] = *(const f32x4*)(mod + c);
    gs[i] = g * (sc + 1.f);
  }
#pragma unroll
  for (int r = 0; r < 4; ++r) {
    float ss = 0.f;
#pragma unroll
    for (int i = 0; i < 4; ++i) ss += v[r][i][0] * v[r][i][0] + v[r][i][1] * v[r][i][1] + v[r][i][2] * v[r][i][2] + v[r][i][3] * v[r][i][3];
#pragma unroll
    for (int o = 32; o >= 1; o >>= 1) ss += __shfl_xor(ss, o);
    const float rstd = __builtin_amdgcn_rsqf(ss * (1.f / 1024.f) + EPS);
    bf16_t* hr = (bf16_t*)(p.ws + OFF_H) + (size_t)(tok0 + r) * 1024;
#pragma unroll
    for (int i = 0; i < 4; ++i) {
      const f32x4 a = v[r][i] * rstd * gs[i] + sh[i];
      u32x2 o;
      o.x = pack_bf2(a[0], a[1]);
      o.y = pack_bf2(a[2], a[3]);
      *(u32x2*)(hr + (lane + i * 64) * 4) = o;
    }
  }
}

template <bool SWAP>
DI void gemm_mainloop(const bf16_t* __restrict__ A, const unsigned (&aoff)[4], int a_kstride, const bf16_t* __restrict__ Bt, int K, int n0,
                      char* smem, f32x4 (&acc)[4][4], int ldb = 0) {
  if (ldb == 0) ldb = K;
  bf16_t* sA = (bf16_t*)smem;
  bf16_t* sB = (bf16_t*)(smem + 36864);
  const int tid = tidx(), lane = tid & 63, w = tid >> 6;
  const int wm = w >> 1, wn = w & 1, c16 = lane & 15, lg = lane >> 4;
  const int r0 = tid >> 3, c8 = tid & 7;
  const int nk = K >> 6;
  u32x4 ra[4], rb[4];
  const bf16_t* bbase = Bt + (size_t)(n0 + r0) * ldb + c8 * 8;
#pragma unroll
  for (int i = 0; i < 4; ++i) {
    ra[i] = *(const u32x4*)(A + aoff[i] + c8 * 8);
    rb[i] = *(const u32x4*)(bbase + (size_t)i * 32 * ldb);
  }
#pragma unroll
  for (int a = 0; a < 4; ++a)
#pragma unroll
    for (int b = 0; b < 4; ++b) acc[a][b] = f32x4{0.f, 0.f, 0.f, 0.f};
  __syncthreads();
  for (int kt = 0; kt < nk; ++kt) {
    const int buf = kt & 1;
    bf16_t* cA = sA + buf * (128 * 72);
    bf16_t* cB = sB + buf * (128 * 72);
#pragma unroll
    for (int i = 0; i < 4; ++i) {
      *(u32x4*)(cA + (r0 + 32 * i) * 72 + c8 * 8) = ra[i];
      *(u32x4*)(cB + (r0 + 32 * i) * 72 + c8 * 8) = rb[i];
    }
    lds_barrier();
    if (kt + 1 < nk) {
#pragma unroll
      for (int i = 0; i < 4; ++i) {
        ra[i] = *(const u32x4*)(A + aoff[i] + (size_t)(kt + 1) * a_kstride + c8 * 8);
        rb[i] = *(const u32x4*)(bbase + (size_t)i * 32 * ldb + (kt + 1) * 64);
      }
    }
#pragma unroll
    for (int ks = 0; ks < 2; ++ks) {
      bf16x8 af[4], bfr[4];
#pragma unroll
      for (int mt = 0; mt < 4; ++mt) af[mt] = *(const bf16x8*)(cA + (wm * 64 + mt * 16 + c16) * 72 + ks * 32 + lg * 8);
#pragma unroll
      for (int nt = 0; nt < 4; ++nt) bfr[nt] = *(const bf16x8*)(cB + (wn * 64 + nt * 16 + c16) * 72 + ks * 32 + lg * 8);
#pragma unroll
      for (int mt = 0; mt < 4; ++mt)
#pragma unroll
        for (int nt = 0; nt < 4; ++nt) {
          if (SWAP) acc[nt][mt] = mfma16(bfr[nt], af[mt], acc[nt][mt]);
          else acc[mt][nt] = mfma16(af[mt], bfr[nt], acc[mt][nt]);
        }
    }
  }
}

DI void epi_normrope(f32x4 (&acc)[4][4], int m_base  , int ncol_base  ,
                     bf16_t* __restrict__ dst, int ld, const float* __restrict__ gw, const float* __restrict__ rope, float oscale) {
  const int lane = tidx() & 63, c16 = lane & 15, lg = lane >> 4;
  float gwv[4][4];
#pragma unroll
  for (int nt = 0; nt < 4; ++nt)
#pragma unroll
    for (int j = 0; j < 4; ++j) gwv[nt][j] = gw[nt * 16 + lg * 4 + j];
#pragma unroll
  for (int mt = 0; mt < 4; ++mt) {
    const int m = m_base + mt * 16 + c16;
    float ss = 0.f;
#pragma unroll
    for (int nt = 0; nt < 4; ++nt)
#pragma unroll
      for (int j = 0; j < 4; ++j) ss += acc[nt][mt][j] * acc[nt][mt][j];
    ss += __shfl_xor(ss, 16);
    ss += __shfl_xor(ss, 32);
    const float rstd = __builtin_amdgcn_rsqf(ss * (1.f / 64.f) + EPS);
    float v[4][4];
#pragma unroll
    for (int nt = 0; nt < 4; ++nt)
#pragma unroll
      for (int j = 0; j < 4; ++j) v[nt][j] = acc[nt][mt][j] * rstd * gwv[nt][j];
    const float4 cs = *(const float4*)(rope + (size_t)m * 16 + (lg & 1) * 4);
    const float4 sn = *(const float4*)(rope + (size_t)m * 16 + 8 + (lg & 1) * 4);
    const float csv[4] = {cs.x, cs.y, cs.z, cs.w};
    const float snv[4] = {sn.x, sn.y, sn.z, sn.w};
#pragma unroll
    for (int j = 0; j < 4; ++j) {
      float mine = v[0][j];
      float other = __shfl_xor(mine, 32);
      float r = (lg < 2) ? (mine * csv[j] - other * snv[j]) : (mine * csv[j] + other * snv[j]);
      v[0][j] = r;
    }
#pragma unroll
    for (int nt = 0; nt < 4; ++nt) {
      u32x2 o;
      o.x = pack_bf2(v[nt][0] * oscale, v[nt][1] * oscale);
      o.y = pack_bf2(v[nt][2] * oscale, v[nt][3] * oscale);
      *(u32x2*)(dst + (size_t)m * ld + ncol_base + nt * 16 + lg * 4) = o;
    }
  }
}

template <int MODE>
DI void epi_store_bf16(f32x4 (&acc)[4][4], int m_base, int ncol_base, bf16_t* __restrict__ dst, int ld, const float* __restrict__ bias) {
  const int lane = tidx() & 63, c16 = lane & 15, lg = lane >> 4;
#pragma unroll
  for (int mt = 0; mt < 4; ++mt) {
    const int m = m_base + mt * 16 + c16;
#pragma unroll
    for (int nt = 0; nt < 4; ++nt) {
      float v[4];
#pragma unroll
      for (int j = 0; j < 4; ++j) {
        float a = acc[nt][mt][j];
        if (MODE == 1) a = siluf_(a);
        if (MODE == 2) a = geluf_(a + bias[ncol_base + nt * 16 + lg * 4 + j]);
        v[j] = a;
      }
      u32x2 o;
      o.x = pack_bf2(v[0], v[1]);
      o.y = pack_bf2(v[2], v[3]);
      *(u32x2*)(dst + (size_t)m * ld + ncol_base + nt * 16 + lg * 4) = o;
    }
  }
}

DI void epi_store_vt(f32x4 (&acc)[4][4], int m_base, int col_base, bf16_t* __restrict__ vt) {
  const int lane = tidx() & 63, c16 = lane & 15, lg = lane >> 4;
#pragma unroll
  for (int mt = 0; mt < 4; ++mt) {
    const int m = m_base + mt * 16 + lg * 4;
    const int b = m >> 11, s = m & 2047;
#pragma unroll
    for (int nt = 0; nt < 4; ++nt) {
      const int col = col_base + nt * 16 + c16;
      const int gh = col >> 6, d = col & 63;
      u32x2 o;
      o.x = pack_bf2(acc[mt][nt][0], acc[mt][nt][1]);
      o.y = pack_bf2(acc[mt][nt][2], acc[mt][nt][3]);
      *(u32x2*)(vt + ((size_t)((b * 4 + gh) * 64 + d)) * 2048 + s) = o;
    }
  }
}

#ifndef PROBE_T
#define PROBE_T -1
#endif
namespace g8 {
constexpr int BM = 256, BK = 64, HALF = 128, HTB = HALF * BK * 2, NXCD = 8, WGM = 8;
DI int lds_byte(int r, int c) { const int st = (r >> 4) * 2 + (c >> 5), rr = r & 15, cc = c & 31, ob = rr * 64 + cc * 2; return st * 1024 + (ob ^ (((ob >> 9) & 1) << 5)); }
DI void stage_rc(int b, int& R, int& C) { const int st = b / 1024, sb = b % 1024, swz = sb ^ (((sb >> 9) & 1) << 5); R = (st >> 1) * 16 + swz / 64; C = (st & 1) * 32 + (swz % 64) / 2; }
struct Unit { int pm, pn; };
struct StaticOrder {
  int nM, nN, nwg, G, c;
  DI void init(int M, int N, int G_, int c_) { nM = M / BM; nN = N / BM; nwg = nM * nN; G = G_; c = c_; }
  DI bool next(int i, Unit& u) const {
    const long L = (long)i * G + c; if (L >= nwg) return false;
    int wgid = (int)L; { const int q = nwg / NXCD, r = nwg % NXCD, xcd = wgid % NXCD, off = wgid / NXCD; wgid = (xcd < r ? xcd * (q + 1) : r * (q + 1) + (xcd - r) * q) + off; }
    const int nig = WGM * nN, gid = wgid / nig, fm = gid * WGM, gsz = (nM - fm) < WGM ? (nM - fm) : WGM;
    u.pm = fm + ((wgid % nig) % gsz); u.pn = (wgid % nig) / gsz; return true;
  }
};
template <class Epi>
DI void gemm_phase(LAS unsigned char* lds, const bf16_t* gA, const bf16_t* gBt, int K, const StaticOrder& S, const Epi& E, unsigned long long& eticks) {
  int tid = __builtin_amdgcn_workitem_id_x();
  asm volatile("" : "+v"(tid));
  const int wid = __builtin_amdgcn_readfirstlane(tid >> 6), lane = tid & 63, wr = wid >> 2, wc = wid & 3, fr = lane & 15, fq = lane >> 4;
  const int nt = K / BK;
  unsigned voffA[2], voffB[2];
#pragma unroll
  for (int i = 0; i < 2; ++i) { int R, C; stage_rc(tid * 16 + i * 8192, R, C); voffA[i] = (unsigned)(R * K + C) * 2u; voffB[i] = voffA[i]; }
  const size_t kstep = (size_t)(BK * 2);
  const size_t hstep = (size_t)HALF * K * 2;
  const size_t tstep = 2 * hstep;
  const unsigned ldsw = (unsigned)wid * 1024u;
  const int aoff = lds_byte(wr * 64 + fr, fq * 8), boff = lds_byte(wc * 32 + fr, fq * 8);
#define G8_SA(b, h) (((b) * 2 + (h)) * HTB)
#define G8_SB(b, h) ((4 + (b) * 2 + (h)) * HTB)
#define G8_STAGE(bufoff, gbase, voff) do { _Pragma("unroll") for (int _i = 0; _i < 2; ++_i) \
    __builtin_amdgcn_global_load_lds((const unsigned*)((const char*)(gbase) + (voff)[_i]), (LAS unsigned*)(lds + (bufoff) + ldsw + _i * 8192), 16, 0, 0); } while (0)
#define G8_LDA(dst, b, h) do { _Pragma("unroll") for (int m = 0; m < 4; ++m) _Pragma("unroll") for (int k = 0; k < 2; ++k) dst[m][k] = *(const LAS bf16x8*)(lds + G8_SA(b, h) + aoff + m * 2048 + k * 1024); } while (0)
#define G8_LDB(dst, b, h) do { _Pragma("unroll") for (int n = 0; n < 2; ++n) _Pragma("unroll") for (int k = 0; k < 2; ++k) dst[n][k] = *(const LAS bf16x8*)(lds + G8_SB(b, h) + boff + n * 2048 + k * 1024); } while (0)
#define G8_MMA(ai, bj, At, Bt) do { __builtin_amdgcn_s_setprio(1); _Pragma("unroll") for (int m = 0; m < 4; ++m) _Pragma("unroll") for (int n = 0; n < 2; ++n) _Pragma("unroll") for (int k = 0; k < 2; ++k) \
    acc[ai][bj][m][n] = __builtin_amdgcn_mfma_f32_16x16x32_bf16(Bt[n][k], At[m][k], acc[ai][bj][m][n], 0, 0, 0); __builtin_amdgcn_s_setprio(0); } while (0)
#define G8_WAIT_V(n) asm volatile("s_waitcnt vmcnt(" #n ")" ::: "memory")
#define G8_WAIT_L(n) asm volatile("s_waitcnt lgkmcnt(" #n ")" ::: "memory")
#define G8_BAR __builtin_amdgcn_s_barrier()
#define G8_SCHED __builtin_amdgcn_sched_barrier(0)
  Unit cur, nxt; int ui = 0;
  if (!S.next(0, cur)) return;
  f32x4 acc[2][2][4][2];
#pragma unroll
  for (int a = 0; a < 2; ++a)
#pragma unroll
    for (int b = 0; b < 2; ++b)
#pragma unroll
      for (int m = 0; m < 4; ++m)
#pragma unroll
        for (int n = 0; n < 2; ++n) acc[a][b][m][n] = (f32x4){0.f, 0.f, 0.f, 0.f};
  bf16x8 At[4][2], B0[2][2], B1[2][2];
  const char* cA = (const char*)gA + (size_t)cur.pm * tstep; const char* cB = (const char*)gBt + (size_t)cur.pn * tstep;
  G8_STAGE(G8_SB(0, 0), cB, voffB); G8_STAGE(G8_SA(0, 0), cA, voffA); G8_STAGE(G8_SB(0, 1), cB + hstep, voffB); G8_STAGE(G8_SA(0, 1), cA + hstep, voffA);
  if (wr == 1) G8_BAR;
  G8_WAIT_V(4); G8_BAR;
  G8_STAGE(G8_SB(1, 0), cB + kstep, voffB); G8_STAGE(G8_SA(1, 0), cA + kstep, voffA); G8_STAGE(G8_SB(1, 1), cB + hstep + kstep, voffB);
  G8_WAIT_V(6); G8_BAR;
  for (;;) {
    const bool has_next = S.next(ui + 1, nxt);
    const char* nA = has_next ? (const char*)gA + (size_t)nxt.pm * tstep : cA; const char* nB = has_next ? (const char*)gBt + (size_t)nxt.pn * tstep : cB;
    for (int t = 0; t < nt; t += 2) {
      const bool last = (t == nt - 2);
      const char* a1 = cA + (size_t)(t + 1) * kstep;
      const char* a2 = last ? nA : cA + (size_t)(t + 2) * kstep; const char* b2 = last ? nB : cB + (size_t)(t + 2) * kstep;
      const char* a3 = a2 + kstep; const char* b3 = b2 + kstep;
      G8_LDB(B0, 0, 0); G8_SCHED; G8_LDA(At, 0, 0); G8_STAGE(G8_SA(1, 1), a1 + hstep, voffA);
      G8_WAIT_L(8); G8_BAR; G8_WAIT_L(0); G8_MMA(0, 0, At, B0); G8_BAR; G8_SCHED;
      G8_LDB(B1, 0, 1); G8_STAGE(G8_SB(0, 0), b2, voffB);
      G8_BAR; G8_WAIT_L(0); G8_MMA(0, 1, At, B1); G8_BAR;
      G8_LDA(At, 0, 1); G8_STAGE(G8_SA(0, 0), a2, voffA);
      G8_BAR; G8_WAIT_L(0); G8_MMA(1, 0, At, B0); G8_BAR; G8_SCHED;
      G8_STAGE(G8_SB(0, 1), b2 + hstep, voffB);
      G8_WAIT_V(6); G8_BAR; G8_MMA(1, 1, At, B1); G8_BAR;
      G8_LDB(B0, 1, 0); G8_SCHED; G8_LDA(At, 1, 0); G8_STAGE(G8_SA(0, 1), a2 + hstep, voffA);
      G8_WAIT_L(8); G8_BAR; G8_WAIT_L(0); G8_MMA(0, 0, At, B0); G8_BAR; G8_SCHED;
      G8_LDB(B1, 1, 1); G8_STAGE(G8_SB(1, 0), b3, voffB);
      G8_BAR; G8_WAIT_L(0); G8_MMA(0, 1, At, B1); G8_BAR;
      G8_LDA(At, 1, 1); G8_STAGE(G8_SA(1, 0), a3, voffA);
      G8_BAR; G8_WAIT_L(0); G8_MMA(1, 0, At, B0); G8_BAR; G8_SCHED;
      G8_STAGE(G8_SB(1, 1), b3 + hstep, voffB);
      G8_WAIT_V(6); G8_BAR; G8_MMA(1, 1, At, B1); G8_BAR;
    }
    if (PROBE_T == 8 || PROBE_T == 9) {
      const unsigned long long _t0 = wall_clock64();
      E(acc, cur, wr, wc, fr, fq);
      if (PROBE_T == 9) asm volatile("s_waitcnt vmcnt(0)" ::: "memory");
      eticks += wall_clock64() - _t0;
    } else {
      E(acc, cur, wr, wc, fr, fq);
    }
    if (!has_next) break;
#pragma unroll
    for (int a = 0; a < 2; ++a)
#pragma unroll
      for (int b = 0; b < 2; ++b)
#pragma unroll
        for (int m = 0; m < 4; ++m)
#pragma unroll
          for (int n = 0; n < 2; ++n) acc[a][b][m][n] = (f32x4){0.f, 0.f, 0.f, 0.f};
    cur = nxt; cA = nA; cB = nB; ++ui;
  }
  G8_WAIT_V(0);
  if (wr == 0) G8_BAR;
  G8_BAR;
#undef G8_SA
#undef G8_SB
#undef G8_STAGE
#undef G8_LDA
#undef G8_LDB
#undef G8_MMA
#undef G8_WAIT_V
#undef G8_WAIT_L
#undef G8_BAR
#undef G8_SCHED
}
}

typedef const f32x4 (&Acc8)[2][2][4][2];
DI void epi8_normrope(Acc8 acc, int row0, int colbase, bf16_t* __restrict__ dst, int ld, const float* __restrict__ gw, const float* __restrict__ rope,
                      float oscale, int fq) {
  float gwv[2][2][4];
#pragma unroll
  for (int bj = 0; bj < 2; ++bj)
#pragma unroll
    for (int n = 0; n < 2; ++n)
#pragma unroll
      for (int j = 0; j < 4; ++j) gwv[bj][n][j] = gw[32 * bj + 16 * n + 4 * fq + j];
#pragma unroll
  for (int am = 0; am < 4; ++am) {
    const int ai = am >> 1;
    f32x4 csv[2], snv[2];
#pragma unroll
    for (int mm = 0; mm < 2; ++mm) {
      const int r = row0 + 128 * ai + 16 * ((am & 1) * 2 + mm);
      csv[mm] = *(const f32x4*)(rope + (size_t)r * 16 + (fq & 1) * 4);
      snv[mm] = *(const f32x4*)(rope + (size_t)r * 16 + 8 + (fq & 1) * 4);
    }
#pragma unroll
    for (int mm = 0; mm < 2; ++mm) {
      const int m = (am & 1) * 2 + mm;
      const int r = row0 + 128 * ai + 16 * m;
      float ss = 0.f;
#pragma unroll
      for (int bj = 0; bj < 2; ++bj)
#pragma unroll
        for (int n = 0; n < 2; ++n)
#pragma unroll
          for (int j = 0; j < 4; ++j) ss += acc[ai][bj][m][n][j] * acc[ai][bj][m][n][j];
      ss += __shfl_xor(ss, 16);
      ss += __shfl_xor(ss, 32);
      const float rstd = __builtin_amdgcn_rsqf(ss * (1.f / 64.f) + EPS);
      float v[2][2][4];
#pragma unroll
      for (int bj = 0; bj < 2; ++bj)
#pragma unroll
        for (int n = 0; n < 2; ++n)
#pragma unroll
          for (int j = 0; j < 4; ++j) v[bj][n][j] = acc[ai][bj][m][n][j] * rstd * gwv[bj][n][j];
      const f32x4 cs = csv[mm], sn = snv[mm];
#pragma unroll
      for (int j = 0; j < 4; ++j) {
        const float mine = v[0][0][j];
        const float other = __shfl_xor(mine, 32);
        v[0][0][j] = (fq < 2) ? (mine * cs[j] - other * sn[j]) : (mine * cs[j] + other * sn[j]);
      }
#pragma unroll
      for (int bj = 0; bj < 2; ++bj)
#pragma unroll
        for (int n = 0; n < 2; ++n) {
          u32x2 o;
          o.x = pack_bf2(v[bj][n][0] * oscale, v[bj][n][1] * oscale);
          o.y = pack_bf2(v[bj][n][2] * oscale, v[bj][n][3] * oscale);
          *(u32x2*)(dst + (size_t)r * ld + colbase + 32 * bj + 16 * n + 4 * fq) = o;
        }
    }
  }
}
template <int MODE>
DI void epi8_store_bf16(Acc8 acc, int row0, int colbase, bf16_t* __restrict__ dst, int ld, int fq) {
#pragma unroll
  for (int ai = 0; ai < 2; ++ai)
#pragma unroll
    for (int m = 0; m < 4; ++m) {
      const int r = row0 + 128 * ai + 16 * m;
#pragma unroll
      for (int bj = 0; bj < 2; ++bj)
#pragma unroll
        for (int n = 0; n < 2; ++n) {
          float v[4];
#pragma unroll
          for (int j = 0; j < 4; ++j) { float a = acc[ai][bj][m][n][j]; if (MODE == 1) a = siluf_(a); v[j] = a; }
          u32x2 o;
          o.x = pack_bf2(v[0], v[1]);
          o.y = pack_bf2(v[2], v[3]);
          *(u32x2*)(dst + (size_t)r * ld + colbase + 32 * bj + 16 * n + 4 * fq) = o;
        }
    }
}
DI void epi8_store_vt(Acc8 acc, int row0, int gh, bf16_t* __restrict__ vt, int fr, int fq) {
  const int q = fr & 3;
  const bool odd = (q & 1) != 0, upper = q >= 2;
  const int dsel = 2 * (q & 1) + (q >> 1);
#pragma unroll
  for (int ai = 0; ai < 2; ++ai)
#pragma unroll
    for (int m = 0; m < 4; ++m) {
      const int r = row0 + 128 * ai + 16 * m;
      const int b = r >> 11, sb = (r & 2047) - q;
#pragma unroll
      for (int bj = 0; bj < 2; ++bj)
#pragma unroll
        for (int n = 0; n < 2; ++n) {
          const float v0 = acc[ai][bj][m][n][0], v1 = acc[ai][bj][m][n][1], v2 = acc[ai][bj][m][n][2], v3 = acc[ai][bj][m][n][3];
          const float s0 = odd ? v0 : v2, s1 = odd ? v1 : v3;
          const float r0 = qxor1(s0), r1 = qxor1(s1);
          const float w0 = odd ? r0 : v0, w1 = odd ? r1 : v1, w2 = odd ? v2 : r0, w3 = odd ? v3 : r1;
          const float t0 = upper ? w0 : w1, t1 = upper ? w2 : w3;
          const float x0 = qxor2(t0), x1 = qxor2(t1);
          const float o0 = upper ? x0 : w0, o1 = upper ? x1 : w2, o2 = upper ? w1 : x0, o3 = upper ? w3 : x1;
          const int d = 32 * bj + 16 * n + 4 * fq + dsel;
          u32x2 o;
          o.x = pack_bf2(o0, o1);
          o.y = pack_bf2(o2, o3);
          *(u32x2*)(vt + ((size_t)((b * 4 + gh) * 64 + d)) * 2048 + sb) = o;
        }
    }
}

struct InProjEpi {
  Params p; int layer;
  DI void operator()(Acc8 acc, const g8::Unit& u, int wr, int wc, int fr, int fq) const {
    const bool nsa = (layer & 1) == 0;
    const int lj = layer >> 1;
    const int pn = u.pn;
    const int row0 = u.pm * 256 + wr * 64 + fr;
    const float* rope = (const float*)(p.ws + OFF_ROPE);
    if (pn < 4) {
      epi8_normrope(acc, row0, pn * 256 + wc * 64, (bf16_t*)(p.ws + OFF_Q), 1024, (nsa ? p.nsa_qn : p.moba_qn) + lj * 64, rope, QSCALE, fq);
    } else if (nsa) {
      if (pn == 4) epi8_store_bf16<0>(acc, row0, wc * 64, (bf16_t*)(p.ws + OFF_KC), 256, fq);
      else if (pn == 5) epi8_store_bf16<0>(acc, row0, wc * 64, (bf16_t*)(p.ws + OFF_VC), 256, fq);
      else if (pn == 6) epi8_normrope(acc, row0, wc * 64, (bf16_t*)(p.ws + OFF_KS), 256, p.nsa_kn + (lj * 3 + 1) * 64, rope, 1.0f, fq);
      else if (pn == 7) epi8_store_vt(acc, row0, wc, (bf16_t*)(p.ws + OFF_VST), fr, fq);
      else if (pn == 8) epi8_normrope(acc, row0, wc * 64, (bf16_t*)(p.ws + OFF_KW), 256, p.nsa_kn + (lj * 3 + 2) * 64, rope, 1.0f, fq);
      else if (pn == 9) epi8_store_vt(acc, row0, wc, (bf16_t*)(p.ws + OFF_VWT), fr, fq);
      else epi8_store_bf16<1>(acc, row0, (pn - 10) * 256 + wc * 64, (bf16_t*)(p.ws + OFF_SZ), 1024, fq);
    } else {
      if (pn == 4) epi8_normrope(acc, row0, wc * 64, (bf16_t*)(p.ws + OFF_KS), 256, p.moba_kn + lj * 64, rope, 1.0f, fq);
      else if (pn == 5) epi8_store_vt(acc, row0, wc, (bf16_t*)(p.ws + OFF_VST), fr, fq);
      else epi8_store_bf16<1>(acc, row0, (pn - 6) * 256 + wc * 64, (bf16_t*)(p.ws + OFF_SZ), 1024, fq);
    }
  }
};
struct OutProjEpi {
  Params p; int layer; const float* xin;
  DI void operator()(Acc8 acc, const g8::Unit& u, int wr, int wc, int fr, int fq) const {
    const int row0 = u.pm * 256 + wr * 64 + fr;
    const int b = (u.pm * 256) >> 11;
    const float* gatev = (const float*)(p.ws + OFF_MOD) + (size_t)(layer * 16 + b) * 3072 + 2048;
#pragma unroll
    for (int bj = 0; bj < 2; ++bj)
#pragma unroll
      for (int n = 0; n < 2; ++n) {
        const int c = u.pn * 256 + wc * 64 + 32 * bj + 16 * n + 4 * fq;
        const f32x4 gv = *(const f32x4*)(gatev + c);
        f32x4 xv[2][4];
#pragma unroll
        for (int ai = 0; ai < 2; ++ai)
#pragma unroll
          for (int m = 0; m < 4; ++m) xv[ai][m] = *(const f32x4*)(xin + (size_t)(row0 + 128 * ai + 16 * m) * 1024 + c);
#pragma unroll
        for (int ai = 0; ai < 2; ++ai)
#pragma unroll
          for (int m = 0; m < 4; ++m) *(f32x4*)(p.out + (size_t)(row0 + 128 * ai + 16 * m) * 1024 + c) = xv[ai][m] + gv * acc[ai][bj][m][n];
      }
  }
};

DI void gates_tile(const Params& p, int lj, int item, char* smem) {
  const int tile = item >> 1, kh = item & 1;
  const int m0 = tile * 128;
  const int tid = tidx(), lane = tid & 63, w = tid >> 6, wm = w >> 1, wn = w & 1, c16 = lane & 15, lg = lane >> 4;
  const bf16_t* A = (const bf16_t*)(p.ws + OFF_H);
  const bf16_t* Bt = (const bf16_t*)(p.ws + OFF_WT_GL) + (size_t)lj * 128 * 1024 + kh * 512;
  unsigned aoff[4];
#pragma unroll
  for (int i = 0; i < 4; ++i) aoff[i] = (unsigned)(m0 + (tid >> 3) + 32 * i) * 1024u + kh * 512u;
  f32x4 acc[4][4];
  gemm_mainloop<true>(A, aoff, 64, Bt, 512, 0, smem, acc, 1024);
  __syncthreads();
  f32x4* red = (f32x4*)(kh ? smem : smem + SMEM_BYTES) + tid;
  if (kh == 1) {
#pragma unroll
    for (int a = 0; a < 3; ++a)
#pragma unroll
      for (int b = 0; b < 4; ++b) red[(a * 4 + b) * 256] = acc[a][b];
  }
  __syncthreads();
  if (kh == 1) return;
#pragma unroll
  for (int a = 0; a < 3; ++a)
#pragma unroll
    for (int b = 0; b < 4; ++b) acc[a][b] += red[(a * 4 + b) * 256];
  float* gates = (float*)(p.ws + OFF_GATES);
  const float* gb = p.gate_b + lj * 48;
  f32x4 gbv[3];
#pragma unroll
  for (int nt = 0; nt < 3; ++nt) gbv[nt] = *(const f32x4*)(gb + nt * 16 + lg * 4);
  if (wn == 0) {
#pragma unroll
    for (int mt = 0; mt < 4; ++mt) {
      const int m = m0 + wm * 64 + mt * 16 + c16;
#pragma unroll
      for (int nt = 0; nt < 3; ++nt) {
        const int nl = nt * 16 + lg * 4;
        f32x4 o;
        o[0] = sigmoidf_(acc[nt][mt][0] + gbv[nt][0]);
        o[1] = sigmoidf_(acc[nt][mt][1] + gbv[nt][1]);
        o[2] = sigmoidf_(acc[nt][mt][2] + gbv[nt][2]);
        o[3] = sigmoidf_(acc[nt][mt][3] + gbv[nt][3]);
        *(f32x4*)(gates + (size_t)m * 48 + nl) = o;
      }
    }
  }
}

DI void cmp1_tile(const Params& p, int lj, int item, char* smem) {
  const int tile = item >> 1, kh = item & 1;
  const int i = tile >> 7, t = tile & 127;
  const int mtile = t >> 1, ntile = t & 1;
  const int m0 = mtile * 128, n0 = ntile * 128;
  const int tid = tidx(), w = tid >> 6, wm = w >> 1, wn = w & 1;
  const bf16_t* A = (const bf16_t*)(p.ws + (i == 0 ? OFF_KC : OFF_VC));
  const bf16_t* Bt = (const bf16_t*)(p.ws + OFF_WT_CMP1) + (size_t)(lj * 2 + i) * 256 * 2048 + kh * 1024;
  unsigned aoff[4];
#pragma unroll
  for (int q = 0; q < 4; ++q) {
    int m = m0 + (tid >> 3) + 32 * q;
    int g = m & 3, n = (m >> 2) & 127, b = m >> 9;
    if (n > 126) n = 126;
    aoff[q] = (unsigned)((b * 2048 + 16 * n + 16 * kh) * 256 + g * 64);
  }
  f32x4 acc[4][4];
  gemm_mainloop<true>(A, aoff, 256, Bt, 1024, n0, smem, acc, 2048);
  __syncthreads();
  f32x4* red = (f32x4*)(kh ? smem : smem + SMEM_BYTES) + tid;
  if (kh == 1) {
#pragma unroll
    for (int a = 0; a < 4; ++a)
#pragma unroll
      for (int b = 0; b < 4; ++b) red[(a * 4 + b) * 256] = acc[a][b];
  }
  __syncthreads();
  if (kh == 0) {
#pragma unroll
    for (int a = 0; a < 4; ++a)
#pragma unroll
      for (int b = 0; b < 4; ++b) acc[a][b] += red[(a * 4 + b) * 256];
    bf16_t* hid = (bf16_t*)(p.ws + OFF_HID) + (size_t)i * 8192 * 256;
    const float* b1 = (const float*)(p.ws + OFF_B1EFF) + (lj * 2 + i) * 256;
    epi_store_bf16<2>(acc, m0 + wm * 64, n0 + wn * 64, hid, 256, b1);
  }
}

DI void cmp2_item(const Params& p, int lj, int item, char* smem) {
  const int tid = tidx();
  const int tile = item >> 1, kh = item & 1;
  const int i = tile >> 7, rt = tile & 127;
  float* w2s = (float*)smem;
  const float* W2 = p.cmp_w2 + (size_t)(lj * 2 + i) * 256 * 64 + (size_t)kh * 128 * 64;
  const int row = tid >> 2, cq = tid & 3;
  const int m = rt * 64 + row;
  const bf16_t* hid = (const bf16_t*)(p.ws + OFF_HID) + ((size_t)i * 8192 + m) * 256 + kh * 128;
  u32x4 hvv[16];
#pragma unroll
  for (int k8 = 0; k8 < 16; ++k8) hvv[k8] = *(const u32x4*)(hid + k8 * 8);
  __syncthreads();
  for (int q = tid; q < 128 * 64 / 4; q += 256) ((float4*)w2s)[q] = ((const float4*)W2)[q];
  __syncthreads();
  float acc[16];
#pragma unroll
  for (int d = 0; d < 16; ++d) acc[d] = 0.f;
#pragma unroll
  for (int k8 = 0; k8 < 16; ++k8) {
    const u32x4 hv = hvv[k8];
    float hf[8] = {bflo(hv.x), bfhi(hv.x), bflo(hv.y), bfhi(hv.y), bflo(hv.z), bfhi(hv.z), bflo(hv.w), bfhi(hv.w)};
#pragma unroll
    for (int kk = 0; kk < 8; ++kk) {
      const float4* wr = (const float4*)(w2s + (k8 * 8 + kk) * 64 + cq * 16);
      float4 w0 = wr[0], w1 = wr[1], w2 = wr[2], w3 = wr[3];
      float h = hf[kk];
      acc[0] += h * w0.x; acc[1] += h * w0.y; acc[2] += h * w0.z; acc[3] += h * w0.w;
      acc[4] += h * w1.x; acc[5] += h * w1.y; acc[6] += h * w1.z; acc[7] += h * w1.w;
      acc[8] += h * w2.x; acc[9] += h * w2.y; acc[10] += h * w2.z; acc[11] += h * w2.w;
      acc[12] += h * w3.x; acc[13] += h * w3.y; acc[14] += h * w3.z; acc[15] += h * w3.w;
    }
  }
  {
    f32x4* red = (f32x4*)((kh ? smem : smem + SMEM_BYTES) + 32768) + tid;
    if (kh == 1) {
#pragma unroll
      for (int q = 0; q < 4; ++q) red[q * 256] = f32x4{acc[4 * q], acc[4 * q + 1], acc[4 * q + 2], acc[4 * q + 3]};
    }
    __syncthreads();
    if (kh == 1) return;
#pragma unroll
    for (int q = 0; q < 4; ++q) {
      const f32x4 r = red[q * 256];
      acc[4 * q] += r[0]; acc[4 * q + 1] += r[1]; acc[4 * q + 2] += r[2]; acc[4 * q + 3] += r[3];
    }
  }
  const int g = m & 3, n = (m >> 2) & 127, b = m >> 9;
  const bool valid = n < 127;
  if (i == 0) {
    float ss = 0.f;
#pragma unroll
    for (int d = 0; d < 16; ++d) ss += acc[d] * acc[d];
    ss += __shfl_xor(ss, 1);
    ss += __shfl_xor(ss, 2);
    const float rstd = __builtin_amdgcn_rsqf(ss * (1.f / 64.f) + EPS);
    const float* gw = p.nsa_kn + (lj * 3 + 0) * 64 + cq * 16;
#pragma unroll
    for (int d = 0; d < 16; ++d) acc[d] = acc[d] * rstd * gw[d];
    if (cq == 0) {
      const int tokc = b * 2048 + (valid ? 16 * n + 31 : 2047);
      const float* rp = (const float*)(p.ws + OFF_ROPE) + (size_t)tokc * 16;
#pragma unroll
      for (int d = 0; d < 8; ++d) {
        float c = rp[d], s = rp[8 + d];
        float x1 = acc[d], x2 = acc[d + 8];
        acc[d] = x1 * c - x2 * s;
        acc[d + 8] = x2 * c + x1 * s;
      }
    }
    bf16_t* dst = (bf16_t*)(p.ws + OFF_KCMP) + ((size_t)((b * 4 + g) * 128 + n)) * 64 + cq * 16;
    u32x4 o0, o1;
    if (valid) {
      o0.x = pack_bf2(acc[0], acc[1]); o0.y = pack_bf2(acc[2], acc[3]); o0.z = pack_bf2(acc[4], acc[5]); o0.w = pack_bf2(acc[6], acc[7]);
      o1.x = pack_bf2(acc[8], acc[9]); o1.y = pack_bf2(acc[10], acc[11]); o1.z = pack_bf2(acc[12], acc[13]); o1.w = pack_bf2(acc[14], acc[15]);
    } else {
      o0 = u32x4{0u, 0u, 0u, 0u}; o1 = o0;
    }
    *(u32x4*)(dst) = o0;
    *(u32x4*)(dst + 8) = o1;
  } else {
    bf16_t* dst = (bf16_t*)(p.ws + OFF_VCMPT) + ((size_t)((b * 4 + g) * 64 + cq * 16)) * 128 + n;
#pragma unroll
    for (int d = 0; d < 16; ++d) {
      unsigned u = pack_bf2(valid ? acc[d] : 0.f, 0.f);
      dst[(size_t)d * 128] = (bf16_t)(u & 0xffff);
    }
  }
}

DI void kmean_item(const Params& p, int item, char* smem) {
  const int tid = tidx();
  const int blk = item & 7, g = (item >> 3) & 3, b = item >> 5;
  const int d8 = tid & 7, rg = tid >> 3;
  const bf16_t* K = (const bf16_t*)(p.ws + OFF_KS) + ((size_t)(b * 2048 + blk * 256)) * 256 + g * 64 + d8 * 8;
  float s[8];
#pragma unroll
  for (int q = 0; q < 8; ++q) s[q] = 0.f;
#pragma unroll
  for (int r = 0; r < 8; ++r) {
    u32x4 v = *(const u32x4*)(K + (size_t)(rg + 32 * r) * 256);
    s[0] += bflo(v.x); s[1] += bfhi(v.x); s[2] += bflo(v.y); s[3] += bfhi(v.y);
    s[4] += bflo(v.z); s[5] += bfhi(v.z); s[6] += bflo(v.w); s[7] += bfhi(v.w);
  }
  float* red = (float*)smem;
  __syncthreads();
#pragma unroll
  for (int q = 0; q < 8; ++q) red[rg * 64 + d8 * 8 + q] = s[q];
  __syncthreads();
  if (tid < 64) {
    float t = 0.f;
    for (int r = 0; r < 32; ++r) t += red[r * 64 + tid];
    bf16_t* km = (bf16_t*)(p.ws + OFF_KMEAN) + (size_t)((b * 4 + g) * 16) * 64;
    km[blk * 64 + tid] = (bf16_t)(pack_bf2(t * (1.f / 256.f), 0.f) & 0xffff);
    km[(8 + blk) * 64 + tid] = 0;
  }
}

template <int MASKMODE, bool FIXED>
DI void softmax_ct(f32x4 (&Sc)[4], int lo, int hi, float& mrun, float& lrun, f32x4 (&Oc)[4], bf16x8 (&Pc)[2]) {
  const bool colok = (MASKMODE == 1) ? (hi >= 0) : true;
  if (FIXED) {
    float rs = 0.f;
#pragma unroll
    for (int kt = 0; kt < 4; ++kt)
#pragma unroll
      for (int j = 0; j < 4; ++j) {
        float s = Sc[kt][j];
        if (MASKMODE == 2) {
          const int idx = kt * 16 + j;
          s = (idx > lo && idx <= hi) ? s : NEG;
        }
        const float pv = fexp2(s);
        Sc[kt][j] = pv;
        rs += pv;
      }
    if (MASKMODE == 1) rs = colok ? rs : 0.f;
    lrun += rs;
  } else {
    float mx = NEG;
#pragma unroll
    for (int kt = 0; kt < 4; ++kt)
#pragma unroll
      for (int j = 0; j < 4; ++j) {
        float s = Sc[kt][j];
        if (MASKMODE == 2) {
          const int idx = kt * 16 + j;
          s = (idx > lo && idx <= hi) ? s : NEG;
          Sc[kt][j] = s;
        }
        if (MASKMODE == 1) { s = colok ? s : NEG; Sc[kt][j] = s; }
        mx = fmaxf(mx, s);
      }
    mx = fmaxf(mx, __shfl_xor(mx, 16));
    mx = fmaxf(mx, __shfl_xor(mx, 32));
    const float mn = fmaxf(mrun, mx);
    const float alpha = fexp2(mrun - mn);
    mrun = mn;
    const float msafe = mn < -1e29f ? 0.f : mn;
    float rs = 0.f;
#pragma unroll
    for (int kt = 0; kt < 4; ++kt)
#pragma unroll
      for (int j = 0; j < 4; ++j) {
        float pv = fexp2(Sc[kt][j] - msafe);
        Sc[kt][j] = pv;
        rs += pv;
      }
    lrun = lrun * alpha + rs;
#pragma unroll
    for (int dt = 0; dt < 4; ++dt) Oc[dt] *= alpha;
  }
#pragma unroll
  for (int kp = 0; kp < 2; ++kp) {
    u32x4 u;
    u.x = pack_bf2(Sc[2 * kp][0], Sc[2 * kp][1]);
    u.y = pack_bf2(Sc[2 * kp][2], Sc[2 * kp][3]);
    u.z = pack_bf2(Sc[2 * kp + 1][0], Sc[2 * kp + 1][1]);
    u.w = pack_bf2(Sc[2 * kp + 1][2], Sc[2 * kp + 1][3]);
    if (MASKMODE == 1 && FIXED) { u.x = colok ? u.x : 0u; u.y = colok ? u.y : 0u; u.z = colok ? u.z : 0u; u.w = colok ? u.w : 0u; }
    Pc[kp] = __builtin_bit_cast(bf16x8, u);
  }
}
template <int MASKMODE, bool FIXED>
DI void attn_h1(const bf16_t* __restrict__ Ks, const bf16x8 (&Qb)[2][2], f32x4 (&O0)[4], f32x4 (&O1)[4], float (&mrun)[2], float (&lrun)[2],
                const int (&lo)[2], const int (&hi)[2], bf16x8 (&P0)[2], f32x4 (&S1)[4]) {
  const int lane = tidx() & 63, c16 = lane & 15, lg = lane >> 4;
  f32x4 S0[4];
  {
    bf16x8 ka[4][2];
#pragma unroll
    for (int kt = 0; kt < 4; ++kt)
#pragma unroll
      for (int ks = 0; ks < 2; ++ks) ka[kt][ks] = *(const bf16x8*)(Ks + (kt * 16 + c16) * 72 + ks * 32 + lg * 8);
#pragma unroll
    for (int kt = 0; kt < 4; ++kt) {
      S0[kt] = f32x4{0.f, 0.f, 0.f, 0.f};
      S1[kt] = f32x4{0.f, 0.f, 0.f, 0.f};
#pragma unroll
      for (int ks = 0; ks < 2; ++ks) {
        S0[kt] = mfma16(ka[kt][ks], Qb[0][ks], S0[kt]);
        S1[kt] = mfma16(ka[kt][ks], Qb[1][ks], S1[kt]);
      }
    }
  }
  softmax_ct<MASKMODE, FIXED>(S0, lo[0], hi[0], mrun[0], lrun[0], O0, P0);
}
template <int MASKMODE, bool FIXED>
DI void attn_h2(const bf16_t* __restrict__ Vs, f32x4 (&O0)[4], f32x4 (&O1)[4], float (&mrun)[2], float (&lrun)[2], const int (&lo)[2],
                const int (&hi)[2], const bf16x8 (&P0)[2], f32x4 (&S1)[4]) {
  const int lane = tidx() & 63, c16 = lane & 15, lg = lane >> 4;
  bf16x8 va[2][4];
#pragma unroll
  for (int kp = 0; kp < 2; ++kp)
#pragma unroll
    for (int dt = 0; dt < 4; ++dt) {
      const u32x2 v0 = *(const u32x2*)(Vs + (dt * 16 + c16) * 72 + kp * 32 + lg * 4);
      const u32x2 v1 = *(const u32x2*)(Vs + (dt * 16 + c16) * 72 + kp * 32 + 16 + lg * 4);
      va[kp][dt] = __builtin_bit_cast(bf16x8, (u32x4{v0.x, v0.y, v1.x, v1.y}));
    }
#pragma unroll
  for (int kp = 0; kp < 2; ++kp)
#pragma unroll
    for (int dt = 0; dt < 4; ++dt) O0[dt] = mfma16(va[kp][dt], P0[kp], O0[dt]);
  bf16x8 P1[2];
  softmax_ct<MASKMODE, FIXED>(S1, lo[1], hi[1], mrun[1], lrun[1], O1, P1);
#pragma unroll
  for (int kp = 0; kp < 2; ++kp)
#pragma unroll
    for (int dt = 0; dt < 4; ++dt) O1[dt] = mfma16(va[kp][dt], P1[kp], O1[dt]);
}

template <int MODE, bool FIXED>
DI void attn_range(const bf16_t* __restrict__ Kg, const bf16_t* __restrict__ VTg, int j0, int j1, char* smem, int& buf, const bf16x8 (&Qb)[2][2],
                   f32x4 (&O)[4][2], float (&mrun)[2], float (&lrun)[2], const int (&tq)[2], const unsigned (&selbits)[2], int own,
                   u32x4 (&rk)[2], u32x4 (&rv)[2]) {
  const int tid = tidx(), lane = tid & 63, lg = lane >> 4;
  const int half = vhalf();
  const int t512 = half * 256 + tid;
  const int r0 = t512 >> 3, c8 = t512 & 7;
  char* smsh = smem - half * SMEM_BYTES;
  const int soff = r0 * 72 + c8 * 8;
  f32x4 O0[4], O1[4];
#pragma unroll
  for (int dt = 0; dt < 4; ++dt) { O0[dt] = O[dt][0]; O1[dt] = O[dt][1]; }
  {
    bf16_t* base = (bf16_t*)(smsh + buf * SMEM_BYTES);
#pragma unroll
    for (int i = 0; i < 2; ++i) {
      *(u32x4*)(base + i * (64 * 72) + soff) = rk[i];
      *(u32x4*)(base + 9216 + i * (64 * 72) + soff) = rv[i];
    }
  }
#pragma unroll
  for (int i = 0; i < 2; ++i) {
    const int jj = j0 + 2 + i <= j1 ? j0 + 2 + i : j1;
    rk[i] = *(const u32x4*)(Kg + (size_t)(jj * 64 + r0) * 256 + c8 * 8);
    rv[i] = *(const u32x4*)(VTg + (size_t)r0 * 2048 + jj * 64 + c8 * 8);
  }
  lds_barrier();
  for (int jp = j0; jp <= j1; jp += 2) {
    const bf16_t* base = (const bf16_t*)(smsh + buf * SMEM_BYTES);
#pragma unroll 1
    for (int sub = 0; sub < 2; ++sub) {
      const int j = jp + sub;
      if (j > j1) break;
      const bf16_t* cK = base + sub * (64 * 72);
      const bf16_t* cV = base + 9216 + sub * (64 * 72);
      int lo[2], hi[2];
      const int kb = j * 64;
#pragma unroll
      for (int ct = 0; ct < 2; ++ct) {
        const int rel = tq[ct] - kb - lg * 4;
        if (MODE == 0) {
          hi[ct] = ((selbits[ct] >> j) & 1u) ? (j < j1 ? 1000 : rel) : -1;
          lo[ct] = -1000;
        } else if (MODE == 1) {
          hi[ct] = rel;
          lo[ct] = rel - 256;
        } else {
          const int jb = j >> 2;
          if (jb < own) hi[ct] = ((selbits[ct] >> jb) & 1u) ? 1000 : -1;
          else hi[ct] = (j < j1 ? 1000 : rel);
          lo[ct] = -1000;
        }
      }
      const bool act = (hi[0] >= 0 && lo[0] < 63) || (hi[1] >= 0 && lo[1] < 63);
      const bool wact = __any(act);
      bf16x8 P0[2];
      f32x4 S1[4];
      const bool f0 = hi[0] >= 63 && lo[0] < 0, f1 = hi[1] >= 63 && lo[1] < 0;
      const bool cu = (f0 || hi[0] < 0) && (f1 || hi[1] < 0);
      const int mm = !wact ? 3 : (__all(f0 && f1) ? 0 : (__all(cu) ? 1 : 2));
      if (mm == 0) attn_h1<0, FIXED>(cK, Qb, O0, O1, mrun, lrun, lo, hi, P0, S1);
      else if (mm == 1) attn_h1<1, FIXED>(cK, Qb, O0, O1, mrun, lrun, lo, hi, P0, S1);
      else if (mm == 2) attn_h1<2, FIXED>(cK, Qb, O0, O1, mrun, lrun, lo, hi, P0, S1);
      if (mm == 0) attn_h2<0, FIXED>(cV, O0, O1, mrun, lrun, lo, hi, P0, S1);
      else if (mm == 1) attn_h2<1, FIXED>(cV, O0, O1, mrun, lrun, lo, hi, P0, S1);
      else if (mm == 2) attn_h2<2, FIXED>(cV, O0, O1, mrun, lrun, lo, hi, P0, S1);
    }
    if (jp + 2 <= j1) {
      bf16_t* nb = (bf16_t*)(smsh + (buf ^ 1) * SMEM_BYTES);
#pragma unroll
      for (int i = 0; i < 2; ++i) {
        *(u32x4*)(nb + i * (64 * 72) + soff) = rk[i];
        *(u32x4*)(nb + 9216 + i * (64 * 72) + soff) = rv[i];
      }
#pragma unroll
      for (int i = 0; i < 2; ++i) {
        const int jj = jp + 4 + i <= j1 ? jp + 4 + i : j1;
        rk[i] = *(const u32x4*)(Kg + (size_t)(jj * 64 + r0) * 256 + c8 * 8);
        rv[i] = *(const u32x4*)(VTg + (size_t)r0 * 2048 + jj * 64 + c8 * 8);
      }
    }
    lds_barrier();
    buf ^= 1;
  }
#pragma unroll
  for (int dt = 0; dt < 4; ++dt) { O[dt][0] = O0[dt]; O[dt][1] = O1[dt]; }
}

DI void attn_first_pair(const bf16_t* __restrict__ Kg, const bf16_t* __restrict__ VTg, int j0, int j1, u32x4 (&rk)[2], u32x4 (&rv)[2]) {
  const int t512 = vhalf() * 256 + tidx();
  const int r0 = t512 >> 3, c8 = t512 & 7;
#pragma unroll
  for (int i = 0; i < 2; ++i) {
    const int jj = j0 + i <= j1 ? j0 + i : j1;
    rk[i] = *(const u32x4*)(Kg + (size_t)(jj * 64 + r0) * 256 + c8 * 8);
    rv[i] = *(const u32x4*)(VTg + (size_t)r0 * 2048 + jj * 64 + c8 * 8);
  }
}
DI void load_q(const Params& p, int b, int g, int tw  , bf16x8 (&Qb)[2][2]) {
  const int lane = tidx() & 63, c16 = lane & 15, lg = lane >> 4;
  const bf16_t* q = (const bf16_t*)(p.ws + OFF_Q);
#pragma unroll
  for (int ct = 0; ct < 2; ++ct) {
    const int t = tw + ct * 4 + (c16 >> 2), head = g * 4 + (c16 & 3);
    const bf16_t* qp = q + ((size_t)(b * 2048 + t)) * 1024 + head * 64 + lg * 8;
    Qb[ct][0] = *(const bf16x8*)(qp);
    Qb[ct][1] = *(const bf16x8*)(qp + 32);
  }
}

DI void store_y(const Params& p, int b, int g, int tw, const f32x4 (&Ot)[4][2]) {
  const int lane = tidx() & 63, c16 = lane & 15, lg = lane >> 4;
  const bf16_t* sz = (const bf16_t*)(p.ws + OFF_SZ);
  bf16_t* y = (bf16_t*)(p.ws + OFF_H);
#pragma unroll
  for (int ct = 0; ct < 2; ++ct) {
    const int t = tw + ct * 4 + (c16 >> 2), head = g * 4 + (c16 & 3);
    const size_t base = ((size_t)(b * 2048 + t)) * 1024 + head * 64 + lg * 4;
#pragma unroll
    for (int dt = 0; dt < 4; ++dt) {
      u32x2 zz = *(const u32x2*)(sz + base + dt * 16);
      u32x2 o;
      o.x = pack_bf2(Ot[dt][ct][0] * bflo(zz.x), Ot[dt][ct][1] * bfhi(zz.x));
      o.y = pack_bf2(Ot[dt][ct][2] * bflo(zz.y), Ot[dt][ct][3] * bfhi(zz.y));
      *(u32x2*)(y + base + dt * 16) = o;
    }
  }
}

template <bool FIXED>
DI void nsa_attn_item(const Params& p, int item, char* smem) {
  const int tid = tidx(), lane = tid & 63, w = tid >> 6, c16 = lane & 15, lg = lane >> 4;
  const int pi = item >> 1;
  const int rr = pi >> 6, kr = rr >> 2, bq = rr & 3;
  const int bg = pi & 63, qb = 2 * (31 - 4 * kr - ((kr & 1) ? 3 - bq : bq)) + (item & 1);
  const int b = bg >> 2, g = bg & 3;
  const int t0 = qb * 32, tw = t0 + w * 8;
  const int cur = t0 >> 6;
  unsigned* selm = (unsigned*)(smem + 36864);
  float* imp_main = (float*)(smem + 36992);
  float* imp_carry = (float*)(smem + 36992 + 4224);
  f32x4* Otl = (f32x4*)(smem + 36992) + tid;
  bf16x8 Qb[2][2];
  load_q(p, b, g, tw, Qb);
  const bf16_t* KgS = (const bf16_t*)(p.ws + OFF_KS) + (size_t)b * 2048 * 256 + g * 64;
  const bf16_t* VTgS = (const bf16_t*)(p.ws + OFF_VST) + (size_t)bg * 64 * 2048;
  const bf16_t* KgW = (const bf16_t*)(p.ws + OFF_KW) + (size_t)b * 2048 * 256 + g * 64;
  const bf16_t* VTgW = (const bf16_t*)(p.ws + OFF_VWT) + (size_t)bg * 64 * 2048;
  int jlo = t0 - 255;
  jlo = jlo < 0 ? 0 : (jlo >> 6);
  u32x4 rk[2], rv[2];
  attn_first_pair(KgS, VTgS, 0, cur, rk, rv);
  int tq[2];
  float gate[2][3];
  const float* gates = (const float*)(p.ws + OFF_GATES);
#pragma unroll
  for (int ct = 0; ct < 2; ++ct) {
    tq[ct] = tw + ct * 4 + (c16 >> 2);
    const float* gp = gates + ((size_t)(b * 2048 + tq[ct])) * 48 + (g * 4 + (c16 & 3)) * 3;
    gate[ct][0] = gp[0]; gate[ct][1] = gp[1]; gate[ct][2] = gp[2];
  }
  __syncthreads();
  char* smsh = smem - vhalf() * SMEM_BYTES;
  bf16_t* Kc = (bf16_t*)smsh;
  bf16_t* VcT = (bf16_t*)(smsh + 18432);
  {
    const bf16_t* kc = (const bf16_t*)(p.ws + OFF_KCMP) + (size_t)bg * 128 * 64;
    const bf16_t* vc = (const bf16_t*)(p.ws + OFF_VCMPT) + (size_t)bg * 64 * 128;
    const int t512 = vhalf() * 256 + tid;
    u32x4 tk[2], tv[2];
#pragma unroll
    for (int i = 0; i < 2; ++i) {
      const int ch = t512 + i * 512;
      tk[i] = *(const u32x4*)(kc + (ch >> 3) * 64 + (ch & 7) * 8);
      tv[i] = *(const u32x4*)(vc + (ch >> 4) * 128 + (ch & 15) * 8);
    }
#pragma unroll
    for (int i = 0; i < 2; ++i) {
      const int ch = t512 + i * 512;
      *(u32x4*)(Kc + (ch >> 3) * 72 + (ch & 7) * 8) = tk[i];
      *(u32x4*)(VcT + (ch >> 4) * 136 + (ch & 15) * 8) = tv[i];
    }
  }
  __syncthreads();
  f32x4 Ot[4][2];
#pragma unroll
  for (int ct = 0; ct < 2; ++ct) {
    f32x4 Sx[8];
#pragma unroll
    for (int kt = 0; kt < 8; ++kt) {
      Sx[kt] = f32x4{0.f, 0.f, 0.f, 0.f};
#pragma unroll
      for (int ks = 0; ks < 2; ++ks) {
        bf16x8 a = *(const bf16x8*)(Kc + (kt * 16 + c16) * 72 + ks * 32 + lg * 8);
        Sx[kt] = mfma16(a, Qb[ct][ks], Sx[kt]);
      }
    }
    {
      const int hi = ((tq[ct] - 31) >> 4) - lg * 4;
      float mx = NEG;
#pragma unroll
      for (int kt = 0; kt < 8; ++kt)
#pragma unroll
        for (int j = 0; j < 4; ++j) {
          float s = (kt * 16 + j <= hi) ? Sx[kt][j] : NEG;
          Sx[kt][j] = s;
          mx = fmaxf(mx, s);
        }
      mx = fmaxf(mx, __shfl_xor(mx, 16));
      mx = fmaxf(mx, __shfl_xor(mx, 32));
      const float msafe = mx < -1e29f ? 0.f : mx;
      float rs = 0.f;
#pragma unroll
      for (int kt = 0; kt < 8; ++kt)
#pragma unroll
        for (int j = 0; j < 4; ++j) {
          float pv = fexp2(Sx[kt][j] - msafe);
          Sx[kt][j] = pv;
          rs += pv;
        }
      rs += __shfl_xor(rs, 16);
      rs += __shfl_xor(rs, 32);
      const float inv = 1.f / fmaxf(rs, 1e-30f);
      const int qloc = w * 8 + ct * 4 + (c16 >> 2);
#pragma unroll
      for (int kt = 0; kt < 8; ++kt) {
#pragma unroll
        for (int j = 0; j < 4; ++j) Sx[kt][j] *= inv;
        float a = Sx[kt][0] + Sx[kt][1] + Sx[kt][2] + 0.5f * Sx[kt][3];
        float c = 0.5f * Sx[kt][3];
        a += qxor1(a);
        a += qxor2(a);
        c += qxor1(c);
        c += qxor2(c);
        if ((c16 & 3) == 0) {
          const int mi = kt * 4 + lg;
          imp_main[qloc * 33 + mi] = a;
          imp_carry[qloc * 34 + mi + 1] = c;
        }
      }
    }
    f32x4 O[4];
#pragma unroll
    for (int dt = 0; dt < 4; ++dt) O[dt] = f32x4{0.f, 0.f, 0.f, 0.f};
#pragma unroll
    for (int kp = 0; kp < 4; ++kp) {
      u32x4 u;
      u.x = pack_bf2(Sx[2 * kp][0], Sx[2 * kp][1]);
      u.y = pack_bf2(Sx[2 * kp][2], Sx[2 * kp][3]);
      u.z = pack_bf2(Sx[2 * kp + 1][0], Sx[2 * kp + 1][1]);
      u.w = pack_bf2(Sx[2 * kp + 1][2], Sx[2 * kp + 1][3]);
      bf16x8 Pb = __builtin_bit_cast(bf16x8, u);
#pragma unroll
      for (int dt = 0; dt < 4; ++dt) {
        u32x2 v0 = *(const u32x2*)(VcT + (dt * 16 + c16) * 136 + kp * 32 + lg * 4);
        u32x2 v1 = *(const u32x2*)(VcT + (dt * 16 + c16) * 136 + kp * 32 + 16 + lg * 4);
        u32x4 uu = u32x4{v0.x, v0.y, v1.x, v1.y};
        bf16x8 va = __builtin_bit_cast(bf16x8, uu);
        O[dt] = mfma16(va, Pb, O[dt]);
      }
    }
#pragma unroll
    for (int dt = 0; dt < 4; ++dt) Ot[dt][ct] = O[dt] * gate[ct][0];
  }
  __syncthreads();
  {
    const int q = tid >> 3, jj = tid & 7;
    const int jmax = cur - 2;
    unsigned forced = 1u | (1u << cur);
    if (cur >= 1) forced |= 1u << (cur - 1);
    const int need = 8 - __popc(forced);
    float vj[4];
    int cnt[4];
#pragma unroll
    for (int c = 0; c < 4; ++c) {
      const int j = jj + 8 * c;
      vj[c] = (j >= 1 && j <= jmax) ? imp_main[q * 33 + j] + imp_carry[q * 34 + j] : 0.f;
      cnt[c] = 0;
    }
    for (int i = 1; i <= jmax; ++i) {
      const float vi = imp_main[q * 33 + i] + imp_carry[q * 34 + i];
#pragma unroll
      for (int c = 0; c < 4; ++c) {
        const int j = jj + 8 * c;
        cnt[c] += (vi > vj[c] || (vi == vj[c] && i < j)) ? 1 : 0;
      }
    }
    unsigned bits = 0;
#pragma unroll
    for (int c = 0; c < 4; ++c) {
      const int j = jj + 8 * c;
      if (j >= 1 && j <= jmax && cnt[c] < need) bits |= 1u << j;
    }
    bits |= (unsigned)__shfl_xor((int)bits, 1);
    bits |= (unsigned)__shfl_xor((int)bits, 2);
    bits |= (unsigned)__shfl_xor((int)bits, 4);
    if (jj == 0) selm[q] = forced | bits;
  }
  __syncthreads();
  unsigned selbits[2];
#pragma unroll
  for (int ct = 0; ct < 2; ++ct) selbits[ct] = selm[w * 8 + ct * 4 + (c16 >> 2)];
#pragma unroll
  for (int dt = 0; dt < 4; ++dt)
#pragma unroll
    for (int ct = 0; ct < 2; ++ct) Otl[(dt * 2 + ct) * 256] = Ot[dt][ct];
  int buf = 0;
  {
    f32x4 O[4][2];
    float mrun[2] = {NEG, NEG}, lrun[2] = {0.f, 0.f};
#pragma unroll
    for (int dt = 0; dt < 4; ++dt) { O[dt][0] = f32x4{0.f, 0.f, 0.f, 0.f}; O[dt][1] = f32x4{0.f, 0.f, 0.f, 0.f}; }
    attn_range<0, FIXED>(KgS, VTgS, 0, cur, smem, buf, Qb, O, mrun, lrun, tq, selbits, 0, rk, rv);
    attn_first_pair(KgW, VTgW, jlo, cur, rk, rv);
#pragma unroll
    for (int ct = 0; ct < 2; ++ct) {
      float l = lrun[ct];
      l += __shfl_xor(l, 16);
      l += __shfl_xor(l, 32);
      const float sc = gate[ct][1] / fmaxf(l, 1e-30f);
#pragma unroll
      for (int dt = 0; dt < 4; ++dt) Otl[(dt * 2 + ct) * 256] = Otl[(dt * 2 + ct) * 256] + O[dt][ct] * sc;
    }
  }
  {
    f32x4 O[4][2];
    float mrun[2] = {NEG, NEG}, lrun[2] = {0.f, 0.f};
#pragma unroll
    for (int dt = 0; dt < 4; ++dt) { O[dt][0] = f32x4{0.f, 0.f, 0.f, 0.f}; O[dt][1] = f32x4{0.f, 0.f, 0.f, 0.f}; }
    attn_range<1, FIXED>(KgW, VTgW, jlo, cur, smem, buf, Qb, O, mrun, lrun, tq, selbits, 0, rk, rv);
#pragma unroll
    for (int ct = 0; ct < 2; ++ct) {
      float l = lrun[ct];
      l += __shfl_xor(l, 16);
      l += __shfl_xor(l, 32);
      const float sc = gate[ct][2] / fmaxf(l, 1e-30f);
#pragma unroll
      for (int dt = 0; dt < 4; ++dt) Ot[dt][ct] = Otl[(dt * 2 + ct) * 256] + O[dt][ct] * sc;
    }
  }
  store_y(p, b, g, tw, Ot);
}

template <bool FIXED>
DI void moba_attn_item(const Params& p, int item, char* smem) {
  const int tid = tidx(), lane = tid & 63, w = tid >> 6, c16 = lane & 15, lg = lane >> 4;
  const int pi = item >> 1;
  const int rr = pi >> 6, kr = rr >> 2, bq = rr & 3;
  const int bg = pi & 63, qb = 2 * (31 - 4 * kr - ((kr & 1) ? 3 - bq : bq)) + (item & 1);
  const int b = bg >> 2, g = bg & 3;
  const int t0 = qb * 32, tw = t0 + w * 8;
  const int own = t0 >> 8;
  bf16x8 Qb[2][2];
  load_q(p, b, g, tw, Qb);
  const bf16_t* Kg = (const bf16_t*)(p.ws + OFF_KS) + (size_t)b * 2048 * 256 + g * 64;
  const bf16_t* VTg = (const bf16_t*)(p.ws + OFF_VST) + (size_t)bg * 64 * 2048;
  u32x4 rk[2], rv[2];
  attn_first_pair(Kg, VTg, 0, t0 >> 6, rk, rv);
  int tq[2];
#pragma unroll
  for (int ct = 0; ct < 2; ++ct) tq[ct] = tw + ct * 4 + (c16 >> 2);
  __syncthreads();
  bf16_t* Km = (bf16_t*)(smem + 36864);
  if (tid < 128) {
    int row = tid >> 3, cc = tid & 7;
    *(u32x4*)(Km + row * 72 + cc * 8) = *(const u32x4*)((const bf16_t*)(p.ws + OFF_KMEAN) + (size_t)bg * 16 * 64 + row * 64 + cc * 8);
  }
  __syncthreads();
  unsigned selbits[2];
#pragma unroll
  for (int ct = 0; ct < 2; ++ct) {
    f32x4 sg = f32x4{0.f, 0.f, 0.f, 0.f};
#pragma unroll
    for (int ks = 0; ks < 2; ++ks) {
      bf16x8 a = *(const bf16x8*)(Km + c16 * 72 + ks * 32 + lg * 8);
      sg = mfma16(a, Qb[ct][ks], sg);
    }
    f32x4 ot;
#pragma unroll
    for (int j = 0; j < 4; ++j) ot[j] = __shfl_xor(sg[j], 16);
    const bool odd = (lg & 1) != 0;
    float v0 = odd ? ot[0] : sg[0], v1 = odd ? ot[1] : sg[1], v2 = odd ? ot[2] : sg[2], v3 = odd ? ot[3] : sg[3];
    float v4 = odd ? sg[0] : ot[0], v5 = odd ? sg[1] : ot[1], v6 = odd ? sg[2] : ot[2], v7 = odd ? sg[3] : ot[3];
    unsigned sel = 0;
#pragma unroll
    for (int it = 0; it < 3; ++it) {
      float bv = -3.0e38f;
      int best = -1;
#define CAND(J, V) if ((J) < own && !((sel >> (J)) & 1u) && (V) > bv) { bv = (V); best = (J); }
      CAND(0, v0) CAND(1, v1) CAND(2, v2) CAND(3, v3) CAND(4, v4) CAND(5, v5) CAND(6, v6) CAND(7, v7)
#undef CAND
      if (best >= 0) sel |= 1u << best;
    }
    selbits[ct] = (unsigned)__shfl((int)sel, c16);
  }
  int buf = 0;
  f32x4 O[4][2];
  float mrun[2] = {NEG, NEG}, lrun[2] = {0.f, 0.f};
#pragma unroll
  for (int dt = 0; dt < 4; ++dt) { O[dt][0] = f32x4{0.f, 0.f, 0.f, 0.f}; O[dt][1] = f32x4{0.f, 0.f, 0.f, 0.f}; }
  attn_range<2, FIXED>(Kg, VTg, 0, t0 >> 6, smem, buf, Qb, O, mrun, lrun, tq, selbits, own, rk, rv);
#pragma unroll
  for (int ct = 0; ct < 2; ++ct) {
    float l = lrun[ct];
    l += __shfl_xor(l, 16);
    l += __shfl_xor(l, 32);
    const float sc = 1.f / fmaxf(l, 1e-30f);
#pragma unroll
    for (int dt = 0; dt < 4; ++dt) O[dt][ct] *= sc;
  }
  store_y(p, b, g, tw, O);
}

#ifndef PROBE_DUP
#define PROBE_DUP -1
#endif
DI void run_phase1(const Params& pin, int layer, int ph, char* smem, unsigned long long& eticks);
DI void run_phase(const Params& pin, int layer, int ph, char* smem, unsigned long long& eticks) {
  run_phase1(pin, layer, ph, smem, eticks);
}
DI void run_phase1(const Params& pin, int layer, int ph, char* smem_all, unsigned long long& eticks) {
  Params p = pin;
  {
    size_t z = 0;
    asm volatile("" : "+s"(z));
    p.ws = pin.ws + z;
    p.out = pin.out + z;
  }
  const int half = vhalf();
  char* smem = smem_all + half * SMEM_BYTES;
  const int G = 2 * gridDim.x, bid = 2 * blockIdx.x + half;
  const bool nsa = (layer & 1) == 0;
  const int lj = layer >> 1;
  const float* xin = layer == 0 ? p.x : p.out;
  if (ph == 0) {
    for (int it = bid; it < NW_TOTAL; it += G) phaseW_item(p, it, smem);
  } else if (ph == 1) {
    for (int it = bid; it < NTOK / 16; it += G) prep_item(p, layer, xin, it);
  } else if (ph == 2) {
    g8::StaticOrder S;
    S.init(NTOK, nsa ? NSA_NP : MOBA_IN, gridDim.x, blockIdx.x);
    InProjEpi E{p, layer};
    const bf16_t* Bt = nsa ? (const bf16_t*)(p.ws + OFF_WT_NSA_IN) + (size_t)lj * NSA_NP * 1024
                           : (const bf16_t*)(p.ws + OFF_WT_MOBA_IN) + (size_t)lj * MOBA_IN * 1024;
    g8::gemm_phase(( LAS unsigned char*)smem_all, (const bf16_t*)(p.ws + OFF_H), Bt, 1024, S, E, eticks);
    if (nsa) {
      __syncthreads();
      for (int it = bid; it < 512; it += G) gates_tile(p, lj, it, smem);
    }
  } else if (ph == 3) {
    if (nsa) { for (int it = bid; it < 512; it += G) cmp1_tile(p, lj, it, smem); }
    else { for (int it = bid; it < 512; it += G) kmean_item(p, it, smem); }
  } else if (ph == 4) {
    if (nsa) for (int it = bid; it < 512; it += G) cmp2_item(p, lj, it, smem);
  } else if (ph == 5) {
    float gq, gk;
    {
      const int l64 = tidx() & 63;
      if (nsa) {
        gq = fabsf(p.nsa_qn[lj * 64 + l64]);
        gk = fmaxf(fabsf(p.nsa_kn[(lj * 3 + 1) * 64 + l64]), fabsf(p.nsa_kn[(lj * 3 + 2) * 64 + l64]));
      } else {
        gq = fabsf(p.moba_qn[lj * 64 + l64]);
        gk = fabsf(p.moba_kn[lj * 64 + l64]);
      }
#pragma unroll
      for (int o = 32; o >= 1; o >>= 1) { gq = fmaxf(gq, __shfl_xor(gq, o)); gk = fmaxf(gk, __shfl_xor(gk, o)); }
    }
    const bool fixed_ok = (11.8f * gq * gk) <= 100.f;
    if (nsa) {
      if (fixed_ok) { for (int it = bid; it < 4096; it += G) nsa_attn_item<true>(p, it, smem); }
      else { for (int it = bid; it < 4096; it += G) nsa_attn_item<false>(p, it, smem); }
    } else {
      if (fixed_ok) { for (int it = bid; it < 4096; it += G) moba_attn_item<true>(p, it, smem); }
      else { for (int it = bid; it < 4096; it += G) moba_attn_item<false>(p, it, smem); }
    }
  } else if (ph == 6) {
    g8::StaticOrder S;
    S.init(NTOK, 1024, gridDim.x, blockIdx.x);
    OutProjEpi E{p, layer, xin};
    const bf16_t* Bt = (const bf16_t*)(p.ws + (nsa ? OFF_WT_NSA_OUT : OFF_WT_MOBA_OUT)) + (size_t)lj * 1024 * 1024;
    { unsigned long long dummy = 0; g8::gemm_phase((LAS unsigned char*)smem_all, (const bf16_t*)(p.ws + OFF_H), Bt, 1024, S, E, dummy); }
  }
}

#if MULTI_LAUNCH
template <int PH>
__global__ void __launch_bounds__(512, 2) phase_kernel(Params p, int layer) {
  __shared__ __attribute__((aligned(16))) char smem[2 * SMEM_BYTES];
  unsigned long long eticks = 0;
  run_phase(p, layer, PH, smem, eticks);
}
#else
#ifndef PROBE_T
#define PROBE_T -1
#endif
#define TSTAMP(type) do { if (PROBE_T >= 0) { unsigned long long _t = wall_clock64(); if (PROBE_T == (type)) tacc += _t - tprev; tprev = _t; } } while (0)
__global__ void __launch_bounds__(512, 2) mega_kernel(Params p) {
  __shared__ __attribute__((aligned(16))) char smem[2 * SMEM_BYTES];
  __shared__ u32x4 xb_words;
  cg::grid_group grid = cg::this_grid();
  if (__builtin_amdgcn_workitem_id_x() == 0) xb_words = u32x4{0u, 0u, 0u, 0u};
  __syncthreads();
  if (blockIdx.x == 0) {
    unsigned* bw = (unsigned*)(p.ws + OFF_BAR);
    for (int i = __builtin_amdgcn_workitem_id_x(); i < (int)(BAR_BYTES / 4); i += 512) bw[i] = 0u;
  }
  grid.sync();
  (void)xcd_barrier_post((unsigned*)(p.ws + OFF_BAR), (volatile LAS unsigned*)&xb_words);
#define XBAR() do { XcdBarrier _xb; _xb.bar = (unsigned*)(p.ws + OFF_BAR); _xb.x = xb_xcc_id(); _xb.st = (volatile LAS unsigned*)&xb_words; xcd_barrier(_xb); } while (0)
  unsigned long long tprev = 0, tacc = 0, eticks = 0;
  if (PROBE_T >= 0) tprev = wall_clock64();
  run_phase(p, 0, 0, smem, eticks);
  XBAR();
  TSTAMP(0);
  for (int layer = 0; layer < 4; ++layer) {
    const bool nsa = (layer & 1) == 0;
    run_phase(p, layer, 1, smem, eticks);
    XBAR();
    TSTAMP(1);
    run_phase(p, layer, 2, smem, eticks);
    XBAR();
    TSTAMP(2);
    run_phase(p, layer, 3, smem, eticks);
    XBAR();
    TSTAMP(3);
    if (nsa) {
      run_phase(p, layer, 4, smem, eticks);
      XBAR();
      TSTAMP(4);
    }
    run_phase(p, layer, 5, smem, eticks);
    XBAR();
    TSTAMP(nsa ? 5 : 7);
    run_phase(p, layer, 6, smem, eticks);
    if (layer < 3 || PROBE_T >= 0) XBAR();
    TSTAMP(6);
  }
  if (PROBE_T >= 0 && blockIdx.x == 0 && __builtin_amdgcn_workitem_id_x() == 0) p.out[0] = (float)((PROBE_T >= 8) ? eticks : tacc) * 0.01f * 0.03f;
}
#endif

extern "C" void kernel_launch(void* const* d_in, const int* in_sizes, int n_in, void* d_out, int out_size, void* d_ws, size_t ws_size,
                              hipStream_t stream) {
  Params p{};
  p.x = (const float*)d_in[0];
  p.c = (const float*)d_in[1];
  p.pos = (const int*)d_in[2];
  p.norm_g = (const float*)d_in[3];
  p.ada_w = (const float*)d_in[4];
  p.ada_b = (const float*)d_in[5];
  p.nsa_w_in = (const float*)d_in[6];
  p.nsa_w_out = (const float*)d_in[7];
  p.nsa_qn = (const float*)d_in[8];
  p.nsa_kn = (const float*)d_in[9];
  p.cmp_pe = (const float*)d_in[10];
  p.cmp_w1 = (const float*)d_in[11];
  p.cmp_b1 = (const float*)d_in[12];
  p.cmp_w2 = (const float*)d_in[13];
  p.gate_b = (const float*)d_in[14];
  p.moba_w_in = (const float*)d_in[15];
  p.moba_w_out = (const float*)d_in[16];
  p.moba_qn = (const float*)d_in[17];
  p.moba_kn = (const float*)d_in[18];
  p.out = (float*)d_out;
  p.ws = (char*)d_ws;
  if (ws_size < WS_TOTAL) { fprintf(stderr, "workspace too small: %zu < %zu\n", ws_size, (size_t)WS_TOTAL); return; }
#if MULTI_LAUNCH
  const int G = 256;
  phase_kernel<0><<<G, 512, 0, stream>>>(p, 0);
  for (int layer = 0; layer < 4; ++layer) {
    phase_kernel<1><<<G, 512, 0, stream>>>(p, layer);
    phase_kernel<2><<<G, 512, 0, stream>>>(p, layer);
    phase_kernel<3><<<G, 512, 0, stream>>>(p, layer);
    if (!(layer & 1)) phase_kernel<4><<<G, 512, 0, stream>>>(p, layer);
    phase_kernel<5><<<G, 512, 0, stream>>>(p, layer);
    phase_kernel<6><<<G, 512, 0, stream>>>(p, layer);
  }
#else
  static int grid_blocks = 0;
  if (!grid_blocks) {
    int dev = 0, cus = 0, per_cu = 0;
    (void)hipGetDevice(&dev);
    (void)hipDeviceGetAttribute(&cus, hipDeviceAttributeMultiprocessorCount, dev);
    (void)hipOccupancyMaxActiveBlocksPerMultiprocessor(&per_cu, mega_kernel, 512, 0);
    if (per_cu > 1) per_cu = 1;
    grid_blocks = cus * per_cu;
  }
  void* args[] = {&p};
  hipError_t e = hipLaunchCooperativeKernel((void*)mega_kernel, dim3(grid_blocks), dim3(512), args, 0, stream);
  if (e != hipSuccess) fprintf(stderr, "cooperative launch failed: %s (grid %d)\n", hipGetErrorString(e), grid_blocks);
#endif
}
```

```cpp
#include <hip/hip_runtime.h>
#include <hip/hip_cooperative_groups.h>
#include <cstdio>
namespace cg = cooperative_groups;

#ifndef MULTI_LAUNCH
#define MULTI_LAUNCH 0
#endif

#define DI __device__ __forceinline__
typedef unsigned short bf16_t;
using bf16x8 = __attribute__((ext_vector_type(8))) short;
using f32x4 = __attribute__((ext_vector_type(4))) float;
typedef __bf16 bf16x2_t __attribute__((ext_vector_type(2)));
typedef float f32x2_t __attribute__((ext_vector_type(2)));
using u32x4 = __attribute__((ext_vector_type(4))) unsigned;
using u32x2 = __attribute__((ext_vector_type(2))) unsigned;

constexpr int DM = 1024, NB = 16, SEQ = 2048, NTOK = NB * SEQ;
constexpr int NSA_IN = 3632, NSA_NP = 3584, MOBA_IN = 2560;
constexpr float EPS = 1e-6f;
constexpr float QSCALE = 0.125f * 1.4426950408889634f;
constexpr float NEG = -1e30f;

constexpr size_t SZ_WT_NSA_IN = (size_t)2 * NSA_NP * 1024 * 2;
constexpr size_t SZ_WT_SQ = (size_t)2 * 1024 * 1024 * 2;
constexpr size_t SZ_WT_MOBA_IN = (size_t)2 * MOBA_IN * 1024 * 2;
constexpr size_t SZ_WT_CMP1 = (size_t)4 * 256 * 2048 * 2;
constexpr size_t SZ_ACT = (size_t)NTOK * 1024 * 2;
constexpr size_t SZ_KV = (size_t)NTOK * 256 * 2;
constexpr size_t OFF_WT_NSA_IN = 0;
constexpr size_t OFF_WT_NSA_OUT = OFF_WT_NSA_IN + SZ_WT_NSA_IN;
constexpr size_t OFF_WT_MOBA_IN = OFF_WT_NSA_OUT + SZ_WT_SQ;
constexpr size_t OFF_WT_MOBA_OUT = OFF_WT_MOBA_IN + SZ_WT_MOBA_IN;
constexpr size_t OFF_WT_CMP1 = OFF_WT_MOBA_OUT + SZ_WT_SQ;
constexpr size_t OFF_B1EFF = OFF_WT_CMP1 + SZ_WT_CMP1;
constexpr size_t OFF_ROPE = OFF_B1EFF + 4096;
constexpr size_t OFF_MOD = OFF_ROPE + (size_t)NTOK * 16 * 4;
constexpr size_t OFF_H = OFF_MOD + (size_t)4 * 16 * 3072 * 4;
constexpr size_t OFF_Q = OFF_H + SZ_ACT;
constexpr size_t OFF_SZ = OFF_Q + SZ_ACT;
constexpr size_t OFF_KC = OFF_SZ + SZ_ACT;
constexpr size_t OFF_VC = OFF_KC + SZ_KV;
constexpr size_t OFF_KS = OFF_VC + SZ_KV;
constexpr size_t OFF_KW = OFF_KS + SZ_KV;
constexpr size_t OFF_VST = OFF_KW + SZ_KV;
constexpr size_t OFF_VWT = OFF_VST + SZ_KV;
constexpr size_t OFF_GATES = OFF_VWT + SZ_KV;
constexpr size_t OFF_HID = OFF_GATES + (size_t)NTOK * 48 * 4;
constexpr size_t OFF_KCMP = OFF_HID + (size_t)2 * 8192 * 256 * 2;
constexpr size_t OFF_VCMPT = OFF_KCMP + (size_t)64 * 128 * 64 * 2;
constexpr size_t OFF_KMEAN = OFF_VCMPT + (size_t)64 * 128 * 64 * 2;
constexpr size_t OFF_WT_GL = OFF_KMEAN + (size_t)64 * 16 * 64 * 2;
constexpr size_t OFF_BAR = OFF_WT_GL + (size_t)2 * 128 * 1024 * 2;
constexpr size_t BAR_BYTES = 3456 * 4;
constexpr size_t WS_TOTAL = OFF_BAR + 16384;

struct Params {
  const float *x, *c;
  const int* pos;
  const float *norm_g, *ada_w, *ada_b, *nsa_w_in, *nsa_w_out, *nsa_qn, *nsa_kn, *cmp_pe, *cmp_w1, *cmp_b1, *cmp_w2, *gate_b,
      *moba_w_in, *moba_w_out, *moba_qn, *moba_kn;
  float* out;
  char* ws;
};

constexpr int SMEM_BYTES = 73728;

DI int tidx() {
  int t = __builtin_amdgcn_workitem_id_x() & 255;
  asm volatile("" : "+v"(t));
  return t;
}
DI void lds_barrier() {
  asm volatile("s_waitcnt lgkmcnt(0)" ::: "memory");
  __builtin_amdgcn_s_barrier();
  asm volatile("" ::: "memory");
}
DI float qxor1(float x) { return __builtin_bit_cast(float, __builtin_amdgcn_mov_dpp(__builtin_bit_cast(int, x), 0xB1, 0xF, 0xF, true)); }
DI float qxor2(float x) { return __builtin_bit_cast(float, __builtin_amdgcn_mov_dpp(__builtin_bit_cast(int, x), 0x4E, 0xF, 0xF, true)); }
DI int vhalf() { return __builtin_amdgcn_readfirstlane(__builtin_amdgcn_workitem_id_x() >> 8); }
DI unsigned pack_bf2(float a, float b) {
  f32x2_t v = {a, b};
  bf16x2_t r = __builtin_convertvector(v, bf16x2_t);
  return __builtin_bit_cast(unsigned, r);
}
DI float bf2f(bf16_t v) { return __uint_as_float(((unsigned)v) << 16); }
DI float bflo(unsigned u) { return __uint_as_float(u << 16); }
DI float bfhi(unsigned u) { return __uint_as_float(u & 0xffff0000u); }
DI f32x4 mfma16(bf16x8 a, bf16x8 b, f32x4 c) { return __builtin_amdgcn_mfma_f32_16x16x32_bf16(a, b, c, 0, 0, 0); }
DI float fexp2(float x) { return __builtin_amdgcn_exp2f(x); }
DI float sigmoidf_(float x) { return __builtin_amdgcn_rcpf(1.f + __builtin_amdgcn_exp2f(-1.4426950408889634f * x)); }
DI float siluf_(float x) { return x * __builtin_amdgcn_rcpf(1.f + __builtin_amdgcn_exp2f(-1.4426950408889634f * x)); }
DI float geluf_(float x) {
  float u = 0.7978845608028654f * (x + 0.044715f * x * x * x);
  float t = 1.f - 2.f / (__expf(2.f * u) + 1.f);
  return 0.5f * x * (1.f + t);
}


#define XB_TMO      128
#define XB_XCNT(j)  (256  + 64 * (j))
#define XB_XSUB(j)  (1280 + 64 * (j))
#define XB_XGEN(j)  (2304 + 64 * (j))
#define XB_TOP      3328
#define XB_TOPGEN   3392
#define XB_SPIN_CAP (1u << 22)
#define LAS __attribute__((address_space(3)))
DI unsigned xb_ld(unsigned* p) { return __hip_atomic_load(p, __ATOMIC_RELAXED, __HIP_MEMORY_SCOPE_AGENT); }
DI unsigned xb_add(unsigned* p, unsigned v) { return __hip_atomic_fetch_add(p, v, __ATOMIC_RELAXED, __HIP_MEMORY_SCOPE_AGENT); }
DI unsigned xb_xcc_id() { return (unsigned)__builtin_amdgcn_s_getreg((3 << 11) | 20) & 0xFu; }
#define XB_SPIN(cond, bar) do { unsigned _sp = 0; while (cond) { __builtin_amdgcn_s_sleep(1); \
    if ((++_sp & 255u) == 0u) { if (xb_ld(&(bar)[XB_TMO])) break; if (_sp > XB_SPIN_CAP) { atomicAdd(&(bar)[XB_TMO], 1u); break; } } } } while (0)
struct XcdBarrier { unsigned* bar; unsigned x; volatile LAS unsigned* st; };
DI XcdBarrier xcd_barrier_post(unsigned* bar, volatile LAS unsigned* st) {
  XcdBarrier b; b.bar = bar; b.x = xb_xcc_id(); b.st = st;
  if (__builtin_amdgcn_workitem_id_x() == 0) (void)xb_add(&bar[XB_XCNT(b.x)], 1u);
  return b;
}
DI void xcd_barrier_complete(unsigned* bar, unsigned x, unsigned& nloc, unsigned& nx) {
  const unsigned G = gridDim.x * gridDim.y * gridDim.z;
  unsigned sum, cnt, mine, sp = 0u;
  for (;;) {
    sum = 0u; cnt = 0u; mine = 0u;
#pragma unroll
    for (unsigned j = 0; j < 16; ++j) { const unsigned c = xb_ld(&bar[XB_XCNT(j)]); sum += c; cnt += (c > 0u) ? 1u : 0u; mine = (j == x) ? c : mine; }
    if (sum == G) break;
    __builtin_amdgcn_s_sleep(1);
    if ((++sp & 255u) == 0u) { if (xb_ld(&bar[XB_TMO])) break; if (sp > XB_SPIN_CAP) { atomicAdd(&bar[XB_TMO], 1u); break; } }
  }
  nloc = mine > 0u ? mine : 1u; nx = cnt > 0u ? cnt : 1u;
}
DI void xcd_barrier(const XcdBarrier& b) {
  asm volatile("s_waitcnt vmcnt(0)" ::: "memory");
  __syncthreads();
  if (__builtin_amdgcn_workitem_id_x() == 0) {
    unsigned* bar = b.bar;
    __builtin_amdgcn_s_waitcnt(0);
    unsigned nloc = b.st[0], nx = b.st[1];
    if (nloc == 0u) { xcd_barrier_complete(bar, b.x, nloc, nx); b.st[0] = nloc; b.st[1] = nx; }
    const unsigned old = xb_add(&bar[XB_XSUB(b.x)], 1u);
    const unsigned gen = old / nloc;
    if (old + 1u == (gen + 1u) * nloc) {
      __builtin_amdgcn_fence(__ATOMIC_RELEASE, "agent");
      asm volatile("s_waitcnt vmcnt(0)" ::: "memory");
      const unsigned og = xb_add(&bar[XB_TOP], 1u);
      const unsigned tg = og / nx;
      if (og + 1u == (tg + 1u) * nx) xb_add(&bar[XB_TOPGEN], 1u);
      else XB_SPIN(xb_ld(&bar[XB_TOPGEN]) == tg, bar);
      __builtin_amdgcn_fence(__ATOMIC_ACQUIRE, "agent");
      xb_add(&bar[XB_XGEN(b.x)], 1u);
      asm volatile("s_waitcnt vmcnt(0)" ::: "memory");
    } else {
      XB_SPIN(xb_ld(&bar[XB_XGEN(b.x)]) == gen, bar);
      __builtin_amdgcn_fence(__ATOMIC_ACQUIRE, "agent");
      asm volatile("s_waitcnt vmcnt(0)" ::: "memory");
    }
  }
  __syncthreads();
}

DI void ada_item(const Params& p, int item, char* smem) {
  const int tid = tidx();
  const int l = item / 192, n0 = (item % 192) * 16;
  float* cond = (float*)smem;
  __syncthreads();
  for (int i = tid; i < 16 * 1024; i += 256) {
    int b = i >> 10, k = i & 1023;
    float v = p.c[i];
    cond[k * 16 + b] = siluf_(v);
  }
  __syncthreads();
  const int kq = tid >> 4, col = tid & 15;
  float acc[16];
#pragma unroll
  for (int b = 0; b < 16; ++b) acc[b] = 0.f;
  const float* w = p.ada_w + (size_t)l * 1024 * 3072 + n0 + col;
#pragma unroll 16
  for (int k = kq * 64; k < kq * 64 + 64; ++k) {
    float wv = __builtin_nontemporal_load(w + (size_t)k * 3072);
    const float4* cp = (const float4*)(cond + k * 16);
    float4 c0 = cp[0], c1 = cp[1], c2 = cp[2], c3 = cp[3];
    acc[0] += wv * c0.x; acc[1] += wv * c0.y; acc[2] += wv * c0.z; acc[3] += wv * c0.w;
    acc[4] += wv * c1.x; acc[5] += wv * c1.y; acc[6] += wv * c1.z; acc[7] += wv * c1.w;
    acc[8] += wv * c2.x; acc[9] += wv * c2.y; acc[10] += wv * c2.z; acc[11] += wv * c2.w;
    acc[12] += wv * c3.x; acc[13] += wv * c3.y; acc[14] += wv * c3.z; acc[15] += wv * c3.w;
  }
  __syncthreads();
  float* red = (float*)smem;
#pragma unroll
  for (int b = 0; b < 16; ++b) red[(kq * 16 + b) * 16 + col] = acc[b];
  __syncthreads();
  float* mod = (float*)(p.ws + OFF_MOD);
  {
    const int b = tid >> 4, cc = tid & 15;
    float s = 0.f;
#pragma unroll
    for (int q = 0; q < 16; ++q) s += red[(q * 16 + b) * 16 + cc];
    mod[(size_t)(l * 16 + b) * 3072 + n0 + cc] = s + p.ada_b[l * 3072 + n0 + cc];
  }
}

DI void b1eff_item(const Params& p, int item, char* smem) {
  const int tid = tidx();
  const int li = item >> 4, h0 = (item & 15) * 16;
  const int kg = tid >> 4, hh = tid & 15;
  const float* W1 = p.cmp_w1 + (size_t)li * 2048 * 256;
  const float* pe = p.cmp_pe + li * 2048;
  float acc = 0.f;
#pragma unroll 16
  for (int k = kg * 128; k < kg * 128 + 128; ++k) acc += pe[k] * __builtin_nontemporal_load(W1 + (size_t)k * 256 + h0 + hh);
  float* red = (float*)smem;
  __syncthreads();
  red[kg * 16 + hh] = acc;
  __syncthreads();
  if (tid < 16) {
    float s = 0.f;
    for (int g = 0; g < 16; ++g) s += red[g * 16 + tid];
    ((float*)(p.ws + OFF_B1EFF))[li * 256 + h0 + tid] = s + p.cmp_b1[li * 256 + h0 + tid];
  }
}

DI void rope_item(const Params& p, int item) {
  const int idx = item * 256 + tidx();
  const int tok = idx >> 3, i = idx & 7;
  const float invf[8] = {1.0f, 0.1939227432012558f, 0.03760603070259094f, 0.007292664609849453f,
                         0.0014142135623842478f, 0.00027424818836152554f, 5.318296098266728e-05f, 1.0313386155758053e-05f};
  float f = i == 0 ? invf[0] : i == 1 ? invf[1] : i == 2 ? invf[2] : i == 3 ? invf[3] : i == 4 ? invf[4] : i == 5 ? invf[5] : i == 6 ? invf[6] : invf[7];
  float ang = (float)p.pos[tok] * f;
  double rev = (double)ang * 0.15915494309189535;
  double fr = rev - floor(rev);
  float frf = (float)fr;
  float* rope = (float*)(p.ws + OFF_ROPE);
  rope[(size_t)tok * 16 + i] = __builtin_amdgcn_cosf(frf);
  rope[(size_t)tok * 16 + 8 + i] = __builtin_amdgcn_sinf(frf);
}

DI void transpose_item(const float* __restrict__ src, int K, int Nsrc, bf16_t* __restrict__ dst, int k0, int n0, int mapmode, char* smem) {
  float* tile = (float*)smem;
  const int tid = tidx();
  __syncthreads();
  float tv[16];
#pragma unroll
  for (int i = 0; i < 16; ++i) {
    int kk = i * 4 + (tid >> 6), nn = tid & 63;
    int nd = n0 + nn, ns = nd;
    if (mapmode == 1 || mapmode == 2) {
      const int rho = nd & 255;
      ns = (nd & ~255) + 64 * ((rho >> 5) & 3) + 32 * (rho >> 7) + (rho & 31);
    }
    if (mapmode == 1) ns = ns < 2560 ? ns : ns + 48;
    if (mapmode == 3) ns = nd < 48 ? 2560 + nd : -1;
    tv[i] = ns >= 0 ? __builtin_nontemporal_load(src + (size_t)(k0 + kk) * Nsrc + ns) : 0.f;
  }
#pragma unroll
  for (int i = 0; i < 16; ++i) {
    int kk = i * 4 + (tid >> 6), nn = tid & 63;
    tile[kk * 65 + nn] = tv[i];
  }
  __syncthreads();
#pragma unroll
  for (int i = 0; i < 8; ++i) {
    const int nn = i * 8 + (tid >> 5), kk2 = (tid & 31) * 2;
    const unsigned u = pack_bf2(tile[kk2 * 65 + nn], tile[(kk2 + 1) * 65 + nn]);
    *(unsigned*)(dst + (size_t)(n0 + nn) * K + k0 + kk2) = u;
  }
}

constexpr int NW_ADA = 768, NW_B1 = 64, NW_ROPE = 1024;
constexpr int NW_T_NSA_IN = 16 * 56, NW_T_SQ = 256, NW_T_MOBA_IN = 16 * 40, NW_T_CMP = 128, NW_T_GL = 16 * 2;
constexpr int NW_TRANS = 2 * NW_T_NSA_IN + 2 * NW_T_SQ + 2 * NW_T_MOBA_IN + 2 * NW_T_SQ + 4 * NW_T_CMP + 2 * NW_T_GL;
constexpr int NW_TOTAL = NW_ADA + NW_B1 + NW_ROPE + NW_TRANS;

DI void phaseW_item(const Params& p, int it, char* smem) {
  if (it < NW_ADA) { ada_item(p, it, smem); return; }
  it -= NW_ADA;
  if (it < NW_B1) { b1eff_item(p, it, smem); return; }
  it -= NW_B1;
  if (it < NW_ROPE) { rope_item(p, it); return; }
  it -= NW_ROPE;
  if (it < 2 * NW_T_NSA_IN) {
    int l = it / NW_T_NSA_IN, t = it % NW_T_NSA_IN;
    transpose_item(p.nsa_w_in + (size_t)l * 1024 * NSA_IN, 1024, NSA_IN, (bf16_t*)(p.ws + OFF_WT_NSA_IN) + (size_t)l * NSA_NP * 1024,
                   (t % 16) * 64, (t / 16) * 64, 1, smem);
    return;
  }
  it -= 2 * NW_T_NSA_IN;
  if (it < 2 * NW_T_SQ) {
    int l = it / NW_T_SQ, t = it % NW_T_SQ;
    transpose_item(p.nsa_w_out + (size_t)l * 1024 * 1024, 1024, 1024, (bf16_t*)(p.ws + OFF_WT_NSA_OUT) + (size_t)l * 1024 * 1024,
                   (t % 16) * 64, (t / 16) * 64, 2, smem);
    return;
  }
  it -= 2 * NW_T_SQ;
  if (it < 2 * NW_T_MOBA_IN) {
    int l = it / NW_T_MOBA_IN, t = it % NW_T_MOBA_IN;
    transpose_item(p.moba_w_in + (size_t)l * 1024 * MOBA_IN, 1024, MOBA_IN, (bf16_t*)(p.ws + OFF_WT_MOBA_IN) + (size_t)l * MOBA_IN * 1024,
                   (t % 16) * 64, (t / 16) * 64, 2, smem);
    return;
  }
  it -= 2 * NW_T_MOBA_IN;
  if (it < 2 * NW_T_SQ) {
    int l = it / NW_T_SQ, t = it % NW_T_SQ;
    transpose_item(p.moba_w_out + (size_t)l * 1024 * 1024, 1024, 1024, (bf16_t*)(p.ws + OFF_WT_MOBA_OUT) + (size_t)l * 1024 * 1024,
                   (t % 16) * 64, (t / 16) * 64, 2, smem);
    return;
  }
  it -= 2 * NW_T_SQ;
  if (it < 4 * NW_T_CMP) {
    int li = it / NW_T_CMP, t = it % NW_T_CMP;
    transpose_item(p.cmp_w1 + (size_t)li * 2048 * 256, 2048, 256, (bf16_t*)(p.ws + OFF_WT_CMP1) + (size_t)li * 256 * 2048,
                   (t % 32) * 64, (t / 32) * 64, 0, smem);
    return;
  }
  it -= 4 * NW_T_CMP;
  {
    int l = it / NW_T_GL, t = it % NW_T_GL;
    transpose_item(p.nsa_w_in + (size_t)l * 1024 * NSA_IN, 1024, NSA_IN, (bf16_t*)(p.ws + OFF_WT_GL) + (size_t)l * 128 * 1024,
                   (t % 16) * 64, (t / 16) * 64, 3, smem);
  }
}

DI void prep_item(const Params& p, int layer, const float* __restrict__ xin, int item) {
  const int lane = tidx() & 63, w = tidx() >> 6;
  const int tok0 = item * 16 + w * 4;
  const int b = tok0 >> 11;
  f32x4 v[4][4];
#pragma unroll
  for (int r = 0; r < 4; ++r)
#pragma unroll
    for (int i = 0; i < 4; ++i) v[r][i] = *(const f32x4*)(xin + (size_t)(tok0 + r) * 1024 + (lane + i * 64) * 4);
  const float* mod = (const float*)(p.ws + OFF_MOD) + (size_t)(layer * 16 + b) * 3072;
  f32x4 gs[4], sh[4];
#pragma unroll
  for (int i = 0; i < 4; ++i) {
    const int c = (lane + i * 64) * 4;
    const f32x4 g = *(const f32x4*)(p.norm_g + layer * 1024 + c);
    const f32x4 sc = *(const f32x4*)(mod + 1024 + c);
    sh[i] = *(const f32x4*)(mod + c);
    gs[i] = g * (sc + 1.f);
  }
#pragma unroll
  for (int r = 0; r < 4; ++r) {
    float ss = 0.f;
#pragma unroll
    for (int i = 0; i < 4; ++i) ss += v[r][i][0] * v[r][i][0] + v[r][i][1] * v[r][i][1] + v[r][i][2] * v[r][i][2] + v[r][i][3] * v[r][i][3];
#pragma unroll
    for (int o = 32; o >= 1; o >>= 1) ss += __shfl_xor(ss, o);
    const float rstd = __builtin_amdgcn_rsqf(ss * (1.f / 1024.f) + EPS);
    bf16_t* hr = (bf16_t*)(p.ws + OFF_H) + (size_t)(tok0 + r) * 1024;
#pragma unroll
    for (int i = 0; i < 4; ++i) {
      const f32x4 a = v[r][i] * rstd * gs[i] + sh[i];
      u32x2 o;
      o.x = pack_bf2(a[0], a[1]);
      o.y = pack_bf2(a[2], a[3]);
      *(u32x2*)(hr + (lane + i * 64) * 4) = o;
    }
  }
}

template <bool SWAP>
DI void gemm_mainloop(const bf16_t* __restrict__ A, const unsigned (&aoff)[4], int a_kstride, const bf16_t* __restrict__ Bt, int K, int n0,
                      char* smem, f32x4 (&acc)[4][4], int ldb = 0) {
  if (ldb == 0) ldb = K;
  bf16_t* sA = (bf16_t*)smem;
  bf16_t* sB = (bf16_t*)(smem + 36864);
  const int tid = tidx(), lane = tid & 63, w = tid >> 6;
  const int wm = w >> 1, wn = w & 1, c16 = lane & 15, lg = lane >> 4;
  const int r0 = tid >> 3, c8 = tid & 7;
  const int nk = K >> 6;
  u32x4 ra[4], rb[4];
  const bf16_t* bbase = Bt + (size_t)(n0 + r0) * ldb + c8 * 8;
#pragma unroll
  for (int i = 0; i < 4; ++i) {
    ra[i] = *(const u32x4*)(A + aoff[i] + c8 * 8);
    rb[i] = *(const u32x4*)(bbase + (size_t)i * 32 * ldb);
  }
#pragma unroll
  for (int a = 0; a < 4; ++a)
#pragma unroll
    for (int b = 0; b < 4; ++b) acc[a][b] = f32x4{0.f, 0.f, 0.f, 0.f};
  __syncthreads();
  for (int kt = 0; kt < nk; ++kt) {
    const int buf = kt & 1;
    bf16_t* cA = sA + buf * (128 * 72);
    bf16_t* cB = sB + buf * (128 * 72);
#pragma unroll
    for (int i = 0; i < 4; ++i) {
      *(u32x4*)(cA + (r0 + 32 * i) * 72 + c8 * 8) = ra[i];
      *(u32x4*)(cB + (r0 + 32 * i) * 72 + c8 * 8) = rb[i];
    }
    lds_barrier();
    if (kt + 1 < nk) {
#pragma unroll
      for (int i = 0; i < 4; ++i) {
        ra[i] = *(const u32x4*)(A + aoff[i] + (size_t)(kt + 1) * a_kstride + c8 * 8);
        rb[i] = *(const u32x4*)(bbase + (size_t)i * 32 * ldb + (kt + 1) * 64);
      }
    }
#pragma unroll
    for (int ks = 0; ks < 2; ++ks) {
      bf16x8 af[4], bfr[4];
#pragma unroll
      for (int mt = 0; mt < 4; ++mt) af[mt] = *(const bf16x8*)(cA + (wm * 64 + mt * 16 + c16) * 72 + ks * 32 + lg * 8);
#pragma unroll
      for (int nt = 0; nt < 4; ++nt) bfr[nt] = *(const bf16x8*)(cB + (wn * 64 + nt * 16 + c16) * 72 + ks * 32 + lg * 8);
#pragma unroll
      for (int mt = 0; mt < 4; ++mt)
#pragma unroll
        for (int nt = 0; nt < 4; ++nt) {
          if (SWAP) acc[nt][mt] = mfma16(bfr[nt], af[mt], acc[nt][mt]);
          else acc[mt][nt] = mfma16(af[mt], bfr[nt], acc[mt][nt]);
        }
    }
  }
}

DI void epi_normrope(f32x4 (&acc)[4][4], int m_base  , int ncol_base  ,
                     bf16_t* __restrict__ dst, int ld, const float* __restrict__ gw, const float* __restrict__ rope, float oscale) {
  const int lane = tidx() & 63, c16 = lane & 15, lg = lane >> 4;
  float gwv[4][4];
#pragma unroll
  for (int nt = 0; nt < 4; ++nt)
#pragma unroll
    for (int j = 0; j < 4; ++j) gwv[nt][j] = gw[nt * 16 + lg * 4 + j];
#pragma unroll
  for (int mt = 0; mt < 4; ++mt) {
    const int m = m_base + mt * 16 + c16;
    float ss = 0.f;
#pragma unroll
    for (int nt = 0; nt < 4; ++nt)
#pragma unroll
      for (int j = 0; j < 4; ++j) ss += acc[nt][mt][j] * acc[nt][mt][j];
    ss += __shfl_xor(ss, 16);
    ss += __shfl_xor(ss, 32);
    const float rstd = __builtin_amdgcn_rsqf(ss * (1.f / 64.f) + EPS);
    float v[4][4];
#pragma unroll
    for (int nt = 0; nt < 4; ++nt)
#pragma unroll
      for (int j = 0; j < 4; ++j) v[nt][j] = acc[nt][mt][j] * rstd * gwv[nt][j];
    const float4 cs = *(const float4*)(rope + (size_t)m * 16 + (lg & 1) * 4);
    const float4 sn = *(const float4*)(rope + (size_t)m * 16 + 8 + (lg & 1) * 4);
    const float csv[4] = {cs.x, cs.y, cs.z, cs.w};
    const float snv[4] = {sn.x, sn.y, sn.z, sn.w};
#pragma unroll
    for (int j = 0; j < 4; ++j) {
      float mine = v[0][j];
      float other = __shfl_xor(mine, 32);
      float r = (lg < 2) ? (mine * csv[j] - other * snv[j]) : (mine * csv[j] + other * snv[j]);
      v[0][j] = r;
    }
#pragma unroll
    for (int nt = 0; nt < 4; ++nt) {
      u32x2 o;
      o.x = pack_bf2(v[nt][0] * oscale, v[nt][1] * oscale);
      o.y = pack_bf2(v[nt][2] * oscale, v[nt][3] * oscale);
      *(u32x2*)(dst + (size_t)m * ld + ncol_base + nt * 16 + lg * 4) = o;
    }
  }
}

template <int MODE>
DI void epi_store_bf16(f32x4 (&acc)[4][4], int m_base, int ncol_base, bf16_t* __restrict__ dst, int ld, const float* __restrict__ bias) {
  const int lane = tidx() & 63, c16 = lane & 15, lg = lane >> 4;
#pragma unroll
  for (int mt = 0; mt < 4; ++mt) {
    const int m = m_base + mt * 16 + c16;
#pragma unroll
    for (int nt = 0; nt < 4; ++nt) {
      float v[4];
#pragma unroll
      for (int j = 0; j < 4; ++j) {
        float a = acc[nt][mt][j];
        if (MODE == 1) a = siluf_(a);
        if (MODE == 2) a = geluf_(a + bias[ncol_base + nt * 16 + lg * 4 + j]);
        v[j] = a;
      }
      u32x2 o;
      o.x = pack_bf2(v[0], v[1]);
      o.y = pack_bf2(v[2], v[3]);
      *(u32x2*)(dst + (size_t)m * ld + ncol_base + nt * 16 + lg * 4) = o;
    }
  }
}

DI void epi_store_vt(f32x4 (&acc)[4][4], int m_base, int col_base, bf16_t* __restrict__ vt) {
  const int lane = tidx() & 63, c16 = lane & 15, lg = lane >> 4;
#pragma unroll
  for (int mt = 0; mt < 4; ++mt) {
    const int m = m_base + mt * 16 + lg * 4;
    const int b = m >> 11, s = m & 2047;
#pragma unroll
    for (int nt = 0; nt < 4; ++nt) {
      const int col = col_base + nt * 16 + c16;
      const int gh = col >> 6, d = col & 63;
      u32x2 o;
      o.x = pack_bf2(acc[mt][nt][0], acc[mt][nt][1]);
      o.y = pack_bf2(acc[mt][nt][2], acc[mt][nt][3]);
      *(u32x2*)(vt + ((size_t)((b * 4 + gh) * 64 + d)) * 2048 + s) = o;
    }
  }
}

#ifndef PROBE_T
#define PROBE_T -1
#endif
namespace g8 {
constexpr int BM = 256, BK = 64, HALF = 128, HTB = HALF * BK * 2, NXCD = 8, WGM = 8;
DI int lds_byte(int r, int c) { const int st = (r >> 4) * 2 + (c >> 5), rr = r & 15, cc = c & 31, ob = rr * 64 + cc * 2; return st * 1024 + (ob ^ (((ob >> 9) & 1) << 5)); }
DI void stage_rc(int b, int& R, int& C) { const int st = b / 1024, sb = b % 1024, swz = sb ^ (((sb >> 9) & 1) << 5); R = (st >> 1) * 16 + swz / 64; C = (st & 1) * 32 + (swz % 64) / 2; }
struct Unit { int pm, pn; };
struct StaticOrder {
  int nM, nN, nwg, G, c;
  DI void init(int M, int N, int G_, int c_) { nM = M / BM; nN = N / BM; nwg = nM * nN; G = G_; c = c_; }
  DI bool next(int i, Unit& u) const {
    const long L = (long)i * G + c; if (L >= nwg) return false;
    int wgid = (int)L; { const int q = nwg / NXCD, r = nwg % NXCD, xcd = wgid % NXCD, off = wgid / NXCD; wgid = (xcd < r ? xcd * (q + 1) : r * (q + 1) + (xcd - r) * q) + off; }
    const int nig = WGM * nN, gid = wgid / nig, fm = gid * WGM, gsz = (nM - fm) < WGM ? (nM - fm) : WGM;
    u.pm = fm + ((wgid % nig) % gsz); u.pn = (wgid % nig) / gsz; return true;
  }
};
template <class Epi>
DI void gemm_phase(LAS unsigned char* lds, const bf16_t* gA, const bf16_t* gBt, int K, const StaticOrder& S, const Epi& E, unsigned long long& eticks) {
  int tid = __builtin_amdgcn_workitem_id_x();
  asm volatile("" : "+v"(tid));
  const int wid = __builtin_amdgcn_readfirstlane(tid >> 6), lane = tid & 63, wr = wid >> 2, wc = wid & 3, fr = lane & 15, fq = lane >> 4;
  const int nt = K / BK;
  unsigned voffA[2], voffB[2];
#pragma unroll
  for (int i = 0; i < 2; ++i) { int R, C; stage_rc(tid * 16 + i * 8192, R, C); voffA[i] = (unsigned)(R * K + C) * 2u; voffB[i] = voffA[i]; }
  const size_t kstep = (size_t)(BK * 2);
  const size_t hstep = (size_t)HALF * K * 2;
  const size_t tstep = 2 * hstep;
  const unsigned ldsw = (unsigned)wid * 1024u;
  const int aoff = lds_byte(wr * 64 + fr, fq * 8), boff = lds_byte(wc * 32 + fr, fq * 8);
#define G8_SA(b, h) (((b) * 2 + (h)) * HTB)
#define G8_SB(b, h) ((4 + (b) * 2 + (h)) * HTB)
#define G8_STAGE(bufoff, gbase, voff) do { _Pragma("unroll") for (int _i = 0; _i < 2; ++_i) \
    __builtin_amdgcn_global_load_lds((const unsigned*)((const char*)(gbase) + (voff)[_i]), (LAS unsigned*)(lds + (bufoff) + ldsw + _i * 8192), 16, 0, 0); } while (0)
#define G8_LDA(dst, b, h) do { _Pragma("unroll") for (int m = 0; m < 4; ++m) _Pragma("unroll") for (int k = 0; k < 2; ++k) dst[m][k] = *(const LAS bf16x8*)(lds + G8_SA(b, h) + aoff + m * 2048 + k * 1024); } while (0)
#define G8_LDB(dst, b, h) do { _Pragma("unroll") for (int n = 0; n < 2; ++n) _Pragma("unroll") for (int k = 0; k < 2; ++k) dst[n][k] = *(const LAS bf16x8*)(lds + G8_SB(b, h) + boff + n * 2048 + k * 1024); } while (0)
#define G8_MMA(ai, bj, At, Bt) do { __builtin_amdgcn_s_setprio(1); _Pragma("unroll") for (int m = 0; m < 4; ++m) _Pragma("unroll") for (int n = 0; n < 2; ++n) _Pragma("unroll") for (int k = 0; k < 2; ++k) \
    acc[ai][bj][m][n] = __builtin_amdgcn_mfma_f32_16x16x32_bf16(Bt[n][k], At[m][k], acc[ai][bj][m][n], 0, 0, 0); __builtin_amdgcn_s_setprio(0); } while (0)
#define G8_WAIT_V(n) asm volatile("s_waitcnt vmcnt(" #n ")" ::: "memory")
#define G8_WAIT_L(n) asm volatile("s_waitcnt lgkmcnt(" #n ")" ::: "memory")
#define G8_BAR __builtin_amdgcn_s_barrier()
#define G8_SCHED __builtin_amdgcn_sched_barrier(0)
  Unit cur, nxt; int ui = 0;
  if (!S.next(0, cur)) return;
  f32x4 acc[2][2][4][2];
#pragma unroll
  for (int a = 0; a < 2; ++a)
#pragma unroll
    for (int b = 0; b < 2; ++b)
#pragma unroll
      for (int m = 0; m < 4; ++m)
#pragma unroll
        for (int n = 0; n < 2; ++n) acc[a][b][m][n] = (f32x4){0.f, 0.f, 0.f, 0.f};
  bf16x8 At[4][2], B0[2][2], B1[2][2];
  const char* cA = (const char*)gA + (size_t)cur.pm * tstep; const char* cB = (const char*)gBt + (size_t)cur.pn * tstep;
  G8_STAGE(G8_SB(0, 0), cB, voffB); G8_STAGE(G8_SA(0, 0), cA, voffA); G8_STAGE(G8_SB(0, 1), cB + hstep, voffB); G8_STAGE(G8_SA(0, 1), cA + hstep, voffA);
  if (wr == 1) G8_BAR;
  G8_WAIT_V(4); G8_BAR;
  G8_STAGE(G8_SB(1, 0), cB + kstep, voffB); G8_STAGE(G8_SA(1, 0), cA + kstep, voffA); G8_STAGE(G8_SB(1, 1), cB + hstep + kstep, voffB);
  G8_WAIT_V(6); G8_BAR;
  for (;;) {
    const bool has_next = S.next(ui + 1, nxt);
    const char* nA = has_next ? (const char*)gA + (size_t)nxt.pm * tstep : cA; const char* nB = has_next ? (const char*)gBt + (size_t)nxt.pn * tstep : cB;
    for (int t = 0; t < nt; t += 2) {
      const bool last = (t == nt - 2);
      const char* a1 = cA + (size_t)(t + 1) * kstep;
      const char* a2 = last ? nA : cA + (size_t)(t + 2) * kstep; const char* b2 = last ? nB : cB + (size_t)(t + 2) * kstep;
      const char* a3 = a2 + kstep; const char* b3 = b2 + kstep;
      G8_LDB(B0, 0, 0); G8_SCHED; G8_LDA(At, 0, 0); G8_STAGE(G8_SA(1, 1), a1 + hstep, voffA);
      G8_WAIT_L(8); G8_BAR; G8_WAIT_L(0); G8_MMA(0, 0, At, B0); G8_BAR; G8_SCHED;
      G8_LDB(B1, 0, 1); G8_STAGE(G8_SB(0, 0), b2, voffB);
      G8_BAR; G8_WAIT_L(0); G8_MMA(0, 1, At, B1); G8_BAR;
      G8_LDA(At, 0, 1); G8_STAGE(G8_SA(0, 0), a2, voffA);
      G8_BAR; G8_WAIT_L(0); G8_MMA(1, 0, At, B0); G8_BAR; G8_SCHED;
      G8_STAGE(G8_SB(0, 1), b2 + hstep, voffB);
      G8_WAIT_V(6); G8_BAR; G8_MMA(1, 1, At, B1); G8_BAR;
      G8_LDB(B0, 1, 0); G8_SCHED; G8_LDA(At, 1, 0); G8_STAGE(G8_SA(0, 1), a2 + hstep, voffA);
      G8_WAIT_L(8); G8_BAR; G8_WAIT_L(0); G8_MMA(0, 0, At, B0); G8_BAR; G8_SCHED;
      G8_LDB(B1, 1, 1); G8_STAGE(G8_SB(1, 0), b3, voffB);
      G8_BAR; G8_WAIT_L(0); G8_MMA(0, 1, At, B1); G8_BAR;
      G8_LDA(At, 1, 1); G8_STAGE(G8_SA(1, 0), a3, voffA);
      G8_BAR; G8_WAIT_L(0); G8_MMA(1, 0, At, B0); G8_BAR; G8_SCHED;
      G8_STAGE(G8_SB(1, 1), b3 + hstep, voffB);
      G8_WAIT_V(6); G8_BAR; G8_MMA(1, 1, At, B1); G8_BAR;
    }
    if (PROBE_T == 8 || PROBE_T == 9) {
      const unsigned long long _t0 = wall_clock64();
      E(acc, cur, wr, wc, fr, fq);
      if (PROBE_T == 9) asm volatile("s_waitcnt vmcnt(0)" ::: "memory");
      eticks += wall_clock64() - _t0;
    } else {
      E(acc, cur, wr, wc, fr, fq);
    }
    if (!has_next) break;
#pragma unroll
    for (int a = 0; a < 2; ++a)
#pragma unroll
      for (int b = 0; b < 2; ++b)
#pragma unroll
        for (int m = 0; m < 4; ++m)
#pragma unroll
          for (int n = 0; n < 2; ++n) acc[a][b][m][n] = (f32x4){0.f, 0.f, 0.f, 0.f};
    cur = nxt; cA = nA; cB = nB; ++ui;
  }
  G8_WAIT_V(0);
  if (wr == 0) G8_BAR;
  G8_BAR;
#undef G8_SA
#undef G8_SB
#undef G8_STAGE
#undef G8_LDA
#undef G8_LDB
#undef G8_MMA
#undef G8_WAIT_V
#undef G8_WAIT_L
#undef G8_BAR
#undef G8_SCHED
}
}

typedef const f32x4 (&Acc8)[2][2][4][2];
DI void epi8_normrope(Acc8 acc, int row0, int colbase, bf16_t* __restrict__ dst, int ld, const float* __restrict__ gw, const float* __restrict__ rope,
                      float oscale, int fq) {
  float gwv[2][2][4];
#pragma unroll
  for (int bj = 0; bj < 2; ++bj)
#pragma unroll
    for (int n = 0; n < 2; ++n)
#pragma unroll
      for (int j = 0; j < 4; ++j) gwv[bj][n][j] = gw[32 * bj + 16 * n + 4 * fq + j];
#pragma unroll
  for (int am = 0; am < 4; ++am) {
    const int ai = am >> 1;
    f32x4 csv[2], snv[2];
#pragma unroll
    for (int mm = 0; mm < 2; ++mm) {
      const int r = row0 + 128 * ai + 16 * ((am & 1) * 2 + mm);
      csv[mm] = *(const f32x4*)(rope + (size_t)r * 16 + (fq & 1) * 4);
      snv[mm] = *(const f32x4*)(rope + (size_t)r * 16 + 8 + (fq & 1) * 4);
    }
#pragma unroll
    for (int mm = 0; mm < 2; ++mm) {
      const int m = (am & 1) * 2 + mm;
      const int r = row0 + 128 * ai + 16 * m;
      float ss = 0.f;
#pragma unroll
      for (int bj = 0; bj < 2; ++bj)
#pragma unroll
        for (int n = 0; n < 2; ++n)
#pragma unroll
          for (int j = 0; j < 4; ++j) ss += acc[ai][bj][m][n][j] * acc[ai][bj][m][n][j];
      ss += __shfl_xor(ss, 16);
      ss += __shfl_xor(ss, 32);
      const float rstd = __builtin_amdgcn_rsqf(ss * (1.f / 64.f) + EPS);
      float v[2][2][4];
#pragma unroll
      for (int bj = 0; bj < 2; ++bj)
#pragma unroll
        for (int n = 0; n < 2; ++n)
#pragma unroll
          for (int j = 0; j < 4; ++j) v[bj][n][j] = acc[ai][bj][m][n][j] * rstd * gwv[bj][n][j];
      const f32x4 cs = csv[mm], sn = snv[mm];
#pragma unroll
      for (int j = 0; j < 4; ++j) {
        const float mine = v[0][0][j];
        const float other = __shfl_xor(mine, 32);
        v[0][0][j] = (fq < 2) ? (mine * cs[j] - other * sn[j]) : (mine * cs[j] + other * sn[j]);
      }
#pragma unroll
      for (int bj = 0; bj < 2; ++bj)
#pragma unroll
        for (int n = 0; n < 2; ++n) {
          u32x2 o;
          o.x = pack_bf2(v[bj][n][0] * oscale, v[bj][n][1] * oscale);
          o.y = pack_bf2(v[bj][n][2] * oscale, v[bj][n][3] * oscale);
          *(u32x2*)(dst + (size_t)r * ld + colbase + 32 * bj + 16 * n + 4 * fq) = o;
        }
    }
  }
}
template <int MODE>
DI void epi8_store_bf16(Acc8 acc, int row0, int colbase, bf16_t* __restrict__ dst, int ld, int fq) {
#pragma unroll
  for (int ai = 0; ai < 2; ++ai)
#pragma unroll
    for (int m = 0; m < 4; ++m) {
      const int r = row0 + 128 * ai + 16 * m;
#pragma unroll
      for (int bj = 0; bj < 2; ++bj)
#pragma unroll
        for (int n = 0; n < 2; ++n) {
          float v[4];
#pragma unroll
          for (int j = 0; j < 4; ++j) { float a = acc[ai][bj][m][n][j]; if (MODE == 1) a = siluf_(a); v[j] = a; }
          u32x2 o;
          o.x = pack_bf2(v[0], v[1]);
          o.y = pack_bf2(v[2], v[3]);
          *(u32x2*)(dst + (size_t)r * ld + colbase + 32 * bj + 16 * n + 4 * fq) = o;
        }
    }
}
DI void epi8_store_vt(Acc8 acc, int row0, int gh, bf16_t* __restrict__ vt, int fr, int fq) {
  const int q = fr & 3;
  const bool odd = (q & 1) != 0, upper = q >= 2;
  const int dsel = 2 * (q & 1) + (q >> 1);
#pragma unroll
  for (int ai = 0; ai < 2; ++ai)
#pragma unroll
    for (int m = 0; m < 4; ++m) {
      const int r = row0 + 128 * ai + 16 * m;
      const int b = r >> 11, sb = (r & 2047) - q;
#pragma unroll
      for (int bj = 0; bj < 2; ++bj)
#pragma unroll
        for (int n = 0; n < 2; ++n) {
          const float v0 = acc[ai][bj][m][n][0], v1 = acc[ai][bj][m][n][1], v2 = acc[ai][bj][m][n][2], v3 = acc[ai][bj][m][n][3];
          const float s0 = odd ? v0 : v2, s1 = odd ? v1 : v3;
          const float r0 = qxor1(s0), r1 = qxor1(s1);
          const float w0 = odd ? r0 : v0, w1 = odd ? r1 : v1, w2 = odd ? v2 : r0, w3 = odd ? v3 : r1;
          const float t0 = upper ? w0 : w1, t1 = upper ? w2 : w3;
          const float x0 = qxor2(t0), x1 = qxor2(t1);
          const float o0 = upper ? x0 : w0, o1 = upper ? x1 : w2, o2 = upper ? w1 : x0, o3 = upper ? w3 : x1;
          const int d = 32 * bj + 16 * n + 4 * fq + dsel;
          u32x2 o;
          o.x = pack_bf2(o0, o1);
          o.y = pack_bf2(o2, o3);
          *(u32x2*)(vt + ((size_t)((b * 4 + gh) * 64 + d)) * 2048 + sb) = o;
        }
    }
}

struct InProjEpi {
  Params p; int layer;
  DI void operator()(Acc8 acc, const g8::Unit& u, int wr, int wc, int fr, int fq) const {
    const bool nsa = (layer & 1) == 0;
    const int lj = layer >> 1;
    const int pn = u.pn;
    const int row0 = u.pm * 256 + wr * 64 + fr;
    const float* rope = (const float*)(p.ws + OFF_ROPE);
    if (pn < 4) {
      epi8_normrope(acc, row0, pn * 256 + wc * 64, (bf16_t*)(p.ws + OFF_Q), 1024, (nsa ? p.nsa_qn : p.moba_qn) + lj * 64, rope, QSCALE, fq);
    } else if (nsa) {
      if (pn == 4) epi8_store_bf16<0>(acc, row0, wc * 64, (bf16_t*)(p.ws + OFF_KC), 256, fq);
      else if (pn == 5) epi8_store_bf16<0>(acc, row0, wc * 64, (bf16_t*)(p.ws + OFF_VC), 256, fq);
      else if (pn == 6) epi8_normrope(acc, row0, wc * 64, (bf16_t*)(p.ws + OFF_KS), 256, p.nsa_kn + (lj * 3 + 1) * 64, rope, 1.0f, fq);
      else if (pn == 7) epi8_store_vt(acc, row0, wc, (bf16_t*)(p.ws + OFF_VST), fr, fq);
      else if (pn == 8) epi8_normrope(acc, row0, wc * 64, (bf16_t*)(p.ws + OFF_KW), 256, p.nsa_kn + (lj * 3 + 2) * 64, rope, 1.0f, fq);
      else if (pn == 9) epi8_store_vt(acc, row0, wc, (bf16_t*)(p.ws + OFF_VWT), fr, fq);
      else epi8_store_bf16<1>(acc, row0, (pn - 10) * 256 + wc * 64, (bf16_t*)(p.ws + OFF_SZ), 1024, fq);
    } else {
      if (pn == 4) epi8_normrope(acc, row0, wc * 64, (bf16_t*)(p.ws + OFF_KS), 256, p.moba_kn + lj * 64, rope, 1.0f, fq);
      else if (pn == 5) epi8_store_vt(acc, row0, wc, (bf16_t*)(p.ws + OFF_VST), fr, fq);
      else epi8_store_bf16<1>(acc, row0, (pn - 6) * 256 + wc * 64, (bf16_t*)(p.ws + OFF_SZ), 1024, fq);
    }
  }
};
struct OutProjEpi {
  Params p; int layer; const float* xin;
  DI void operator()(Acc8 acc, const g8::Unit& u, int wr, int wc, int fr, int fq) const {
    const int row0 = u.pm * 256 + wr * 64 + fr;
    const int b = (u.pm * 256) >> 11;
    const float* gatev = (const float*)(p.ws + OFF_MOD) + (size_t)(layer * 16 + b) * 3072 + 2048;
#pragma unroll
    for (int bj = 0; bj < 2; ++bj)
#pragma unroll
      for (int n = 0; n < 2; ++n) {
        const int c = u.pn * 256 + wc * 64 + 32 * bj + 16 * n + 4 * fq;
        const f32x4 gv = *(const f32x4*)(gatev + c);
        f32x4 xv[2][4];
#pragma unroll
        for (int ai = 0; ai < 2; ++ai)
#pragma unroll
          for (int m = 0; m < 4; ++m) xv[ai][m] = *(const f32x4*)(xin + (size_t)(row0 + 128 * ai + 16 * m) * 1024 + c);
#pragma unroll
        for (int ai = 0; ai < 2; ++ai)
#pragma unroll
          for (int m = 0; m < 4; ++m) *(f32x4*)(p.out + (size_t)(row0 + 128 * ai + 16 * m) * 1024 + c) = xv[ai][m] + gv * acc[ai][bj][m][n];
      }
  }
};

DI void gates_tile(const Params& p, int lj, int item, char* smem) {
  const int tile = item >> 1, kh = item & 1;
  const int m0 = tile * 128;
  const int tid = tidx(), lane = tid & 63, w = tid >> 6, wm = w >> 1, wn = w & 1, c16 = lane & 15, lg = lane >> 4;
  const bf16_t* A = (const bf16_t*)(p.ws + OFF_H);
  const bf16_t* Bt = (const bf16_t*)(p.ws + OFF_WT_GL) + (size_t)lj * 128 * 1024 + kh * 512;
  unsigned aoff[4];
#pragma unroll
  for (int i = 0; i < 4; ++i) aoff[i] = (unsigned)(m0 + (tid >> 3) + 32 * i) * 1024u + kh * 512u;
  f32x4 acc[4][4];
  gemm_mainloop<true>(A, aoff, 64, Bt, 512, 0, smem, acc, 1024);
  __syncthreads();
  f32x4* red = (f32x4*)(kh ? smem : smem + SMEM_BYTES) + tid;
  if (kh == 1) {
#pragma unroll
    for (int a = 0; a < 3; ++a)
#pragma unroll
      for (int b = 0; b < 4; ++b) red[(a * 4 + b) * 256] = acc[a][b];
  }
  __syncthreads();
  if (kh == 1) return;
#pragma unroll
  for (int a = 0; a < 3; ++a)
#pragma unroll
    for (int b = 0; b < 4; ++b) acc[a][b] += red[(a * 4 + b) * 256];
  float* gates = (float*)(p.ws + OFF_GATES);
  const float* gb = p.gate_b + lj * 48;
  f32x4 gbv[3];
#pragma unroll
  for (int nt = 0; nt < 3; ++nt) gbv[nt] = *(const f32x4*)(gb + nt * 16 + lg * 4);
  if (wn == 0) {
#pragma unroll
    for (int mt = 0; mt < 4; ++mt) {
      const int m = m0 + wm * 64 + mt * 16 + c16;
#pragma unroll
      for (int nt = 0; nt < 3; ++nt) {
        const int nl = nt * 16 + lg * 4;
        f32x4 o;
        o[0] = sigmoidf_(acc[nt][mt][0] + gbv[nt][0]);
        o[1] = sigmoidf_(acc[nt][mt][1] + gbv[nt][1]);
        o[2] = sigmoidf_(acc[nt][mt][2] + gbv[nt][2]);
        o[3] = sigmoidf_(acc[nt][mt][3] + gbv[nt][3]);
        *(f32x4*)(gates + (size_t)m * 48 + nl) = o;
      }
    }
  }
}

DI void cmp1_tile(const Params& p, int lj, int item, char* smem) {
  const int tile = item >> 1, kh = item & 1;
  const int i = tile >> 7, t = tile & 127;
  const int mtile = t >> 1, ntile = t & 1;
  const int m0 = mtile * 128, n0 = ntile * 128;
  const int tid = tidx(), w = tid >> 6, wm = w >> 1, wn = w & 1;
  const bf16_t* A = (const bf16_t*)(p.ws + (i == 0 ? OFF_KC : OFF_VC));
  const bf16_t* Bt = (const bf16_t*)(p.ws + OFF_WT_CMP1) + (size_t)(lj * 2 + i) * 256 * 2048 + kh * 1024;
  unsigned aoff[4];
#pragma unroll
  for (int q = 0; q < 4; ++q) {
    int m = m0 + (tid >> 3) + 32 * q;
    int g = m & 3, n = (m >> 2) & 127, b = m >> 9;
    if (n > 126) n = 126;
    aoff[q] = (unsigned)((b * 2048 + 16 * n + 16 * kh) * 256 + g * 64);
  }
  f32x4 acc[4][4];
  gemm_mainloop<true>(A, aoff, 256, Bt, 1024, n0, smem, acc, 2048);
  __syncthreads();
  f32x4* red = (f32x4*)(kh ? smem : smem + SMEM_BYTES) + tid;
  if (kh == 1) {
#pragma unroll
    for (int a = 0; a < 4; ++a)
#pragma unroll
      for (int b = 0; b < 4; ++b) red[(a * 4 + b) * 256] = acc[a][b];
  }
  __syncthreads();
  if (kh == 0) {
#pragma unroll
    for (int a = 0; a < 4; ++a)
#pragma unroll
      for (int b = 0; b < 4; ++b) acc[a][b] += red[(a * 4 + b) * 256];
    bf16_t* hid = (bf16_t*)(p.ws + OFF_HID) + (size_t)i * 8192 * 256;
    const float* b1 = (const float*)(p.ws + OFF_B1EFF) + (lj * 2 + i) * 256;
    epi_store_bf16<2>(acc, m0 + wm * 64, n0 + wn * 64, hid, 256, b1);
  }
}

DI void cmp2_item(const Params& p, int lj, int item, char* smem) {
  const int tid = tidx();
  const int tile = item >> 1, kh = item & 1;
  const int i = tile >> 7, rt = tile & 127;
  float* w2s = (float*)smem;
  const float* W2 = p.cmp_w2 + (size_t)(lj * 2 + i) * 256 * 64 + (size_t)kh * 128 * 64;
  const int row = tid >> 2, cq = tid & 3;
  const int m = rt * 64 + row;
  const bf16_t* hid = (const bf16_t*)(p.ws + OFF_HID) + ((size_t)i * 8192 + m) * 256 + kh * 128;
  u32x4 hvv[16];
#pragma unroll
  for (int k8 = 0; k8 < 16; ++k8) hvv[k8] = *(const u32x4*)(hid + k8 * 8);
  __syncthreads();
  for (int q = tid; q < 128 * 64 / 4; q += 256) ((float4*)w2s)[q] = ((const float4*)W2)[q];
  __syncthreads();
  float acc[16];
#pragma unroll
  for (int d = 0; d < 16; ++d) acc[d] = 0.f;
#pragma unroll
  for (int k8 = 0; k8 < 16; ++k8) {
    const u32x4 hv = hvv[k8];
    float hf[8] = {bflo(hv.x), bfhi(hv.x), bflo(hv.y), bfhi(hv.y), bflo(hv.z), bfhi(hv.z), bflo(hv.w), bfhi(hv.w)};
#pragma unroll
    for (int kk = 0; kk < 8; ++kk) {
      const float4* wr = (const float4*)(w2s + (k8 * 8 + kk) * 64 + cq * 16);
      float4 w0 = wr[0], w1 = wr[1], w2 = wr[2], w3 = wr[3];
      float h = hf[kk];
      acc[0] += h * w0.x; acc[1] += h * w0.y; acc[2] += h * w0.z; acc[3] += h * w0.w;
      acc[4] += h * w1.x; acc[5] += h * w1.y; acc[6] += h * w1.z; acc[7] += h * w1.w;
      acc[8] += h * w2.x; acc[9] += h * w2.y; acc[10] += h * w2.z; acc[11] += h * w2.w;
      acc[12] += h * w3.x; acc[13] += h * w3.y; acc[14] += h * w3.z; acc[15] += h * w3.w;
    }
  }
  {
    f32x4* red = (f32x4*)((kh ? smem : smem + SMEM_BYTES) + 32768) + tid;
    if (kh == 1) {
#pragma unroll
      for (int q = 0; q < 4; ++q) red[q * 256] = f32x4{acc[4 * q], acc[4 * q + 1], acc[4 * q + 2], acc[4 * q + 3]};
    }
    __syncthreads();
    if (kh == 1) return;
#pragma unroll
    for (int q = 0; q < 4; ++q) {
      const f32x4 r = red[q * 256];
      acc[4 * q] += r[0]; acc[4 * q + 1] += r[1]; acc[4 * q + 2] += r[2]; acc[4 * q + 3] += r[3];
    }
  }
  const int g = m & 3, n = (m >> 2) & 127, b = m >> 9;
  const bool valid = n < 127;
  if (i == 0) {
    float ss = 0.f;
#pragma unroll
    for (int d = 0; d < 16; ++d) ss += acc[d] * acc[d];
    ss += __shfl_xor(ss, 1);
    ss += __shfl_xor(ss, 2);
    const float rstd = __builtin_amdgcn_rsqf(ss * (1.f / 64.f) + EPS);
    const float* gw = p.nsa_kn + (lj * 3 + 0) * 64 + cq * 16;
#pragma unroll
    for (int d = 0; d < 16; ++d) acc[d] = acc[d] * rstd * gw[d];
    if (cq == 0) {
      const int tokc = b * 2048 + (valid ? 16 * n + 31 : 2047);
      const float* rp = (const float*)(p.ws + OFF_ROPE) + (size_t)tokc * 16;
#pragma unroll
      for (int d = 0; d < 8; ++d) {
        float c = rp[d], s = rp[8 + d];
        float x1 = acc[d], x2 = acc[d + 8];
        acc[d] = x1 * c - x2 * s;
        acc[d + 8] = x2 * c + x1 * s;
      }
    }
    bf16_t* dst = (bf16_t*)(p.ws + OFF_KCMP) + ((size_t)((b * 4 + g) * 128 + n)) * 64 + cq * 16;
    u32x4 o0, o1;
    if (valid) {
      o0.x = pack_bf2(acc[0], acc[1]); o0.y = pack_bf2(acc[2], acc[3]); o0.z = pack_bf2(acc[4], acc[5]); o0.w = pack_bf2(acc[6], acc[7]);
      o1.x = pack_bf2(acc[8], acc[9]); o1.y = pack_bf2(acc[10], acc[11]); o1.z = pack_bf2(acc[12], acc[13]); o1.w = pack_bf2(acc[14], acc[15]);
    } else {
      o0 = u32x4{0u, 0u, 0u, 0u}; o1 = o0;
    }
    *(u32x4*)(dst) = o0;
    *(u32x4*)(dst + 8) = o1;
  } else {
    bf16_t* dst = (bf16_t*)(p.ws + OFF_VCMPT) + ((size_t)((b * 4 + g) * 64 + cq * 16)) * 128 + n;
#pragma unroll
    for (int d = 0; d < 16; ++d) {
      unsigned u = pack_bf2(valid ? acc[d] : 0.f, 0.f);
      dst[(size_t)d * 128] = (bf16_t)(u & 0xffff);
    }
  }
}

DI void kmean_item(const Params& p, int item, char* smem) {
  const int tid = tidx();
  const int blk = item & 7, g = (item >> 3) & 3, b = item >> 5;
  const int d8 = tid & 7, rg = tid >> 3;
  const bf16_t* K = (const bf16_t*)(p.ws + OFF_KS) + ((size_t)(b * 2048 + blk * 256)) * 256 + g * 64 + d8 * 8;
  float s[8];
#pragma unroll
  for (int q = 0; q < 8; ++q) s[q] = 0.f;
#pragma unroll
  for (int r = 0; r < 8; ++r) {
    u32x4 v = *(const u32x4*)(K + (size_t)(rg + 32 * r) * 256);
    s[0] += bflo(v.x); s[1] += bfhi(v.x); s[2] += bflo(v.y); s[3] += bfhi(v.y);
    s[4] += bflo(v.z); s[5] += bfhi(v.z); s[6] += bflo(v.w); s[7] += bfhi(v.w);
  }
  float* red = (float*)smem;
  __syncthreads();
#pragma unroll
  for (int q = 0; q < 8; ++q) red[rg * 64 + d8 * 8 + q] = s[q];
  __syncthreads();
  if (tid < 64) {
    float t = 0.f;
    for (int r = 0; r < 32; ++r) t += red[r * 64 + tid];
    bf16_t* km = (bf16_t*)(p.ws + OFF_KMEAN) + (size_t)((b * 4 + g) * 16) * 64;
    km[blk * 64 + tid] = (bf16_t)(pack_bf2(t * (1.f / 256.f), 0.f) & 0xffff);
    km[(8 + blk) * 64 + tid] = 0;
  }
}

template <int MASKMODE, bool FIXED>
DI void softmax_ct(f32x4 (&Sc)[4], int lo, int hi, float& mrun, float& lrun, f32x4 (&Oc)[4], bf16x8 (&Pc)[2]) {
  const bool colok = (MASKMODE == 1) ? (hi >= 0) : true;
  if (FIXED) {
    float rs = 0.f;
#pragma unroll
    for (int kt = 0; kt < 4; ++kt)
#pragma unroll
      for (int j = 0; j < 4; ++j) {
        float s = Sc[kt][j];
        if (MASKMODE == 2) {
          const int idx = kt * 16 + j;
          s = (idx > lo && idx <= hi) ? s : NEG;
        }
        const float pv = fexp2(s);
        Sc[kt][j] = pv;
        rs += pv;
      }
    if (MASKMODE == 1) rs = colok ? rs : 0.f;
    lrun += rs;
  } else {
    float mx = NEG;
#pragma unroll
    for (int kt = 0; kt < 4; ++kt)
#pragma unroll
      for (int j = 0; j < 4; ++j) {
        float s = Sc[kt][j];
        if (MASKMODE == 2) {
          const int idx = kt * 16 + j;
          s = (idx > lo && idx <= hi) ? s : NEG;
          Sc[kt][j] = s;
        }
        if (MASKMODE == 1) { s = colok ? s : NEG; Sc[kt][j] = s; }
        mx = fmaxf(mx, s);
      }
    mx = fmaxf(mx, __shfl_xor(mx, 16));
    mx = fmaxf(mx, __shfl_xor(mx, 32));
    const float mn = fmaxf(mrun, mx);
    const float alpha = fexp2(mrun - mn);
    mrun = mn;
    const float msafe = mn < -1e29f ? 0.f : mn;
    float rs = 0.f;
#pragma unroll
    for (int kt = 0; kt < 4; ++kt)
#pragma unroll
      for (int j = 0; j < 4; ++j) {
        float pv = fexp2(Sc[kt][j] - msafe);
        Sc[kt][j] = pv;
        rs += pv;
      }
    lrun = lrun * alpha + rs;
#pragma unroll
    for (int dt = 0; dt < 4; ++dt) Oc[dt] *= alpha;
  }
#pragma unroll
  for (int kp = 0; kp < 2; ++kp) {
    u32x4 u;
    u.x = pack_bf2(Sc[2 * kp][0], Sc[2 * kp][1]);
    u.y = pack_bf2(Sc[2 * kp][2], Sc[2 * kp][3]);
    u.z = pack_bf2(Sc[2 * kp + 1][0], Sc[2 * kp + 1][1]);
    u.w = pack_bf2(Sc[2 * kp + 1][2], Sc[2 * kp + 1][3]);
    if (MASKMODE == 1 && FIXED) { u.x = colok ? u.x : 0u; u.y = colok ? u.y : 0u; u.z = colok ? u.z : 0u; u.w = colok ? u.w : 0u; }
    Pc[kp] = __builtin_bit_cast(bf16x8, u);
  }
}
template <int MASKMODE, bool FIXED>
DI void attn_h1(const bf16_t* __restrict__ Ks, const bf16x8 (&Qb)[2][2], f32x4 (&O0)[4], f32x4 (&O1)[4], float (&mrun)[2], float (&lrun)[2],
                const int (&lo)[2], const int (&hi)[2], bf16x8 (&P0)[2], f32x4 (&S1)[4]) {
  const int lane = tidx() & 63, c16 = lane & 15, lg = lane >> 4;
  f32x4 S0[4];
  {
    bf16x8 ka[4][2];
#pragma unroll
    for (int kt = 0; kt < 4; ++kt)
#pragma unroll
      for (int ks = 0; ks < 2; ++ks) ka[kt][ks] = *(const bf16x8*)(Ks + (kt * 16 + c16) * 72 + ks * 32 + lg * 8);
#pragma unroll
    for (int kt = 0; kt < 4; ++kt) {
      S0[kt] = f32x4{0.f, 0.f, 0.f, 0.f};
      S1[kt] = f32x4{0.f, 0.f, 0.f, 0.f};
#pragma unroll
      for (int ks = 0; ks < 2; ++ks) {
        S0[kt] = mfma16(ka[kt][ks], Qb[0][ks], S0[kt]);
        S1[kt] = mfma16(ka[kt][ks], Qb[1][ks], S1[kt]);
      }
    }
  }
  softmax_ct<MASKMODE, FIXED>(S0, lo[0], hi[0], mrun[0], lrun[0], O0, P0);
}
template <int MASKMODE, bool FIXED>
DI void attn_h2(const bf16_t* __restrict__ Vs, f32x4 (&O0)[4], f32x4 (&O1)[4], float (&mrun)[2], float (&lrun)[2], const int (&lo)[2],
                const int (&hi)[2], const bf16x8 (&P0)[2], f32x4 (&S1)[4]) {
  const int lane = tidx() & 63, c16 = lane & 15, lg = lane >> 4;
  bf16x8 va[2][4];
#pragma unroll
  for (int kp = 0; kp < 2; ++kp)
#pragma unroll
    for (int dt = 0; dt < 4; ++dt) {
      const u32x2 v0 = *(const u32x2*)(Vs + (dt * 16 + c16) * 72 + kp * 32 + lg * 4);
      const u32x2 v1 = *(const u32x2*)(Vs + (dt * 16 + c16) * 72 + kp * 32 + 16 + lg * 4);
      va[kp][dt] = __builtin_bit_cast(bf16x8, (u32x4{v0.x, v0.y, v1.x, v1.y}));
    }
#pragma unroll
  for (int kp = 0; kp < 2; ++kp)
#pragma unroll
    for (int dt = 0; dt < 4; ++dt) O0[dt] = mfma16(va[kp][dt], P0[kp], O0[dt]);
  bf16x8 P1[2];
  softmax_ct<MASKMODE, FIXED>(S1, lo[1], hi[1], mrun[1], lrun[1], O1, P1);
#pragma unroll
  for (int kp = 0; kp < 2; ++kp)
#pragma unroll
    for (int dt = 0; dt < 4; ++dt) O1[dt] = mfma16(va[kp][dt], P1[kp], O1[dt]);
}

template <int MODE, bool FIXED>
DI void attn_range(const bf16_t* __restrict__ Kg, const bf16_t* __restrict__ VTg, int j0, int j1, char* smem, int& buf, const bf16x8 (&Qb)[2][2],
                   f32x4 (&O)[4][2], float (&mrun)[2], float (&lrun)[2], const int (&tq)[2], const unsigned (&selbits)[2], int own,
                   u32x4 (&rk)[2], u32x4 (&rv)[2]) {
  const int tid = tidx(), lane = tid & 63, lg = lane >> 4;
  const int half = vhalf();
  const int t512 = half * 256 + tid;
  const int r0 = t512 >> 3, c8 = t512 & 7;
  char* smsh = smem - half * SMEM_BYTES;
  const int soff = r0 * 72 + c8 * 8;
  f32x4 O0[4], O1[4];
#pragma unroll
  for (int dt = 0; dt < 4; ++dt) { O0[dt] = O[dt][0]; O1[dt] = O[dt][1]; }
  {
    bf16_t* base = (bf16_t*)(smsh + buf * SMEM_BYTES);
#pragma unroll
    for (int i = 0; i < 2; ++i) {
      *(u32x4*)(base + i * (64 * 72) + soff) = rk[i];
      *(u32x4*)(base + 9216 + i * (64 * 72) + soff) = rv[i];
    }
  }
#pragma unroll
  for (int i = 0; i < 2; ++i) {
    const int jj = j0 + 2 + i <= j1 ? j0 + 2 + i : j1;
    rk[i] = *(const u32x4*)(Kg + (size_t)(jj * 64 + r0) * 256 + c8 * 8);
    rv[i] = *(const u32x4*)(VTg + (size_t)r0 * 2048 + jj * 64 + c8 * 8);
  }
  lds_barrier();
  for (int jp = j0; jp <= j1; jp += 2) {
    const bf16_t* base = (const bf16_t*)(smsh + buf * SMEM_BYTES);
#pragma unroll 1
    for (int sub = 0; sub < 2; ++sub) {
      const int j = jp + sub;
      if (j > j1) break;
      const bf16_t* cK = base + sub * (64 * 72);
      const bf16_t* cV = base + 9216 + sub * (64 * 72);
      int lo[2], hi[2];
      const int kb = j * 64;
#pragma unroll
      for (int ct = 0; ct < 2; ++ct) {
        const int rel = tq[ct] - kb - lg * 4;
        if (MODE == 0) {
          hi[ct] = ((selbits[ct] >> j) & 1u) ? (j < j1 ? 1000 : rel) : -1;
          lo[ct] = -1000;
        } else if (MODE == 1) {
          hi[ct] = rel;
          lo[ct] = rel - 256;
        } else {
          const int jb = j >> 2;
          if (jb < own) hi[ct] = ((selbits[ct] >> jb) & 1u) ? 1000 : -1;
          else hi[ct] = (j < j1 ? 1000 : rel);
          lo[ct] = -1000;
        }
      }
      const bool act = (hi[0] >= 0 && lo[0] < 63) || (hi[1] >= 0 && lo[1] < 63);
      const bool wact = __any(act);
      bf16x8 P0[2];
      f32x4 S1[4];
      const bool f0 = hi[0] >= 63 && lo[0] < 0, f1 = hi[1] >= 63 && lo[1] < 0;
      const bool cu = (f0 || hi[0] < 0) && (f1 || hi[1] < 0);
      const int mm = !wact ? 3 : (__all(f0 && f1) ? 0 : (__all(cu) ? 1 : 2));
      if (mm == 0) attn_h1<0, FIXED>(cK, Qb, O0, O1, mrun, lrun, lo, hi, P0, S1);
      else if (mm == 1) attn_h1<1, FIXED>(cK, Qb, O0, O1, mrun, lrun, lo, hi, P0, S1);
      else if (mm == 2) attn_h1<2, FIXED>(cK, Qb, O0, O1, mrun, lrun, lo, hi, P0, S1);
      if (mm == 0) attn_h2<0, FIXED>(cV, O0, O1, mrun, lrun, lo, hi, P0, S1);
      else if (mm == 1) attn_h2<1, FIXED>(cV, O0, O1, mrun, lrun, lo, hi, P0, S1);
      else if (mm == 2) attn_h2<2, FIXED>(cV, O0, O1, mrun, lrun, lo, hi, P0, S1);
    }
    if (jp + 2 <= j1) {
      bf16_t* nb = (bf16_t*)(smsh + (buf ^ 1) * SMEM_BYTES);
#pragma unroll
      for (int i = 0; i < 2; ++i) {
        *(u32x4*)(nb + i * (64 * 72) + soff) = rk[i];
        *(u32x4*)(nb + 9216 + i * (64 * 72) + soff) = rv[i];
      }
#pragma unroll
      for (int i = 0; i < 2; ++i) {
        const int jj = jp + 4 + i <= j1 ? jp + 4 + i : j1;
        rk[i] = *(const u32x4*)(Kg + (size_t)(jj * 64 + r0) * 256 + c8 * 8);
        rv[i] = *(const u32x4*)(VTg + (size_t)r0 * 2048 + jj * 64 + c8 * 8);
      }
    }
    lds_barrier();
    buf ^= 1;
  }
#pragma unroll
  for (int dt = 0; dt < 4; ++dt) { O[dt][0] = O0[dt]; O[dt][1] = O1[dt]; }
}

DI void attn_first_pair(const bf16_t* __restrict__ Kg, const bf16_t* __restrict__ VTg, int j0, int j1, u32x4 (&rk)[2], u32x4 (&rv)[2]) {
  const int t512 = vhalf() * 256 + tidx();
  const int r0 = t512 >> 3, c8 = t512 & 7;
#pragma unroll
  for (int i = 0; i < 2; ++i) {
    const int jj = j0 + i <= j1 ? j0 + i : j1;
    rk[i] = *(const u32x4*)(Kg + (size_t)(jj * 64 + r0) * 256 + c8 * 8);
    rv[i] = *(const u32x4*)(VTg + (size_t)r0 * 2048 + jj * 64 + c8 * 8);
  }
}
DI void load_q(const Params& p, int b, int g, int tw  , bf16x8 (&Qb)[2][2]) {
  const int lane = tidx() & 63, c16 = lane & 15, lg = lane >> 4;
  const bf16_t* q = (const bf16_t*)(p.ws + OFF_Q);
#pragma unroll
  for (int ct = 0; ct < 2; ++ct) {
    const int t = tw + ct * 4 + (c16 >> 2), head = g * 4 + (c16 & 3);
    const bf16_t* qp = q + ((size_t)(b * 2048 + t)) * 1024 + head * 64 + lg * 8;
    Qb[ct][0] = *(const bf16x8*)(qp);
    Qb[ct][1] = *(const bf16x8*)(qp + 32);
  }
}

DI void store_y(const Params& p, int b, int g, int tw, const f32x4 (&Ot)[4][2]) {
  const int lane = tidx() & 63, c16 = lane & 15, lg = lane >> 4;
  const bf16_t* sz = (const bf16_t*)(p.ws + OFF_SZ);
  bf16_t* y = (bf16_t*)(p.ws + OFF_H);
#pragma unroll
  for (int ct = 0; ct < 2; ++ct) {
    const int t = tw + ct * 4 + (c16 >> 2), head = g * 4 + (c16 & 3);
    const size_t base = ((size_t)(b * 2048 + t)) * 1024 + head * 64 + lg * 4;
#pragma unroll
    for (int dt = 0; dt < 4; ++dt) {
      u32x2 zz = *(const u32x2*)(sz + base + dt * 16);
      u32x2 o;
      o.x = pack_bf2(Ot[dt][ct][0] * bflo(zz.x), Ot[dt][ct][1] * bfhi(zz.x));
      o.y = pack_bf2(Ot[dt][ct][2] * bflo(zz.y), Ot[dt][ct][3] * bfhi(zz.y));
      *(u32x2*)(y + base + dt * 16) = o;
    }
  }
}

template <bool FIXED>
DI void nsa_attn_item(const Params& p, int item, char* smem) {
  const int tid = tidx(), lane = tid & 63, w = tid >> 6, c16 = lane & 15, lg = lane >> 4;
  const int pi = item >> 1;
  const int rr = pi >> 6, kr = rr >> 2, bq = rr & 3;
  const int bg = pi & 63, qb = 2 * (31 - 4 * kr - ((kr & 1) ? 3 - bq : bq)) + (item & 1);
  const int b = bg >> 2, g = bg & 3;
  const int t0 = qb * 32, tw = t0 + w * 8;
  const int cur = t0 >> 6;
  unsigned* selm = (unsigned*)(smem + 36864);
  float* imp_main = (float*)(smem + 36992);
  float* imp_carry = (float*)(smem + 36992 + 4224);
  f32x4* Otl = (f32x4*)(smem + 36992) + tid;
  bf16x8 Qb[2][2];
  load_q(p, b, g, tw, Qb);
  const bf16_t* KgS = (const bf16_t*)(p.ws + OFF_KS) + (size_t)b * 2048 * 256 + g * 64;
  const bf16_t* VTgS = (const bf16_t*)(p.ws + OFF_VST) + (size_t)bg * 64 * 2048;
  const bf16_t* KgW = (const bf16_t*)(p.ws + OFF_KW) + (size_t)b * 2048 * 256 + g * 64;
  const bf16_t* VTgW = (const bf16_t*)(p.ws + OFF_VWT) + (size_t)bg * 64 * 2048;
  int jlo = t0 - 255;
  jlo = jlo < 0 ? 0 : (jlo >> 6);
  u32x4 rk[2], rv[2];
  attn_first_pair(KgS, VTgS, 0, cur, rk, rv);
  int tq[2];
  float gate[2][3];
  const float* gates = (const float*)(p.ws + OFF_GATES);
#pragma unroll
  for (int ct = 0; ct < 2; ++ct) {
    tq[ct] = tw + ct * 4 + (c16 >> 2);
    const float* gp = gates + ((size_t)(b * 2048 + tq[ct])) * 48 + (g * 4 + (c16 & 3)) * 3;
    gate[ct][0] = gp[0]; gate[ct][1] = gp[1]; gate[ct][2] = gp[2];
  }
  __syncthreads();
  char* smsh = smem - vhalf() * SMEM_BYTES;
  bf16_t* Kc = (bf16_t*)smsh;
  bf16_t* VcT = (bf16_t*)(smsh + 18432);
  {
    const bf16_t* kc = (const bf16_t*)(p.ws + OFF_KCMP) + (size_t)bg * 128 * 64;
    const bf16_t* vc = (const bf16_t*)(p.ws + OFF_VCMPT) + (size_t)bg * 64 * 128;
    const int t512 = vhalf() * 256 + tid;
    u32x4 tk[2], tv[2];
#pragma unroll
    for (int i = 0; i < 2; ++i) {
      const int ch = t512 + i * 512;
      tk[i] = *(const u32x4*)(kc + (ch >> 3) * 64 + (ch & 7) * 8);
      tv[i] = *(const u32x4*)(vc + (ch >> 4) * 128 + (ch & 15) * 8);
    }
#pragma unroll
    for (int i = 0; i < 2; ++i) {
      const int ch = t512 + i * 512;
      *(u32x4*)(Kc + (ch >> 3) * 72 + (ch & 7) * 8) = tk[i];
      *(u32x4*)(VcT + (ch >> 4) * 136 + (ch & 15) * 8) = tv[i];
    }
  }
  __syncthreads();
  f32x4 Ot[4][2];
#pragma unroll
  for (int ct = 0; ct < 2; ++ct) {
    f32x4 Sx[8];
#pragma unroll
    for (int kt = 0; kt < 8; ++kt) {
      Sx[kt] = f32x4{0.f, 0.f, 0.f, 0.f};
#pragma unroll
      for (int ks = 0; ks < 2; ++ks) {
        bf16x8 a = *(const bf16x8*)(Kc + (kt * 16 + c16) * 72 + ks * 32 + lg * 8);
        Sx[kt] = mfma16(a, Qb[ct][ks], Sx[kt]);
      }
    }
    {
      const int hi = ((tq[ct] - 31) >> 4) - lg * 4;
      float mx = NEG;
#pragma unroll
      for (int kt = 0; kt < 8; ++kt)
#pragma unroll
        for (int j = 0; j < 4; ++j) {
          float s = (kt * 16 + j <= hi) ? Sx[kt][j] : NEG;
          Sx[kt][j] = s;
          mx = fmaxf(mx, s);
        }
      mx = fmaxf(mx, __shfl_xor(mx, 16));
      mx = fmaxf(mx, __shfl_xor(mx, 32));
      const float msafe = mx < -1e29f ? 0.f : mx;
      float rs = 0.f;
#pragma unroll
      for (int kt = 0; kt < 8; ++kt)
#pragma unroll
        for (int j = 0; j < 4; ++j) {
          float pv = fexp2(Sx[kt][j] - msafe);
          Sx[kt][j] = pv;
          rs += pv;
        }
      rs += __shfl_xor(rs, 16);
      rs += __shfl_xor(rs, 32);
      const float inv = 1.f / fmaxf(rs, 1e-30f);
      const int qloc = w * 8 + ct * 4 + (c16 >> 2);
#pragma unroll
      for (int kt = 0; kt < 8; ++kt) {
#pragma unroll
        for (int j = 0; j < 4; ++j) Sx[kt][j] *= inv;
        float a = Sx[kt][0] + Sx[kt][1] + Sx[kt][2] + 0.5f * Sx[kt][3];
        float c = 0.5f * Sx[kt][3];
        a += qxor1(a);
        a += qxor2(a);
        c += qxor1(c);
        c += qxor2(c);
        if ((c16 & 3) == 0) {
          const int mi = kt * 4 + lg;
          imp_main[qloc * 33 + mi] = a;
          imp_carry[qloc * 34 + mi + 1] = c;
        }
      }
    }
    f32x4 O[4];
#pragma unroll
    for (int dt = 0; dt < 4; ++dt) O[dt] = f32x4{0.f, 0.f, 0.f, 0.f};
#pragma unroll
    for (int kp = 0; kp < 4; ++kp) {
      u32x4 u;
      u.x = pack_bf2(Sx[2 * kp][0], Sx[2 * kp][1]);
      u.y = pack_bf2(Sx[2 * kp][2], Sx[2 * kp][3]);
      u.z = pack_bf2(Sx[2 * kp + 1][0], Sx[2 * kp + 1][1]);
      u.w = pack_bf2(Sx[2 * kp + 1][2], Sx[2 * kp + 1][3]);
      bf16x8 Pb = __builtin_bit_cast(bf16x8, u);
#pragma unroll
      for (int dt = 0; dt < 4; ++dt) {
        u32x2 v0 = *(const u32x2*)(VcT + (dt * 16 + c16) * 136 + kp * 32 + lg * 4);
        u32x2 v1 = *(const u32x2*)(VcT + (dt * 16 + c16) * 136 + kp * 32 + 16 + lg * 4);
        u32x4 uu = u32x4{v0.x, v0.y, v1.x, v1.y};
        bf16x8 va = __builtin_bit_cast(bf16x8, uu);
        O[dt] = mfma16(va, Pb, O[dt]);
      }
    }
#pragma unroll
    for (int dt = 0; dt < 4; ++dt) Ot[dt][ct] = O[dt] * gate[ct][0];
  }
  __syncthreads();
  {
    const int q = tid >> 3, jj = tid & 7;
    const int jmax = cur - 2;
    unsigned forced = 1u | (1u << cur);
    if (cur >= 1) forced |= 1u << (cur - 1);
    const int need = 8 - __popc(forced);
    float vj[4];
    int cnt[4];
#pragma unroll
    for (int c = 0; c < 4; ++c) {
      const int j = jj + 8 * c;
      vj[c] = (j >= 1 && j <= jmax) ? imp_main[q * 33 + j] + imp_carry[q * 34 + j] : 0.f;
      cnt[c] = 0;
    }
    for (int i = 1; i <= jmax; ++i) {
      const float vi = imp_main[q * 33 + i] + imp_carry[q * 34 + i];
#pragma unroll
      for (int c = 0; c < 4; ++c) {
        const int j = jj + 8 * c;
        cnt[c] += (vi > vj[c] || (vi == vj[c] && i < j)) ? 1 : 0;
      }
    }
    unsigned bits = 0;
#pragma unroll
    for (int c = 0; c < 4; ++c) {
      const int j = jj + 8 * c;
      if (j >= 1 && j <= jmax && cnt[c] < need) bits |= 1u << j;
    }
    bits |= (unsigned)__shfl_xor((int)bits, 1);
    bits |= (unsigned)__shfl_xor((int)bits, 2);
    bits |= (unsigned)__shfl_xor((int)bits, 4);
    if (jj == 0) selm[q] = forced | bits;
  }
  __syncthreads();
  unsigned selbits[2];
#pragma unroll
  for (int ct = 0; ct < 2; ++ct) selbits[ct] = selm[w * 8 + ct * 4 + (c16 >> 2)];
#pragma unroll
  for (int dt = 0; dt < 4; ++dt)
#pragma unroll
    for (int ct = 0; ct < 2; ++ct) Otl[(dt * 2 + ct) * 256] = Ot[dt][ct];
  int buf = 0;
  {
    f32x4 O[4][2];
    float mrun[2] = {NEG, NEG}, lrun[2] = {0.f, 0.f};
#pragma unroll
    for (int dt = 0; dt < 4; ++dt) { O[dt][0] = f32x4{0.f, 0.f, 0.f, 0.f}; O[dt][1] = f32x4{0.f, 0.f, 0.f, 0.f}; }
    attn_range<0, FIXED>(KgS, VTgS, 0, cur, smem, buf, Qb, O, mrun, lrun, tq, selbits, 0, rk, rv);
    attn_first_pair(KgW, VTgW, jlo, cur, rk, rv);
#pragma unroll
    for (int ct = 0; ct < 2; ++ct) {
      float l = lrun[ct];
      l += __shfl_xor(l, 16);
      l += __shfl_xor(l, 32);
      const float sc = gate[ct][1] / fmaxf(l, 1e-30f);
#pragma unroll
      for (int dt = 0; dt < 4; ++dt) Otl[(dt * 2 + ct) * 256] = Otl[(dt * 2 + ct) * 256] + O[dt][ct] * sc;
    }
  }
  {
    f32x4 O[4][2];
    float mrun[2] = {NEG, NEG}, lrun[2] = {0.f, 0.f};
#pragma unroll
    for (int dt = 0; dt < 4; ++dt) { O[dt][0] = f32x4{0.f, 0.f, 0.f, 0.f}; O[dt][1] = f32x4{0.f, 0.f, 0.f, 0.f}; }
    attn_range<1, FIXED>(KgW, VTgW, jlo, cur, smem, buf, Qb, O, mrun, lrun, tq, selbits, 0, rk, rv);
#pragma unroll
    for (int ct = 0; ct < 2; ++ct) {
      float l = lrun[ct];
      l += __shfl_xor(l, 16);
      l += __shfl_xor(l, 32);
      const float sc = gate[ct][2] / fmaxf(l, 1e-30f);
#pragma unroll
      for (int dt = 0; dt < 4; ++dt) Ot[dt][ct] = Otl[(dt * 2 + ct) * 256] + O[dt][ct] * sc;
    }
  }
  store_y(p, b, g, tw, Ot);
}

template <bool FIXED>
DI void moba_attn_item(const Params& p, int item, char* smem) {
  const int tid = tidx(), lane = tid & 63, w = tid >> 6, c16 = lane & 15, lg = lane >> 4;
  const int pi = item >> 1;
  const int rr = pi >> 6, kr = rr >> 2, bq = rr & 3;
  const int bg = pi & 63, qb = 2 * (31 - 4 * kr - ((kr & 1) ? 3 - bq : bq)) + (item & 1);
  const int b = bg >> 2, g = bg & 3;
  const int t0 = qb * 32, tw = t0 + w * 8;
  const int own = t0 >> 8;
  bf16x8 Qb[2][2];
  load_q(p, b, g, tw, Qb);
  const bf16_t* Kg = (const bf16_t*)(p.ws + OFF_KS) + (size_t)b * 2048 * 256 + g * 64;
  const bf16_t* VTg = (const bf16_t*)(p.ws + OFF_VST) + (size_t)bg * 64 * 2048;
  u32x4 rk[2], rv[2];
  attn_first_pair(Kg, VTg, 0, t0 >> 6, rk, rv);
  int tq[2];
#pragma unroll
  for (int ct = 0; ct < 2; ++ct) tq[ct] = tw + ct * 4 + (c16 >> 2);
  __syncthreads();
  bf16_t* Km = (bf16_t*)(smem + 36864);
  if (tid < 128) {
    int row = tid >> 3, cc = tid & 7;
    *(u32x4*)(Km + row * 72 + cc * 8) = *(const u32x4*)((const bf16_t*)(p.ws + OFF_KMEAN) + (size_t)bg * 16 * 64 + row * 64 + cc * 8);
  }
  __syncthreads();
  unsigned selbits[2];
#pragma unroll
  for (int ct = 0; ct < 2; ++ct) {
    f32x4 sg = f32x4{0.f, 0.f, 0.f, 0.f};
#pragma unroll
    for (int ks = 0; ks < 2; ++ks) {
      bf16x8 a = *(const bf16x8*)(Km + c16 * 72 + ks * 32 + lg * 8);
      sg = mfma16(a, Qb[ct][ks], sg);
    }
    f32x4 ot;
#pragma unroll
    for (int j = 0; j < 4; ++j) ot[j] = __shfl_xor(sg[j], 16);
    const bool odd = (lg & 1) != 0;
    float v0 = odd ? ot[0] : sg[0], v1 = odd ? ot[1] : sg[1], v2 = odd ? ot[2] : sg[2], v3 = odd ? ot[3] : sg[3];
    float v4 = odd ? sg[0] : ot[0], v5 = odd ? sg[1] : ot[1], v6 = odd ? sg[2] : ot[2], v7 = odd ? sg[3] : ot[3];
    unsigned sel = 0;
#pragma unroll
    for (int it = 0; it < 3; ++it) {
      float bv = -3.0e38f;
      int best = -1;
#define CAND(J, V) if ((J) < own && !((sel >> (J)) & 1u) && (V) > bv) { bv = (V); best = (J); }
      CAND(0, v0) CAND(1, v1) CAND(2, v2) CAND(3, v3) CAND(4, v4) CAND(5, v5) CAND(6, v6) CAND(7, v7)
#undef CAND
      if (best >= 0) sel |= 1u << best;
    }
    selbits[ct] = (unsigned)__shfl((int)sel, c16);
  }
  int buf = 0;
  f32x4 O[4][2];
  float mrun[2] = {NEG, NEG}, lrun[2] = {0.f, 0.f};
#pragma unroll
  for (int dt = 0; dt < 4; ++dt) { O[dt][0] = f32x4{0.f, 0.f, 0.f, 0.f}; O[dt][1] = f32x4{0.f, 0.f, 0.f, 0.f}; }
  attn_range<2, FIXED>(Kg, VTg, 0, t0 >> 6, smem, buf, Qb, O, mrun, lrun, tq, selbits, own, rk, rv);
#pragma unroll
  for (int ct = 0; ct < 2; ++ct) {
    float l = lrun[ct];
    l += __shfl_xor(l, 16);
    l += __shfl_xor(l, 32);
    const float sc = 1.f / fmaxf(l, 1e-30f);
#pragma unroll
    for (int dt = 0; dt < 4; ++dt) O[dt][ct] *= sc;
  }
  store_y(p, b, g, tw, O);
}

#ifndef PROBE_DUP
#define PROBE_DUP -1
#endif
DI void run_phase1(const Params& pin, int layer, int ph, char* smem, unsigned long long& eticks);
DI void run_phase(const Params& pin, int layer, int ph, char* smem, unsigned long long& eticks) {
  run_phase1(pin, layer, ph, smem, eticks);
}
DI void run_phase1(const Params& pin, int layer, int ph, char* smem_all, unsigned long long& eticks) {
  Params p = pin;
  {
    size_t z = 0;
    asm volatile("" : "+s"(z));
    p.ws = pin.ws + z;
    p.out = pin.out + z;
  }
  const int half = vhalf();
  char* smem = smem_all + half * SMEM_BYTES;
  const int G = 2 * gridDim.x, bid = 2 * blockIdx.x + half;
  const bool nsa = (layer & 1) == 0;
  const int lj = layer >> 1;
  const float* xin = layer == 0 ? p.x : p.out;
  if (ph == 0) {
    for (int it = bid; it < NW_TOTAL; it += G) phaseW_item(p, it, smem);
  } else if (ph == 1) {
    for (int it = bid; it < NTOK / 16; it += G) prep_item(p, layer, xin, it);
  } else if (ph == 2) {
    g8::StaticOrder S;
    S.init(NTOK, nsa ? NSA_NP : MOBA_IN, gridDim.x, blockIdx.x);
    InProjEpi E{p, layer};
    const bf16_t* Bt = nsa ? (const bf16_t*)(p.ws + OFF_WT_NSA_IN) + (size_t)lj * NSA_NP * 1024
                           : (const bf16_t*)(p.ws + OFF_WT_MOBA_IN) + (size_t)lj * MOBA_IN * 1024;
    g8::gemm_phase(( LAS unsigned char*)smem_all, (const bf16_t*)(p.ws + OFF_H), Bt, 1024, S, E, eticks);
    if (nsa) {
      __syncthreads();
      for (int it = bid; it < 512; it += G) gates_tile(p, lj, it, smem);
    }
  } else if (ph == 3) {
    if (nsa) { for (int it = bid; it < 512; it += G) cmp1_tile(p, lj, it, smem); }
    else { for (int it = bid; it < 512; it += G) kmean_item(p, it, smem); }
  } else if (ph == 4) {
    if (nsa) for (int it = bid; it < 512; it += G) cmp2_item(p, lj, it, smem);
  } else if (ph == 5) {
    float gq, gk;
    {
      const int l64 = tidx() & 63;
      if (nsa) {
        gq = fabsf(p.nsa_qn[lj * 64 + l64]);
        gk = fmaxf(fabsf(p.nsa_kn[(lj * 3 + 1) * 64 + l64]), fabsf(p.nsa_kn[(lj * 3 + 2) * 64 + l64]));
      } else {
        gq = fabsf(p.moba_qn[lj * 64 + l64]);
        gk = fabsf(p.moba_kn[lj * 64 + l64]);
      }
#pragma unroll
      for (int o = 32; o >= 1; o >>= 1) { gq = fmaxf(gq, __shfl_xor(gq, o)); gk = fmaxf(gk, __shfl_xor(gk, o)); }
    }
    const bool fixed_ok = (11.8f * gq * gk) <= 100.f;
    if (nsa) {
      if (fixed_ok) { for (int it = bid; it < 4096; it += G) nsa_attn_item<true>(p, it, smem); }
      else { for (int it = bid; it < 4096; it += G) nsa_attn_item<false>(p, it, smem); }
    } else {
      if (fixed_ok) { for (int it = bid; it < 4096; it += G) moba_attn_item<true>(p, it, smem); }
      else { for (int it = bid; it < 4096; it += G) moba_attn_item<false>(p, it, smem); }
    }
  } else if (ph == 6) {
    g8::StaticOrder S;
    S.init(NTOK, 1024, gridDim.x, blockIdx.x);
    OutProjEpi E{p, layer, xin};
    const bf16_t* Bt = (const bf16_t*)(p.ws + (nsa ? OFF_WT_NSA_OUT : OFF_WT_MOBA_OUT)) + (size_t)lj * 1024 * 1024;
    { unsigned long long dummy = 0; g8::gemm_phase((LAS unsigned char*)smem_all, (const bf16_t*)(p.ws + OFF_H), Bt, 1024, S, E, dummy); }
  }
}

#if MULTI_LAUNCH
template <int PH>
__global__ void __launch_bounds__(512, 2) phase_kernel(Params p, int layer) {
  __shared__ __attribute__((aligned(16))) char smem[2 * SMEM_BYTES];
  unsigned long long eticks = 0;
  run_phase(p, layer, PH, smem, eticks);
}
#else
#ifndef PROBE_T
#define PROBE_T -1
#endif
#define TSTAMP(type) do { if (PROBE_T >= 0) { unsigned long long _t = wall_clock64(); if (PROBE_T == (type)) tacc += _t - tprev; tprev = _t; } } while (0)
__global__ void __launch_bounds__(512, 2) mega_kernel(Params p) {
  __shared__ __attribute__((aligned(16))) char smem[2 * SMEM_BYTES];
  __shared__ u32x4 xb_words;
  cg::grid_group grid = cg::this_grid();
  if (__builtin_amdgcn_workitem_id_x() == 0) xb_words = u32x4{0u, 0u, 0u, 0u};
  __syncthreads();
  if (blockIdx.x == 0) {
    unsigned* bw = (unsigned*)(p.ws + OFF_BAR);
    for (int i = __builtin_amdgcn_workitem_id_x(); i < (int)(BAR_BYTES / 4); i += 512) bw[i] = 0u;
  }
  grid.sync();
  (void)xcd_barrier_post((unsigned*)(p.ws + OFF_BAR), (volatile LAS unsigned*)&xb_words);
#define XBAR() do { XcdBarrier _xb; _xb.bar = (unsigned*)(p.ws + OFF_BAR); _xb.x = xb_xcc_id(); _xb.st = (volatile LAS unsigned*)&xb_words; xcd_barrier(_xb); } while (0)
  unsigned long long tprev = 0, tacc = 0, eticks = 0;
  if (PROBE_T >= 0) tprev = wall_clock64();
  run_phase(p, 0, 0, smem, eticks);
  XBAR();
  TSTAMP(0);
  for (int layer = 0; layer < 4; ++layer) {
    const bool nsa = (layer & 1) == 0;
    run_phase(p, layer, 1, smem, eticks);
    XBAR();
    TSTAMP(1);
    run_phase(p, layer, 2, smem, eticks);
    XBAR();
    TSTAMP(2);
    run_phase(p, layer, 3, smem, eticks);
    XBAR();
    TSTAMP(3);
    if (nsa) {
      run_phase(p, layer, 4, smem, eticks);
      XBAR();
      TSTAMP(4);
    }
    run_phase(p, layer, 5, smem, eticks);
    XBAR();
    TSTAMP(nsa ? 5 : 7);
    run_phase(p, layer, 6, smem, eticks);
    if (layer < 3 || PROBE_T >= 0) XBAR();
    TSTAMP(6);
  }
  if (PROBE_T >= 0 && blockIdx.x == 0 && __builtin_amdgcn_workitem_id_x() == 0) p.out[0] = (float)((PROBE_T >= 8) ? eticks : tacc) * 0.01f * 0.03f;
}
#endif

extern "C" void kernel_launch(void* const* d_in, const int* in_sizes, int n_in, void* d_out, int out_size, void* d_ws, size_t ws_size,
                              hipStream_t stream) {
  Params p{};
  p.x = (const float*)d_in[0];
  p.c = (const float*)d_in[1];
  p.pos = (const int*)d_in[2];
  p.norm_g = (const float*)d_in[3];
  p.ada_w = (const float*)d_in[4];
  p.ada_b = (const float*)d_in[5];
  p.nsa_w_in = (const float*)d_in[6];
  p.nsa_w_out = (const float*)d_in[7];
  p.nsa_qn = (const float*)d_in[8];
  p.nsa_kn = (const float*)d_in[9];
  p.cmp_pe = (const float*)d_in[10];
  p.cmp_w1 = (const float*)d_in[11];
  p.cmp_b1 = (const float*)d_in[12];
  p.cmp_w2 = (const float*)d_in[13];
  p.gate_b = (const float*)d_in[14];
  p.moba_w_in = (const float*)d_in[15];
  p.moba_w_out = (const float*)d_in[16];
  p.moba_qn = (const float*)d_in[17];
  p.moba_kn = (const float*)d_in[18];
  p.out = (float*)d_out;
  p.ws = (char*)d_ws;
  if (ws_size < WS_TOTAL) { fprintf(stderr, "workspace too small: %zu < %zu\n", ws_size, (size_t)WS_TOTAL); return; }
#if MULTI_LAUNCH
  const int G = 256;
  phase_kernel<0><<<G, 512, 0, stream>>>(p, 0);
  for (int layer = 0; layer < 4; ++layer) {
    phase_kernel<1><<<G, 512, 0, stream>>>(p, layer);
    phase_kernel<2><<<G, 512, 0, stream>>>(p, layer);
    phase_kernel<3><<<G, 512, 0, stream>>>(p, layer);
    if (!(layer & 1)) phase_kernel<4><<<G, 512, 0, stream>>>(p, layer);
    phase_kernel<5><<<G, 512, 0, stream>>>(p, layer);
    phase_kernel<6><<<G, 512, 0, stream>>>(p, layer);
  }
#else
  static int grid_blocks = 0;
  if (!grid_blocks) {
    int dev = 0, cus = 0, per_cu = 0;
    (void)hipGetDevice(&dev);
    (void)hipDeviceGetAttribute(&cus, hipDeviceAttributeMultiprocessorCount, dev);
    (void)hipOccupancyMaxActiveBlocksPerMultiprocessor(&per_cu, mega_kernel, 512, 0);
    if (per_cu > 1) per_cu = 1;
    grid_blocks = cus * per_cu;
  }
  void* args[] = {&p};
  hipError_t e = hipLaunchCooperativeKernel((void*)mega_kernel, dim3(grid_blocks), dim3(512), args, 0, stream);
  if (e != hipSuccess) fprintf(stderr, "cooperative launch failed: %s (grid %d)\n", hipGetErrorString(e), grid_blocks);
#endif
}
```
